# Optimizing an MI355X kernel written in HIP

```python
import math
import jax
import jax.numpy as jnp
from jax import lax
import numpy as np

D_MODEL = 1024
BATCH = 16
SEQ = 256
DEPTH = 4
DEC_BATCH = 4
DEC_SEQ = 2048
PAST_LEN = 256

GRID_W = 64
F32 = jnp.float32

MLA_HEADS = 8
QK_NOPE = 64
QK_ROPE = 32
QK_HEAD = QK_NOPE + QK_ROPE
V_HEAD = 64
Q_RANK = 256
KV_RANK = 128
ROPE_THETA = 10000.0
Q_BLOCK = 128

SSD_HEADS = 4
SSD_HEAD_DIM = 64
SSD_INNER = SSD_HEADS * SSD_HEAD_DIM
SSD_GROUPS = 2
SSD_STATE = 64
SSD_CONV = 5
SSD_CHUNK = 128

CM_CH = 256
CM_WIDTH = 31

D_FF = -(-8 * D_MODEL // (3 * 256)) * 256
N_MOD = 6

MLA_IN = Q_RANK + KV_RANK + QK_ROPE
SSD_XBC = SSD_INNER + 2 * SSD_GROUPS * SSD_STATE
SSD_IN = SSD_INNER + SSD_XBC + 2 * SSD_HEADS
CM_IN = 2 * CM_CH
OFF_SSD = MLA_IN
OFF_CM = MLA_IN + SSD_IN
IN_WIDTH = OFF_CM + CM_IN
MIX_WIDTH = MLA_HEADS * V_HEAD + SSD_INNER + CM_CH

kernel_name = 'hybrid_mla_ssd_conformer_dit_step'


def rmsnorm(x, g, eps=1e-6):
    xf = x.astype(F32)
    y = xf * lax.rsqrt(jnp.mean(xf * xf, axis=-1, keepdims=True) + eps)
    return (y * g.astype(F32)).astype(x.dtype)


def layernorm(x, g, b, eps=1e-5):
    xf = x.astype(F32)
    mu = jnp.mean(xf, axis=-1, keepdims=True)
    var = jnp.mean(jnp.square(xf - mu), axis=-1, keepdims=True)
    y = (xf - mu) * lax.rsqrt(var + eps)
    return (y * g.astype(F32) + b.astype(F32)).astype(x.dtype)


def dwconv(x, w, b):
    k = w.shape[0]
    y = lax.conv_general_dilated(x, w[:, None, :].astype(x.dtype), (1,), [(k // 2, k // 2)],
                                 dimension_numbers=('NWC', 'WIO', 'NWC'),
                                 feature_group_count=x.shape[-1])
    return y + b


def rope_tables(t):
    rows = t // GRID_W
    row = jnp.repeat(jnp.arange(rows), GRID_W).astype(F32)
    col = (jnp.arange(rows * GRID_W) % GRID_W).astype(F32)
    nf = QK_ROPE // 4
    inv = ROPE_THETA ** (-jnp.arange(nf, dtype=F32) / nf)
    ang = jnp.stack([row[:, None] * inv, col[:, None] * inv], axis=1)
    return jnp.cos(ang), jnp.sin(ang)


def apply_rope(x, cos, sin):
    xf = x.astype(F32).reshape(x.shape[:-1] + (2, 2, QK_ROPE // 4))
    x1, x2 = xf[..., 0, :], xf[..., 1, :]
    c, s = cos[:, None], sin[:, None]
    out = jnp.stack([x1 * c - x2 * s, x2 * c + x1 * s], axis=-2)
    return out.reshape(x.shape).astype(x.dtype)


def block_attention(q, k, v):
    b, tq, h, dk = q.shape
    nb = tq // Q_BLOCK
    scale = dk ** -0.5
    qb = q.reshape(b, nb, Q_BLOCK, h, dk).transpose(1, 0, 2, 3, 4)

    def one_block(qi):
        s = jnp.einsum('bqhd,bkhd->bhqk', qi, k).astype(F32) * scale
        p = jax.nn.softmax(s, axis=-1).astype(v.dtype)
        return jnp.einsum('bhqk,bkhd->bqhd', p, v)

    o = lax.map(one_block, qb)
    return o.transpose(1, 0, 2, 3, 4).reshape(b, tq, h, v.shape[-1])


def mla_kv(ckv, kr_h, w_ukv):
    b, t, _ = ckv.shape
    kv = (ckv @ w_ukv).reshape(b, t, MLA_HEADS, QK_NOPE + V_HEAD)
    k = jnp.concatenate([kv[..., :QK_NOPE],
                         jnp.broadcast_to(kr_h, (b, t, MLA_HEADS, QK_ROPE))], axis=-1)
    return k, kv[..., QK_NOPE:]


def mla_mixer(comb, lp, rope, ctx):
    b, t, _ = comb.shape
    q = rmsnorm(comb[..., :Q_RANK], lp['g_q']) @ lp['w_uq']
    q = q.reshape(b, t, MLA_HEADS, QK_HEAD)
    ckv = rmsnorm(comb[..., Q_RANK:Q_RANK + KV_RANK], lp['g_kv'])
    kr = comb[..., Q_RANK + KV_RANK:MLA_IN]
    q_nope, q_rope = q[..., :QK_NOPE], q[..., QK_NOPE:]
    kr_h = kr[:, :, None, :]
    if rope is not None:
        q_rope = apply_rope(q_rope, *rope)
        kr_h = apply_rope(kr_h, *rope)
    q = jnp.concatenate([q_nope, q_rope], axis=-1)
    k, v = mla_kv(ckv, kr_h, lp['w_ukv'])
    if ctx is not None:
        k_c, v_c = mla_kv(ctx[0], ctx[1][:, :, None, :], lp['w_ukv'])
        k = jnp.concatenate([k_c, k], axis=1)
        v = jnp.concatenate([v_c, v], axis=1)
    o = block_attention(q, k, v).reshape(b, t, MLA_HEADS * V_HEAD)
    return o, ckv, kr


def ssd_scan(x, dt, bm, cm, a, h0):
    bsz, t, h, p = x.shape
    n = bm.shape[-1]
    nc = t // SSD_CHUNK
    L = SSD_CHUNK
    xf = (x.astype(F32) * dt[..., None]).reshape(bsz, nc, L, h, p)
    bf = bm.astype(F32).reshape(bsz, nc, L, h, n)
    cf = cm.astype(F32).reshape(bsz, nc, L, h, n)
    acs = jnp.cumsum((dt * a).reshape(bsz, nc, L, h).transpose(0, 3, 1, 2), axis=-1)
    lower = jnp.tril(jnp.ones((L, L), bool))
    seg = jnp.exp(jnp.where(lower, acs[..., :, None] - acs[..., None, :], -jnp.inf))
    y_diag = jnp.einsum('bclhn,bcshn,bhcls,bcshp->bclhp', cf, bf, seg, xf)
    decay_to_end = jnp.exp(acs[..., -1:] - acs)
    chunk_states = jnp.einsum('bclhn,bhcl,bclhp->bchpn', bf, decay_to_end, xf)
    chunk_decay = jnp.exp(acs[..., -1])

    def step(hc, inp):
        s_c, d_c = inp
        return d_c[:, :, None, None] * hc + s_c, hc

    h_fin, h_in = lax.scan(step, h0.astype(F32),
                           (chunk_states.transpose(1, 0, 2, 3, 4), chunk_decay.transpose(2, 0, 1)))
    y_off = jnp.einsum('bclhn,cbhpn,bhcl->bclhp', cf, h_in, jnp.exp(acs))
    y = (y_diag + y_off).reshape(bsz, t, h, p)
    return y.astype(x.dtype), h_fin.astype(h0.dtype)


def ssd_mixer(comb, lp, h0):
    b, t, _ = comb.shape
    z = comb[..., :SSD_INNER]
    xbc = jax.nn.silu(dwconv(comb[..., SSD_INNER:SSD_INNER + SSD_XBC], lp['ssd_conv_w'], lp['ssd_conv_b']))
    xs = xbc[..., :SSD_INNER].reshape(b, t, SSD_HEADS, SSD_HEAD_DIM)
    gn = SSD_GROUPS * SSD_STATE
    rep = SSD_HEADS // SSD_GROUPS
    bm = jnp.repeat(xbc[..., SSD_INNER:SSD_INNER + gn].reshape(b, t, SSD_GROUPS, SSD_STATE), rep, axis=2)
    cm = jnp.repeat(xbc[..., SSD_INNER + gn:].reshape(b, t, SSD_GROUPS, SSD_STATE), rep, axis=2)
    dt_raw = comb[..., SSD_INNER + SSD_XBC:].reshape(b, t, 2, SSD_HEADS)
    y = jnp.zeros_like(xs)
    finals = []
    for d in range(2):
        dt = jax.nn.softplus(dt_raw[:, :, d].astype(F32) + lp['ssd_dt_bias'][d].astype(F32))
        a = -jnp.exp(lp['ssd_a_log'][d].astype(F32))
        args = (xs, dt, bm, cm)
        if d == 1:
            args = tuple(jnp.flip(u, axis=1) for u in args)
        yd, hd = ssd_scan(*args, a, h0[:, d])
        if d == 1:
            yd = jnp.flip(yd, axis=1)
        y = y + yd + lp['ssd_d'][d][:, None] * xs
        finals.append(hd)
    y = y.reshape(b, t, SSD_INNER)
    y = rmsnorm(y * jax.nn.silu(z), lp['ssd_norm_g'])
    return y, jnp.stack(finals, axis=1)


def conv_module(comb, lp):
    g = comb[..., :CM_CH] * jax.nn.sigmoid(comb[..., CM_CH:])
    g = dwconv(g, lp['cm_conv_w'], lp['cm_conv_b'])
    return jax.nn.silu(layernorm(g, lp['cm_ln_g'], lp['cm_ln_b']))


def layer(x, cond, lp, rope=None, ctx=None):
    mod = (jax.nn.silu(cond) @ lp['w_ada'] + lp['b_ada'])[:, None, :]
    sh1, sc1, g1, sh2, sc2, g2 = jnp.split(mod, N_MOD, axis=-1)
    h = rmsnorm(x, lp['g_mix']) * (1 + sc1) + sh1
    comb = h @ lp['w_in']
    attn, ckv, kr = mla_mixer(comb[..., :MLA_IN], lp, rope, None if ctx is None else ctx[:2])
    if ctx is None:
        h0 = jnp.zeros((x.shape[0], 2, SSD_HEADS, SSD_HEAD_DIM, SSD_STATE), x.dtype)
    else:
        h0 = ctx[2]
    ssm, h_fin = ssd_mixer(comb[..., OFF_SSD:OFF_CM], lp, h0)
    conv = conv_module(comb[..., OFF_CM:], lp)
    mixed = jnp.concatenate([attn, ssm, conv], axis=-1)
    x = x + g1 * (mixed @ lp['w_out'])
    h = rmsnorm(x, lp['g_ffn']) * (1 + sc2) + sh2
    ff = (jax.nn.silu(h @ lp['w_gate']) * (h @ lp['w_up'])) @ lp['w_down']
    x = x + g2 * ff
    return x, ckv, kr, h_fin


def setup_inputs(seed: int = 0) -> dict:
    key = jax.random.key(seed)
    ks = jax.random.split(key, 32)
    L = DEPTH

    def nrm(k, shape, s):
        return jax.random.normal(k, shape, F32) * s

    def gain(k, shape):
        return 1.0 + 0.02 * jax.random.normal(k, shape, F32)

    dt0 = jnp.exp(jax.random.uniform(ks[17], (L, 2, SSD_HEADS), F32,
                                     minval=math.log(1e-3), maxval=math.log(1e-1)))
    return dict(
        x_prompt=nrm(ks[0], (BATCH, SEQ, D_MODEL), 1.0),
        x_sample=nrm(ks[1], (DEC_BATCH, DEC_SEQ, D_MODEL), 1.0),
        c=nrm(ks[2], (DEC_BATCH, D_MODEL), 1.0),
        cache_ckv=nrm(ks[3], (DEC_BATCH, L, PAST_LEN, KV_RANK), 1.0),
        cache_krope=nrm(ks[4], (DEC_BATCH, L, PAST_LEN, QK_ROPE), 1.0),
        state_ssd=nrm(ks[5], (DEC_BATCH, L, 2, SSD_HEADS, SSD_HEAD_DIM, SSD_STATE), 0.5),
        c_ctx=nrm(ks[6], (D_MODEL,), 1.0),
        w_ada=nrm(ks[7], (L, D_MODEL, N_MOD * D_MODEL), 0.5 * D_MODEL ** -0.5),
        b_ada=nrm(ks[8], (L, N_MOD * D_MODEL), 0.02),
        g_mix=gain(ks[9], (L, D_MODEL)),
        w_in=nrm(ks[10], (L, D_MODEL, IN_WIDTH), D_MODEL ** -0.5),
        g_q=gain(ks[11], (L, Q_RANK)),
        w_uq=nrm(ks[12], (L, Q_RANK, MLA_HEADS * QK_HEAD), Q_RANK ** -0.5),
        g_kv=gain(ks[13], (L, KV_RANK)),
        w_ukv=nrm(ks[14], (L, KV_RANK, MLA_HEADS * (QK_NOPE + V_HEAD)), KV_RANK ** -0.5),
        ssd_conv_w=nrm(ks[15], (L, SSD_CONV, SSD_XBC), SSD_CONV ** -0.5),
        ssd_conv_b=nrm(ks[16], (L, SSD_XBC), 0.02),
        ssd_dt_bias=dt0 + jnp.log(-jnp.expm1(-dt0)),
        ssd_a_log=jnp.log(jax.random.uniform(ks[18], (L, 2, SSD_HEADS), F32, minval=1.0, maxval=16.0)),
        ssd_d=gain(ks[19], (L, 2, SSD_HEADS)),
        ssd_norm_g=gain(ks[20], (L, SSD_INNER)),
        cm_conv_w=nrm(ks[21], (L, CM_WIDTH, CM_CH), CM_WIDTH ** -0.5),
        cm_conv_b=nrm(ks[22], (L, CM_CH), 0.02),
        cm_ln_g=gain(ks[23], (L, CM_CH)),
        cm_ln_b=nrm(ks[24], (L, CM_CH), 0.02),
        w_out=nrm(ks[25], (L, MIX_WIDTH, D_MODEL), MIX_WIDTH ** -0.5),
        g_ffn=gain(ks[26], (L, D_MODEL)),
        w_gate=nrm(ks[27], (L, D_MODEL, D_FF), D_MODEL ** -0.5),
        w_up=nrm(ks[28], (L, D_MODEL, D_FF), D_MODEL ** -0.5),
        w_down=nrm(ks[29], (L, D_FF, D_MODEL), D_FF ** -0.5),
        g_final=gain(ks[30], (D_MODEL,)),
    )


def reference(x_prompt, x_sample, c, cache_ckv, cache_krope, state_ssd, c_ctx, w_ada, b_ada,
              g_mix, w_in, g_q, w_uq, g_kv, w_ukv, ssd_conv_w, ssd_conv_b, ssd_dt_bias,
              ssd_a_log, ssd_d, ssd_norm_g, cm_conv_w, cm_conv_b, cm_ln_g, cm_ln_b, w_out,
              g_ffn, w_gate, w_up, w_down, g_final):
    rope = rope_tables(x_sample.shape[1])
    cond_ctx = c_ctx[None, :]
    xp, xs = x_prompt, x_sample
    ckvs, krs, hss = [], [], []
    for l in range(DEPTH):
        lp = dict(w_ada=w_ada[l], b_ada=b_ada[l], g_mix=g_mix[l], w_in=w_in[l], g_q=g_q[l],
                  w_uq=w_uq[l], g_kv=g_kv[l], w_ukv=w_ukv[l], ssd_conv_w=ssd_conv_w[l],
                  ssd_conv_b=ssd_conv_b[l], ssd_dt_bias=ssd_dt_bias[l], ssd_a_log=ssd_a_log[l],
                  ssd_d=ssd_d[l], ssd_norm_g=ssd_norm_g[l], cm_conv_w=cm_conv_w[l],
                  cm_conv_b=cm_conv_b[l], cm_ln_g=cm_ln_g[l], cm_ln_b=cm_ln_b[l], w_out=w_out[l],
                  g_ffn=g_ffn[l], w_gate=w_gate[l], w_up=w_up[l], w_down=w_down[l])
        xp, ckv, kr, h_fin = layer(xp, cond_ctx, lp)
        ckvs.append(ckv)
        krs.append(kr)
        hss.append(h_fin)
        xs = layer(xs, c, lp, rope, (cache_ckv[:, l], cache_krope[:, l], state_ssd[:, l]))[0]
    y_prompt = rmsnorm(xp, g_final)
    y_sample = rmsnorm(xs, g_final)
    new_ckv = jnp.stack(ckvs, axis=1)
    new_krope = jnp.stack(krs, axis=1)
    new_ssd = jnp.stack(hss, axis=1)
    return (y_prompt, y_sample, new_ckv, new_krope, new_ssd)
```

```cpp
#include <hip/hip_runtime.h>
#include <hip/hip_cooperative_groups.h>
#include <stdint.h>
#include <stdio.h>
namespace cg = cooperative_groups;

#ifndef USE_CG_SYNC
#define USE_CG_SYNC 0
#endif

#define DI __device__ __forceinline__
#define LAS __attribute__((address_space(3)))
typedef unsigned short u16;
typedef __bf16 bf2_t __attribute__((ext_vector_type(2)));
typedef float f2_t __attribute__((ext_vector_type(2)));
using bf16x8 = __attribute__((ext_vector_type(8))) short;
using s16x4 = __attribute__((ext_vector_type(4))) short;
using f32x4 = __attribute__((ext_vector_type(4))) float;
using u32x4 = __attribute__((ext_vector_type(4))) unsigned;
using u32x2 = __attribute__((ext_vector_type(2))) unsigned;

#define MFMA(a, b, c) __builtin_amdgcn_mfma_f32_16x16x32_bf16((a), (b), (c), 0, 0, 0)

constexpr int NTOK = 12288, NCTX = 4096, KVROWS = 13312;
constexpr int INW = 1704, INWP = 1792, DFF = 2816;
constexpr size_t O_CKV = 12582912, O_KR = 14680064, O_SSD = 15204352;
constexpr int LDS_MAIN = 131072;
constexpr int LDS_BYTES = LDS_MAIN + 64;
constexpr int NTHREADS = 512;

struct P {
  const float *x_prompt, *x_sample, *c, *cache_ckv, *cache_krope, *state_ssd, *c_ctx, *w_ada, *b_ada, *g_mix, *w_in,
      *g_q, *w_uq, *g_kv, *w_ukv, *ssd_conv_w, *ssd_conv_b, *ssd_dt_bias, *ssd_a_log, *ssd_d, *ssd_norm_g, *cm_conv_w,
      *cm_conv_b, *cm_ln_g, *cm_ln_b, *w_out, *g_ffn, *w_gate, *w_up, *w_down, *g_final;
  float* out;
  unsigned* bar;
  unsigned* ctr;
  u16 *wt_in, *wt_uq, *wt_ukv, *wt_out, *wt_gu, *wt_down;
  float *mod, *ropec, *ropes;
  u16* hb;
  u16* comb;
  u16* act;
  u16 *qn, *ckvn, *qbuf, *knope, *vt, *krope;
  float *xbc, *dtb, *ydir;
};

typedef const __attribute__((address_space(4))) P CP;
DI CP& get_params() {
  unsigned long long kp = (unsigned long long)__builtin_amdgcn_kernarg_segment_ptr();
  asm volatile("" : "+s"(kp));
  return *(CP*)kp;
}
DI int opaque_tid() { int t = threadIdx.x; asm volatile("" : "+v"(t)); return t; }

DI unsigned pack2(float a, float b) {
  f2_t v = {a, b};
  bf2_t r = __builtin_convertvector(v, bf2_t);
  return __builtin_bit_cast(unsigned, r);
}
DI u16 f2bf(float a) { return (u16)(pack2(a, 0.f) & 0xffffu); }
DI float bf2f(u16 v) { return __uint_as_float(((unsigned)v) << 16); }
DI float frcp(float x) { return __builtin_amdgcn_rcpf(x); }
DI float xrow16_max(float x) {
  auto s = __builtin_amdgcn_permlane16_swap(__float_as_uint(x), __float_as_uint(x), false, false);
  x = fmaxf(__uint_as_float(s[0]), __uint_as_float(s[1]));
  auto t = __builtin_amdgcn_permlane32_swap(__float_as_uint(x), __float_as_uint(x), false, false);
  return fmaxf(__uint_as_float(t[0]), __uint_as_float(t[1]));
}
DI float xrow16_sum(float x) {
  auto s = __builtin_amdgcn_permlane16_swap(__float_as_uint(x), __float_as_uint(x), false, false);
  x = __uint_as_float(s[0]) + __uint_as_float(s[1]);
  auto t = __builtin_amdgcn_permlane32_swap(__float_as_uint(x), __float_as_uint(x), false, false);
  return __uint_as_float(t[0]) + __uint_as_float(t[1]);
}
template <int CTRL> DI float dppf(float x) {
  return __builtin_bit_cast(float, __builtin_amdgcn_mov_dpp(__builtin_bit_cast(int, x), CTRL, 0xf, 0xf, true));
}
DI float wave_sum(float x) {
  x += dppf<0xB1>(x);
  x += dppf<0x4E>(x);
  x += dppf<0x141>(x);
  x += dppf<0x128>(x);
  return xrow16_sum(x);
}
DI float sigmoidf(float x) { return frcp(1.f + __expf(-x)); }
DI float siluf(float x) { return x * frcp(1.f + __expf(-x)); }

#define XB_TMO      128
#define XB_XCNT(j)  (256  + 64 * (j))
#define XB_XSUB(j)  (1280 + 64 * (j))
#define XB_XGEN(j)  (2304 + 64 * (j))
#define XB_TOP      3328
#define XB_TOPGEN   3392
#define XB_SPIN_CAP (1u << 20)
DI unsigned xb_ld(unsigned* p) { return __hip_atomic_load(p, __ATOMIC_RELAXED, __HIP_MEMORY_SCOPE_AGENT); }
DI unsigned xb_add(unsigned* p, unsigned v) { return __hip_atomic_fetch_add(p, v, __ATOMIC_RELAXED, __HIP_MEMORY_SCOPE_AGENT); }
DI unsigned xb_xcc_id() { return (unsigned)__builtin_amdgcn_s_getreg((3 << 11) | 20) & 0xFu; }
#define XB_SPIN(cond, bar) do { unsigned _sp = 0; while (cond) { __builtin_amdgcn_s_sleep(1); \
    if ((++_sp & 255u) == 0u) { if (xb_ld(&(bar)[XB_TMO])) break; if (_sp > XB_SPIN_CAP) { atomicAdd(&(bar)[XB_TMO], 1u); break; } } } } while (0)
struct XcdBarrier { unsigned* bar; unsigned x; volatile LAS unsigned* st; };
DI XcdBarrier xcd_barrier_post(unsigned* bar, volatile LAS unsigned* st) {
  XcdBarrier b; b.bar = bar; b.x = xb_xcc_id(); b.st = st;
  if (threadIdx.x == 0) (void)xb_add(&bar[XB_XCNT(b.x)], 1u);
  return b;
}
DI void xcd_barrier_complete(unsigned* bar, unsigned x, unsigned& nloc, unsigned& nx) {
  const unsigned G = gridDim.x * gridDim.y * gridDim.z;
  unsigned sum, cnt, mine, sp = 0u;
  for (;;) {
    sum = 0u; cnt = 0u; mine = 0u;
#pragma unroll
    for (unsigned j = 0; j < 16; ++j) { const unsigned c = xb_ld(&bar[XB_XCNT(j)]); sum += c; cnt += (c > 0u) ? 1u : 0u; mine = (j == x) ? c : mine; }
    if (sum == G) break;
    __builtin_amdgcn_s_sleep(1);
    if ((++sp & 255u) == 0u) { if (xb_ld(&bar[XB_TMO])) break; if (sp > XB_SPIN_CAP) { atomicAdd(&bar[XB_TMO], 1u); break; } }
  }
  nloc = mine > 0u ? mine : 1u; nx = cnt > 0u ? cnt : 1u;
}
DI void xcd_barrier(const XcdBarrier& b0) {
  asm volatile("s_waitcnt vmcnt(0)" ::: "memory");
  __syncthreads();
  if (threadIdx.x == 0) {
    XcdBarrier b; b.bar = get_params().bar; b.x = xb_xcc_id(); b.st = b0.st;
    unsigned* bar = b.bar;
    __builtin_amdgcn_s_waitcnt(0);
    unsigned nloc = b.st[0], nx = b.st[1];
    if (nloc == 0u) { xcd_barrier_complete(bar, b.x, nloc, nx); b.st[0] = nloc; b.st[1] = nx; }
    const unsigned old = xb_add(&bar[XB_XSUB(b.x)], 1u);
    const unsigned gen = old / nloc;
    if (old + 1u == (gen + 1u) * nloc) {
      __builtin_amdgcn_fence(__ATOMIC_RELEASE, "agent");
      asm volatile("s_waitcnt vmcnt(0)" ::: "memory");
      const unsigned og = xb_add(&bar[XB_TOP], 1u);
      const unsigned tg = og / nx;
      if (og + 1u == (tg + 1u) * nx) xb_add(&bar[XB_TOPGEN], 1u);
      else XB_SPIN(xb_ld(&bar[XB_TOPGEN]) == tg, bar);
      __builtin_amdgcn_fence(__ATOMIC_ACQUIRE, "agent");
      xb_add(&bar[XB_XGEN(b.x)], 1u);
      asm volatile("s_waitcnt vmcnt(0)" ::: "memory");
    } else {
      XB_SPIN(xb_ld(&bar[XB_XGEN(b.x)]) == gen, bar);
      __builtin_amdgcn_fence(__ATOMIC_ACQUIRE, "agent");
      asm volatile("s_waitcnt vmcnt(0)" ::: "memory");
    }
  }
  __syncthreads();
}

enum { E_COMB = 0, E_Q = 1, E_KV = 2, E_RES = 3, E_SWIGLU = 4 };

DI int lds_byte(int r, int c) {
  const int st = (r >> 4) * 2 + (c >> 5), ob = (r & 15) * 64 + (c & 31) * 2;
  return st * 1024 + (ob ^ (((ob >> 9) & 1) << 5));
}
DI void stage_rc(int b, int& R, int& C) {
  const int st = b >> 10, sb = b & 1023, swz = sb ^ (((sb >> 9) & 1) << 5);
  R = (st >> 1) * 16 + swz / 64;
  C = (st & 1) * 32 + (swz % 64) / 2;
}
DI void tile_rc(int t, int nM, int nN, int& pm, int& pn) {
  const int nwg = nM * nN;
  const int q = nwg / 8, r = nwg % 8, xcd = t % 8, off = t / 8;
  const int w = (xcd < r ? xcd * (q + 1) : r * (q + 1) + (xcd - r) * q) + off;
  const int nig = 8 * nN, gid = w / nig, fm = gid * 8;
  const int gsz = (nM - fm) < 8 ? (nM - fm) : 8;
  pm = fm + ((w % nig) % gsz);
  pn = (w % nig) / gsz;
}

template <int EPI, int MT>
DI void gemm_epilogue(CP& p, int l, const f32x4 (&acc)[MT][4], int mb, int nb, int goff, int fr, int fq) {
#pragma unroll
  for (int mi = 0; mi < MT; ++mi) {
    const int m = mb + mi * 16 + fr;
#pragma unroll
    for (int ni = 0; ni < 4; ++ni) {
      const int n = nb + ni * 16 + fq * 4;
      const f32x4 v = acc[mi][ni];
      if (EPI == E_COMB) {
        if (n < INW) { u32x2 o = {pack2(v[0], v[1]), pack2(v[2], v[3])}; *(u32x2*)(p.comb + (size_t)m * INW + n) = o; }
      } else if (EPI == E_Q) {
        u32x2 o = {pack2(v[0], v[1]), pack2(v[2], v[3])};
        *(u32x2*)(p.qbuf + (size_t)m * 768 + n) = o;
      } else if (EPI == E_KV) {
        const int hh = n >> 7, c = n & 127;
        if (c < 64) {
          u32x2 o = {pack2(v[0], v[1]), pack2(v[2], v[3])};
          *(u32x2*)(p.knope + (size_t)m * 512 + hh * 64 + c) = o;
        } else {
          int kvbase, Tk;
          if (m < NCTX) { kvbase = m & ~255; Tk = 256; }
          else { const int b = (m - NCTX) / 2304; kvbase = NCTX + b * 2304; Tk = 2304; }
          u16* dst = p.vt + (size_t)512 * kvbase + (size_t)(hh * 64 + (c - 64)) * Tk + (m - kvbase);
#pragma unroll
          for (int i = 0; i < 4; ++i) dst[(size_t)i * Tk] = f2bf(v[i]);
        }
      } else if (EPI == E_RES) {
        const int vs = m < NCTX ? 0 : 1 + ((m - NCTX) >> 11);
        const f32x4 gt = *(const f32x4*)(p.mod + (size_t)(l * 5 + vs) * 6144 + goff + n);
        float* xp = p.out + (size_t)m * 1024 + n;
        const float* xs = xp;
        if (l == 0 && goff == 2048) xs = (m < NCTX ? p.x_prompt + (size_t)m * 1024 : p.x_sample + (size_t)(m - NCTX) * 1024) + n;
        f32x4 xv = *(const f32x4*)xs;
        xv += gt * v;
        *(f32x4*)xp = xv;
      } else if (EPI == E_SWIGLU) {
        if ((ni & 1) == 0) {
          const f32x4 u = acc[mi][ni + 1];
          u32x2 o = {pack2(siluf(v[0]) * u[0], siluf(v[1]) * u[1]), pack2(siluf(v[2]) * u[2], siluf(v[3]) * u[3])};
          *(u32x2*)(p.act + (size_t)m * DFF + ((nb + ni * 16) >> 1) + fq * 4) = o;
        }
      }
    }
  }
}

#define GEMM_STAGE(buf, Ap, Wp, kt) do {                                                                                  \
    _Pragma("unroll") for (int i = 0; i < GLA; ++i)                                                                       \
      __builtin_amdgcn_global_load_lds((const unsigned*)((Ap) + (size_t)sR[i] * K + (kt) * 64 + sC[i]),                    \
                                       (LAS unsigned*)(ls + (buf) * STAGE_B + wid * 1024 + i * 8192), 16, 0, 0);         \
    _Pragma("unroll") for (int i = 0; i < 4; ++i)                                                                         \
      __builtin_amdgcn_global_load_lds((const unsigned*)((Wp) + (size_t)sR[i] * K + (kt) * 64 + sC[i]),                    \
                                       (LAS unsigned*)(ls + (buf) * STAGE_B + TILE_A + wid * 1024 + i * 8192), 16, 0, 0); \
  } while (0)

template <int EPI, int BM>
DI void gemm_phase(CP& p, int l, const u16* __restrict__ A, const u16* __restrict__ W, int K, int nM, int nN, int goff,
                   int t0, int tstride, int ntiles, bool raster, char* smem) {
  const int tid = opaque_tid(), lane = tid & 63, wid = tid >> 6;
  const int wr = wid >> 2, wc = wid & 3, fr = lane & 15, fq = lane >> 4;
  constexpr int MT = BM / 32, GLA = BM / 64;
  constexpr int TILE_A = BM * 128, TILE_B = 256 * 128, STAGE_B = TILE_A + TILE_B;
  LAS char* ls = (LAS char*)smem;
  int sR[4], sC[4];
#pragma unroll
  for (int i = 0; i < 4; ++i) stage_rc(wid * 1024 + i * 8192 + lane * 16, sR[i], sC[i]);
  int t = t0;
  if (t >= ntiles) return;
  int pm, pn;
  if (raster) tile_rc(t, nM, nN, pm, pn); else { pn = t / nM; pm = t - pn * nM; }
  const u16* Ab = A + (size_t)pm * BM * K;
  const u16* Wb = W + (size_t)pn * 256 * K;
  const int nt = K >> 6;
  __syncthreads();
  GEMM_STAGE(0, Ab, Wb, 0);
  asm volatile("s_waitcnt vmcnt(0)" ::: "memory");
  __syncthreads();
  for (;;) {
    const int tn = t + tstride;
    const bool has_next = tn < ntiles;
    int pmn = 0, pnn = 0;
    if (has_next) { if (raster) tile_rc(tn, nM, nN, pmn, pnn); else { pnn = tn / nM; pmn = tn - pnn * nM; } }
    const u16* Abn = A + (size_t)pmn * BM * K;
    const u16* Wbn = W + (size_t)pnn * 256 * K;
    f32x4 acc[MT][4];
#pragma unroll
    for (int m = 0; m < MT; ++m)
#pragma unroll
      for (int n = 0; n < 4; ++n) acc[m][n] = (f32x4){0.f, 0.f, 0.f, 0.f};
    for (int kt = 0; kt < nt; ++kt) {
      const int cur = kt & 1;
      if (kt + 1 < nt) GEMM_STAGE(cur ^ 1, Ab, Wb, kt + 1);
      else if (has_next) GEMM_STAGE(cur ^ 1, Abn, Wbn, 0);
      const char* sa = smem + cur * STAGE_B;
      const char* sb = sa + TILE_A;
#pragma unroll
      for (int ks = 0; ks < 2; ++ks) {
        bf16x8 At[MT], Bf[4];
#pragma unroll
        for (int m = 0; m < MT; ++m) At[m] = *(const bf16x8*)(sa + lds_byte(wr * (BM / 2) + m * 16 + fr, ks * 32 + fq * 8));
#pragma unroll
        for (int n = 0; n < 4; ++n) Bf[n] = *(const bf16x8*)(sb + lds_byte(wc * 64 + n * 16 + fr, ks * 32 + fq * 8));
        __builtin_amdgcn_s_setprio(1);
#pragma unroll
        for (int m = 0; m < MT; ++m)
#pragma unroll
          for (int n = 0; n < 4; ++n) acc[m][n] = MFMA(Bf[n], At[m], acc[m][n]);
        __builtin_amdgcn_s_setprio(0);
        __builtin_amdgcn_sched_barrier(0);
      }
      if (kt + 1 < nt) {
        asm volatile("s_waitcnt vmcnt(0)" ::: "memory");
        __syncthreads();
      }
    }
    gemm_epilogue<EPI, MT>(p, l, acc, pm * BM + wr * (BM / 2), pn * 256 + wc * 64, goff, fr, fq);
    asm volatile("s_waitcnt vmcnt(0)" ::: "memory");
    __syncthreads();
    if (!has_next) break;
    t = tn; pm = pmn; pn = pnn; Ab = Abn; Wb = Wbn;
  }
}
#undef GEMM_STAGE

DI void conv_wtile(const float* __restrict__ src, int K, int N, u16* __restrict__ dst, int rowmul, int rowoff, int kt,
                   int nt, LAS float* wt, int lane) {
  const int k0 = kt * 32, n0 = nt * 64;
  float v[32];
  const bool ok = n0 + lane < N;
  const float* sp = src + (size_t)k0 * N + n0 + lane;
#pragma unroll
  for (int i = 0; i < 32; ++i) v[i] = ok ? sp[(size_t)i * N] : 0.f;
#pragma unroll
  for (int i = 0; i < 32; ++i) wt[i * 65 + lane] = v[i];
#pragma unroll
  for (int i = 0; i < 16; ++i) {
    const int n = i * 4 + (lane >> 4), kp = lane & 15;
    const float lo = wt[(2 * kp) * 65 + n], hi = wt[(2 * kp + 1) * 65 + n];
    const int nn = n0 + n;
    const int drow = rowmul == 1 ? nn : ((nn >> 4) << 5) + (nn & 15) + 16 * rowoff;
    *(unsigned*)(dst + (size_t)drow * K + k0 + 2 * kp) = pack2(lo, hi);
  }
}

DI void conv_dispatch(CP& p, int l, int r, LAS float* wt, int lane) {
  if (r < 896) {
    conv_wtile(p.w_in + (size_t)l * 1024 * INW, 1024, INW, p.wt_in + (size_t)l * INWP * 1024, 1, 0, r & 31, r >> 5, wt, lane);
  } else if ((r -= 896) < 96) {
    conv_wtile(p.w_uq + (size_t)l * 256 * 768, 256, 768, p.wt_uq + (size_t)l * 768 * 256, 1, 0, r & 7, r >> 3, wt, lane);
  } else if ((r -= 96) < 64) {
    conv_wtile(p.w_ukv + (size_t)l * 128 * 1024, 128, 1024, p.wt_ukv + (size_t)l * 1024 * 128, 1, 0, r & 3, r >> 2, wt, lane);
  } else if ((r -= 64) < 512) {
    conv_wtile(p.w_out + (size_t)l * 1024 * 1024, 1024, 1024, p.wt_out + (size_t)l * 1024 * 1024, 1, 0, r & 31, r >> 5, wt, lane);
  } else if ((r -= 512) < 1408) {
    conv_wtile(p.w_gate + (size_t)l * 1024 * DFF, 1024, DFF, p.wt_gu + (size_t)l * 2 * DFF * 1024, 2, 0, r & 31, r >> 5, wt, lane);
  } else if ((r -= 1408) < 1408) {
    conv_wtile(p.w_up + (size_t)l * 1024 * DFF, 1024, DFF, p.wt_gu + (size_t)l * 2 * DFF * 1024, 2, 1, r & 31, r >> 5, wt, lane);
  } else {
    r -= 1408;
    conv_wtile(p.w_down + (size_t)l * DFF * 1024, DFF, 1024, p.wt_down + (size_t)l * 1024 * DFF, 1, 0, r % 88, r / 88, wt, lane);
  }
}

DI void conv_fill(CP& p, int l, int r_lo, int r_hi, unsigned* ctr, int* slot, char* smem) {
  const int tid = opaque_tid(), lane = tid & 63, wave = tid >> 6;
  LAS float* wt = (LAS float*)smem + wave * (32 * 65);
  const int nitems = (r_hi - r_lo + 7) >> 3;
  for (;;) {
    __syncthreads();
    if (tid == 0) *slot = (int)atomicAdd(ctr, 1u);
    __syncthreads();
    const int it = *slot;
    if (it >= nitems) break;
    const int r = r_lo + it * 8 + wave;
    if (r < r_hi) conv_dispatch(p, l, r, wt, lane);
  }
}

DI void phase0(CP& p, char* smem) {
  const int tid = opaque_tid();
  const int G = gridDim.x, bid = blockIdx.x;
  {
    const int lane = tid & 63, wave = tid >> 6;
    LAS float* wt = (LAS float*)smem + wave * (32 * 65);
    __syncthreads();
    for (int idx = bid * 8 + wave; idx < 5792; idx += G * 8) conv_dispatch(p, 0, idx, wt, lane);
  }
  {
    float* scond = (float*)(smem + 32768);
    float* red = scond + 5120;
    __syncthreads();
    for (int i = tid; i < 5120; i += NTHREADS) {
      const int v = i >> 10, k = i & 1023;
      const float x = v == 0 ? p.c_ctx[k] : p.c[(v - 1) * 1024 + k];
      scond[i] = siluf(x);
    }
    __syncthreads();
    for (int job = bid; job < 384; job += G) {
      const int l = job / 96, chunk = job - l * 96;
      const int c = tid & 63, kg = tid >> 6, col = chunk * 64 + c;
      float a0 = 0.f, a1 = 0.f, a2 = 0.f, a3 = 0.f, a4 = 0.f;
      const float* w = p.w_ada + ((size_t)l * 1024 + kg * 128) * 6144 + col;
      const float* sc = scond + kg * 128;
#pragma unroll 32
      for (int k = 0; k < 128; ++k) {
        const float wv = w[(size_t)k * 6144];
        a0 += sc[k] * wv; a1 += sc[1024 + k] * wv; a2 += sc[2048 + k] * wv; a3 += sc[3072 + k] * wv; a4 += sc[4096 + k] * wv;
      }
      red[(kg * 5 + 0) * 64 + c] = a0; red[(kg * 5 + 1) * 64 + c] = a1; red[(kg * 5 + 2) * 64 + c] = a2;
      red[(kg * 5 + 3) * 64 + c] = a3; red[(kg * 5 + 4) * 64 + c] = a4;
      __syncthreads();
      if (kg == 0) {
        const float bb = p.b_ada[l * 6144 + col];
#pragma unroll
        for (int v = 0; v < 5; ++v) {
          float s = 0.f;
#pragma unroll
          for (int q = 0; q < 8; ++q) s += red[(q * 5 + v) * 64 + c];
          p.mod[(size_t)(l * 5 + v) * 6144 + col] = s + bb;
        }
      }
      __syncthreads();
    }
  }
  for (int i = bid * NTHREADS + tid; i < 2048 * 16; i += G * NTHREADS) {
    const int t = i >> 4, a = (i >> 3) & 1, f = i & 7;
    const float pos = a == 0 ? (float)(t >> 6) : (float)(t & 63);
    const float inv = powf(10000.0f, -(float)f / 8.0f);
    const float ang = pos * inv;
    p.ropec[i] = cosf(ang);
    p.ropes[i] = sinf(ang);
  }
}

DI void norm_phase(CP& p, int l, int which) {
  const int tid = opaque_tid(), lane = tid & 63, wave = tid >> 6;
  const float* gw = (which == 0 ? p.g_mix : p.g_ffn) + l * 1024;
  const int shoff = which == 0 ? 0 : 3072, scoff = shoff + 1024;
  f32x4 gg[4];
#pragma unroll
  for (int i = 0; i < 4; ++i) gg[i] = *(const f32x4*)(gw + i * 256 + lane * 4);
  const int stride = gridDim.x * 8;
  for (int tok0 = blockIdx.x * 8 + wave; tok0 < NTOK; tok0 += 2 * stride) {
    f32x4 v[2][4], sc[2][4], sh[2][4];
    bool ok[2];
#pragma unroll
    for (int a = 0; a < 2; ++a) {
      const int tok = tok0 + a * stride;
      ok[a] = tok < NTOK;
      const int tk = ok[a] ? tok : tok0;
      const float* xr = p.out + (size_t)tk * 1024;
      if (l == 0 && which == 0) xr = tk < NCTX ? p.x_prompt + (size_t)tk * 1024 : p.x_sample + (size_t)(tk - NCTX) * 1024;
      const int vs = tk < NCTX ? 0 : 1 + ((tk - NCTX) >> 11);
      const float* md = p.mod + (size_t)(l * 5 + vs) * 6144;
#pragma unroll
      for (int i = 0; i < 4; ++i) {
        const int col = i * 256 + lane * 4;
        v[a][i] = *(const f32x4*)(xr + col);
        sc[a][i] = *(const f32x4*)(md + scoff + col);
        sh[a][i] = *(const f32x4*)(md + shoff + col);
      }
    }
#pragma unroll
    for (int a = 0; a < 2; ++a) {
      const int tok = tok0 + a * stride;
      float ss = 0.f;
#pragma unroll
      for (int i = 0; i < 4; ++i) ss += v[a][i][0] * v[a][i][0] + v[a][i][1] * v[a][i][1] + v[a][i][2] * v[a][i][2] + v[a][i][3] * v[a][i][3];
      ss = wave_sum(ss);
      const float rstd = rsqrtf(ss * (1.f / 1024.f) + 1e-6f);
      if (ok[a]) {
#pragma unroll
        for (int i = 0; i < 4; ++i) {
          const int col = i * 256 + lane * 4;
          f32x4 o;
#pragma unroll
          for (int j = 0; j < 4; ++j) o[j] = v[a][i][j] * rstd * gg[i][j] * (1.f + sc[a][i][j]) + sh[a][i][j];
          u32x2 pk = {pack2(o[0], o[1]), pack2(o[2], o[3])};
          *(u32x2*)(p.hb + (size_t)tok * 1024 + col) = pk;
        }
      }
    }
  }
}

DI void final_norm(CP& p) {
  const int tid = opaque_tid(), lane = tid & 63, wave = tid >> 6;
  f32x4 gg[4];
#pragma unroll
  for (int i = 0; i < 4; ++i) gg[i] = *(const f32x4*)(p.g_final + i * 256 + lane * 4);
  const int stride = gridDim.x * 8;
  for (int tok0 = blockIdx.x * 8 + wave; tok0 < NTOK; tok0 += 2 * stride) {
    f32x4 v[2][4];
    bool ok[2];
#pragma unroll
    for (int a = 0; a < 2; ++a) {
      const int tok = tok0 + a * stride;
      ok[a] = tok < NTOK;
      const float* xr = p.out + (size_t)(ok[a] ? tok : tok0) * 1024;
#pragma unroll
      for (int i = 0; i < 4; ++i) v[a][i] = *(const f32x4*)(xr + i * 256 + lane * 4);
    }
#pragma unroll
    for (int a = 0; a < 2; ++a) {
      const int tok = tok0 + a * stride;
      float ss = 0.f;
#pragma unroll
      for (int i = 0; i < 4; ++i) ss += v[a][i][0] * v[a][i][0] + v[a][i][1] * v[a][i][1] + v[a][i][2] * v[a][i][2] + v[a][i][3] * v[a][i][3];
      ss = wave_sum(ss);
      const float rstd = rsqrtf(ss * (1.f / 1024.f) + 1e-6f);
      if (ok[a]) {
        float* xr = p.out + (size_t)tok * 1024;
#pragma unroll
        for (int i = 0; i < 4; ++i) {
          f32x4 o;
#pragma unroll
          for (int j = 0; j < 4; ++j) o[j] = v[a][i][j] * rstd * gg[i][j];
          *(f32x4*)(xr + i * 256 + lane * 4) = o;
        }
      }
    }
  }
}

DI void prep_cache_row(CP& p, int l, int row) {
  const int lane = opaque_tid() & 63;
  {
    const int r = row - NTOK, b = r >> 8, j = r & 255;
    const int kvrow = NCTX + b * 2304 + j;
    const float* ck = p.cache_ckv + ((size_t)(b * 4 + l) * 256 + j) * 128;
    const f2_t v = *(const f2_t*)(ck + lane * 2);
    *(unsigned*)(p.ckvn + (size_t)kvrow * 128 + lane * 2) = pack2(v[0], v[1]);
    if (lane < 16) {
      const float* kr = p.cache_krope + ((size_t)(b * 4 + l) * 256 + j) * 32;
      const f2_t w = *(const f2_t*)(kr + lane * 2);
      *(unsigned*)(p.krope + (size_t)kvrow * 32 + lane * 2) = pack2(w[0], w[1]);
    }
  }
}

constexpr int PSTR = 1192;
struct PrepW { f32x4 gq; f2_t gkv; float cw[8][5]; float cb[8]; float dtb; };
DI void prep_load_w(CP& p, int l, int lane, PrepW& w) {
  w.gq = *(const f32x4*)(p.g_q + l * 256 + lane * 4);
  w.gkv = *(const f2_t*)(p.g_kv + l * 128 + lane * 2);
  const float* cw = p.ssd_conv_w + (size_t)l * 5 * 512;
  const float* cb = p.ssd_conv_b + l * 512;
#pragma unroll
  for (int i = 0; i < 8; ++i) {
    w.cb[i] = cb[i * 64 + lane];
#pragma unroll
    for (int j = 0; j < 5; ++j) w.cw[i][j] = cw[j * 512 + i * 64 + lane];
  }
  w.dtb = p.ssd_dt_bias[l * 8 + (lane & 7)];
}
DI void prep_row(CP& p, int l, int tok, const LAS float* cr, const PrepW& w, int lane) {
  int b, t, T, kvrow;
  const bool lat = tok >= NCTX;
  if (!lat) { b = tok >> 8; t = tok & 255; T = 256; kvrow = tok; }
  else { const int q = tok - NCTX; b = q >> 11; t = q & 2047; T = 2048; kvrow = NCTX + b * 2304 + 256 + t; }
  {
    const f32x4 v = *(const LAS f32x4*)(cr + lane * 4);
    float ss = v[0] * v[0] + v[1] * v[1] + v[2] * v[2] + v[3] * v[3];
    ss = wave_sum(ss);
    const float rstd = rsqrtf(ss * (1.f / 256.f) + 1e-6f);
    const f32x4 gg = w.gq;
    u32x2 pk = {pack2(v[0] * rstd * gg[0], v[1] * rstd * gg[1]), pack2(v[2] * rstd * gg[2], v[3] * rstd * gg[3])};
    *(u32x2*)(p.qn + (size_t)tok * 256 + lane * 4) = pk;
  }
  {
    const f2_t v = *(const LAS f2_t*)(cr + 256 + lane * 2);
    float ss = v[0] * v[0] + v[1] * v[1];
    ss = wave_sum(ss);
    const float rstd = rsqrtf(ss * (1.f / 128.f) + 1e-6f);
    const f2_t gg = w.gkv;
    const float o0 = v[0] * rstd * gg[0], o1 = v[1] * rstd * gg[1];
    *(unsigned*)(p.ckvn + (size_t)kvrow * 128 + lane * 2) = pack2(o0, o1);
    if (!lat) {
      f2_t o = {o0, o1};
      *(f2_t*)(p.out + O_CKV + ((size_t)(b * 4 + l) * 256 + t) * 128 + lane * 2) = o;
    }
  }
  if (lane < 16) {
    const int a = lane >> 3, f = lane & 7;
    const float x1 = cr[384 + a * 16 + f], x2 = cr[384 + a * 16 + 8 + f];
    float o1 = x1, o2 = x2;
    if (!lat) {
      float* dst = p.out + O_KR + ((size_t)(b * 4 + l) * 256 + t) * 32;
      dst[a * 16 + f] = x1;
      dst[a * 16 + 8 + f] = x2;
    } else {
      const float c = p.ropec[t * 16 + a * 8 + f], s = p.ropes[t * 16 + a * 8 + f];
      o1 = x1 * c - x2 * s;
      o2 = x2 * c + x1 * s;
    }
    p.krope[(size_t)kvrow * 32 + a * 16 + f] = f2bf(o1);
    p.krope[(size_t)kvrow * 32 + a * 16 + 8 + f] = f2bf(o2);
  }
  {
#pragma unroll
    for (int i = 0; i < 8; ++i) {
      const int c = i * 64 + lane;
      float acc = w.cb[i];
#pragma unroll
      for (int j = 0; j < 5; ++j) {
        acc += w.cw[i][j] * cr[(j - 2) * PSTR + 672 + c];
      }
      p.xbc[(size_t)tok * 512 + c] = siluf(acc);
    }
  }
  if (lane < 8) {
    const float x = cr[1184 + lane] + w.dtb;
    const float sp = x > 20.f ? x : log1pf(expf(x));
    p.dtb[(size_t)tok * 8 + lane] = sp;
  }
}

DI void prep_tile(CP& p, int l, int ti, char* smem) {
  const int tid = opaque_tid(), wave = tid >> 6;
  int base, t0, T;
  if (ti < 256) { base = (ti >> 4) * 256; t0 = (ti & 15) * 16; T = 256; }
  else { const int j = ti - 256; base = NCTX + (j >> 7) * 2048; t0 = (j & 127) * 16; T = 2048; }
  LAS float* sr = (LAS float*)smem;
  const int lane = tid & 63;
  PrepW pw;
  prep_load_w(p, l, lane, pw);
  __syncthreads();
  u32x4 stg[6];
#pragma unroll
  for (int i = 0; i < 6; ++i) {
    const int idx = tid + i * 512;
    const int row = idx / 149, c8 = idx - row * 149;
    const int t = t0 - 2 + row;
    stg[i] = (u32x4){0u, 0u, 0u, 0u};
    if (idx < 2980 && t >= 0 && t < T) stg[i] = *(const u32x4*)(p.comb + (size_t)(base + t) * INW + c8 * 8);
  }
#pragma unroll
  for (int i = 0; i < 6; ++i) {
    const int idx = tid + i * 512;
    const int row = idx / 149, c8 = idx - row * 149;
    if (idx < 2980) {
      f32x4 lo, hi;
      lo[0] = __uint_as_float(stg[i][0] << 16); lo[1] = __uint_as_float(stg[i][0] & 0xffff0000u);
      lo[2] = __uint_as_float(stg[i][1] << 16); lo[3] = __uint_as_float(stg[i][1] & 0xffff0000u);
      hi[0] = __uint_as_float(stg[i][2] << 16); hi[1] = __uint_as_float(stg[i][2] & 0xffff0000u);
      hi[2] = __uint_as_float(stg[i][3] << 16); hi[3] = __uint_as_float(stg[i][3] & 0xffff0000u);
      *(LAS f32x4*)(sr + row * PSTR + c8 * 8) = lo;
      *(LAS f32x4*)(sr + row * PSTR + c8 * 8 + 4) = hi;
    }
  }
  __syncthreads();
#pragma unroll
  for (int i = 0; i < 2; ++i) {
    const int tt = wave * 2 + i;
    prep_row(p, l, base + t0 + tt, sr + (tt + 2) * PSTR, pw, lane);
  }
}

DI void cm_tile(CP& p, int l, int ti, char* smem) {
  const int tid = opaque_tid(), lane = tid & 63, wave = tid >> 6;
  int base, t0, T;
  if (ti < 128) { base = (ti >> 3) * 256; t0 = (ti & 7) * 32; T = 256; }
  else { const int j = ti - 128; base = NCTX + (j >> 6) * 2048; t0 = (j & 63) * 32; T = 2048; }
  LAS float* sg = (LAS float*)smem;
  LAS float* so = sg + 62 * 256;
  const int c = tid & 255, half = tid >> 8;
  float w[31];
#pragma unroll
  for (int j = 0; j < 31; ++j) w[j] = p.cm_conv_w[(size_t)(l * 31 + j) * 256 + c];
  const float bias = p.cm_conv_b[l * 256 + c];
  __syncthreads();
  {
    u32x4 ra[4], rb[4];
#pragma unroll
    for (int i = 0; i < 4; ++i) {
      const int idx = tid + i * 512;
      const int r = idx >> 5, c8 = idx & 31;
      const int t = t0 - 15 + r;
      ra[i] = (u32x4){0u, 0u, 0u, 0u}; rb[i] = (u32x4){0u, 0u, 0u, 0u};
      if (idx < 62 * 32 && t >= 0 && t < T) {
        const u16* cr = p.comb + (size_t)(base + t) * INW;
        ra[i] = *(const u32x4*)(cr + 1192 + c8 * 8);
        rb[i] = *(const u32x4*)(cr + 1448 + c8 * 8);
      }
    }
#pragma unroll
    for (int i = 0; i < 4; ++i) {
      const int idx = tid + i * 512;
      const int r = idx >> 5, c8 = idx & 31;
      if (idx < 62 * 32) {
        f32x4 lo, hi;
#pragma unroll
        for (int q = 0; q < 2; ++q) {
          lo[2 * q] = __uint_as_float(ra[i][q] << 16) * sigmoidf(__uint_as_float(rb[i][q] << 16));
          lo[2 * q + 1] = __uint_as_float(ra[i][q] & 0xffff0000u) * sigmoidf(__uint_as_float(rb[i][q] & 0xffff0000u));
          hi[2 * q] = __uint_as_float(ra[i][q + 2] << 16) * sigmoidf(__uint_as_float(rb[i][q + 2] << 16));
          hi[2 * q + 1] = __uint_as_float(ra[i][q + 2] & 0xffff0000u) * sigmoidf(__uint_as_float(rb[i][q + 2] & 0xffff0000u));
        }
        *(LAS f32x4*)(sg + r * 256 + c8 * 8) = lo;
        *(LAS f32x4*)(sg + r * 256 + c8 * 8 + 4) = hi;
      }
    }
  }
  __syncthreads();
#pragma unroll 1
  for (int t4 = 0; t4 < 4; ++t4) {
    const int tb = half * 16 + t4 * 4;
    float a0 = bias, a1 = bias, a2 = bias, a3 = bias;
#pragma unroll
    for (int j = 0; j < 34; ++j) {
      const float x = sg[(tb + j) * 256 + c];
      if (j < 31) a0 += w[j] * x;
      if (j >= 1 && j < 32) a1 += w[j - 1] * x;
      if (j >= 2 && j < 33) a2 += w[j - 2] * x;
      if (j >= 3) a3 += w[j - 3] * x;
    }
    so[tb * 256 + c] = a0;
    so[(tb + 1) * 256 + c] = a1;
    so[(tb + 2) * 256 + c] = a2;
    so[(tb + 3) * 256 + c] = a3;
  }
  __syncthreads();
  {
    float lg[4], lb[4];
#pragma unroll
    for (int i = 0; i < 4; ++i) { lg[i] = p.cm_ln_g[l * 256 + lane + 64 * i]; lb[i] = p.cm_ln_b[l * 256 + lane + 64 * i]; }
#pragma unroll
    for (int tt = 0; tt < 4; ++tt) {
      const int t = wave * 4 + tt;
      float v[4];
      float sm = 0.f;
#pragma unroll
      for (int i = 0; i < 4; ++i) { v[i] = so[t * 256 + lane + 64 * i]; sm += v[i]; }
      const float mean = wave_sum(sm) * (1.f / 256.f);
      float q = 0.f;
#pragma unroll
      for (int i = 0; i < 4; ++i) { const float d = v[i] - mean; q += d * d; }
      const float var = wave_sum(q) * (1.f / 256.f);
      const float rstd = rsqrtf(var + 1e-5f);
#pragma unroll
      for (int i = 0; i < 4; ++i) {
        const int cc = lane + 64 * i;
        float y = (v[i] - mean) * rstd * lg[i] + lb[i];
        y = siluf(y);
        p.hb[(size_t)(base + t0 + t) * 1024 + 768 + cc] = f2bf(y);
      }
    }
  }
}

DI void ssd_item(CP& p, int l, int seq, int h, int dir, char* smem) {
  const int tid = opaque_tid(), lane = tid & 63, wave = tid >> 6, lr = lane & 15, g = lane >> 4;
  const int rt = wave & 3, ch = wave >> 2;
  const bool lat = seq >= 16;
  const int b = lat ? seq - 16 : seq;
  const int T = lat ? 2048 : 256;
  const int qbase = lat ? NCTX + b * 2048 : b * 256;
  u16* sC = (u16*)smem;
  u16* sB = sC + 64 * 72;
  u16* sBt = sB + 64 * 72;
  u16* sXt = sBt + 64 * 72;
  u16* sXw = sXt + 64 * 72;
  u16* sM = sXw + 64 * 72;
  u16* sH = sM + 64 * 72;
  float* sdtA = (float*)(sH + 64 * 72);
  float* sacsA = sdtA + 2048;
  const float Aneg = -expf(p.ssd_a_log[(l * 2 + dir) * 4 + h]);
  const int grp = h >> 1;
  f32x4 hacc[2];
  if (lat) {
    const float* src = p.state_ssd + ((size_t)(((b * 4 + l) * 2 + dir) * 4 + h)) * 4096;
#pragma unroll
    for (int n2 = 0; n2 < 2; ++n2)
#pragma unroll
      for (int i = 0; i < 4; ++i) hacc[n2][i] = src[(rt * 16 + g * 4 + i) * 64 + (ch * 2 + n2) * 16 + lr];
  } else {
#pragma unroll
    for (int n2 = 0; n2 < 2; ++n2) hacc[n2] = (f32x4){0.f, 0.f, 0.f, 0.f};
  }
  __syncthreads();
#pragma unroll
  for (int n2 = 0; n2 < 2; ++n2)
#pragma unroll
    for (int i = 0; i < 4; ++i) sH[(rt * 16 + g * 4 + i) * 72 + (ch * 2 + n2) * 16 + lr] = f2bf(hacc[n2][i]);
  const int nch = T >> 6;
  {
    float dv[4];
#pragma unroll
    for (int i = 0; i < 4; ++i) {
      const int cq = wave + 8 * i;
      dv[i] = cq < nch ? p.dtb[(size_t)(qbase + cq * 64 + lane) * 8 + dir * 4 + h] : 0.f;
    }
#pragma unroll
    for (int i = 0; i < 4; ++i) {
      const int cq = wave + 8 * i;
      float sc = dv[i] * Aneg;
      if (!dir) {
#pragma unroll
        for (int o = 1; o < 64; o <<= 1) { const float tv = __shfl_up(sc, o); if (lane >= o) sc += tv; }
      } else {
#pragma unroll
        for (int o = 1; o < 64; o <<= 1) { const float tv = __shfl_down(sc, o); if (lane + o < 64) sc += tv; }
      }
      if (cq < nch) { sdtA[cq * 64 + lane] = dv[i]; sacsA[cq * 64 + lane] = sc; }
    }
  }
  const int r = tid >> 3, cc = (tid & 7) * 8;
  f32x4 xv[2], bv[2], cv[2];
  {
    const int c0 = dir ? nch - 1 : 0;
    const float* rowp = p.xbc + (size_t)(qbase + c0 * 64 + r) * 512;
#pragma unroll
    for (int i = 0; i < 2; ++i) {
      xv[i] = *(const f32x4*)(rowp + h * 64 + cc + i * 4);
      bv[i] = *(const f32x4*)(rowp + 256 + grp * 64 + cc + i * 4);
      cv[i] = *(const f32x4*)(rowp + 384 + grp * 64 + cc + i * 4);
    }
  }
  __syncthreads();
#pragma unroll 1
  for (int ci = 0; ci < nch; ++ci) {
    const int c = dir ? nch - 1 - ci : ci;
    const int tok0 = qbase + c * 64;
    const float* sdt = sdtA + c * 64;
    const float* sacs = sacsA + c * 64;
    const float total = dir ? sacs[0] : sacs[63];
    const float wr = __expf(total - sacs[r]) * sdt[r];
    {
      u32x4 c0 = {pack2(cv[0][0], cv[0][1]), pack2(cv[0][2], cv[0][3]), pack2(cv[1][0], cv[1][1]), pack2(cv[1][2], cv[1][3])};
      *(u32x4*)(sC + r * 72 + cc) = c0;
      u32x4 b0 = {pack2(bv[0][0], bv[0][1]), pack2(bv[0][2], bv[0][3]), pack2(bv[1][0], bv[1][1]), pack2(bv[1][2], bv[1][3])};
      *(u32x4*)(sB + r * 72 + cc) = b0;
#pragma unroll
      for (int i = 0; i < 2; ++i)
#pragma unroll
        for (int j = 0; j < 4; ++j) {
          const int e = cc + i * 4 + j;
          sBt[e * 72 + r] = f2bf(bv[i][j]);
          sXt[e * 72 + r] = f2bf(xv[i][j]);
          sXw[e * 72 + r] = f2bf(xv[i][j] * wr);
        }
    }
    if (ci + 1 < nch) {
      const int cn = dir ? nch - 2 - ci : ci + 1;
      const float* rowp = p.xbc + (size_t)(qbase + cn * 64 + r) * 512;
#pragma unroll
      for (int i = 0; i < 2; ++i) {
        xv[i] = *(const f32x4*)(rowp + h * 64 + cc + i * 4);
        bv[i] = *(const f32x4*)(rowp + 256 + grp * 64 + cc + i * 4);
        cv[i] = *(const f32x4*)(rowp + 384 + grp * 64 + cc + i * 4);
      }
    }
    __syncthreads();
    f32x4 gacc[2];
#pragma unroll
    for (int s2 = 0; s2 < 2; ++s2) gacc[s2] = (f32x4){0.f, 0.f, 0.f, 0.f};
#pragma unroll
    for (int ks = 0; ks < 2; ++ks) {
      const bf16x8 cf = *(const bf16x8*)(sC + (rt * 16 + lr) * 72 + ks * 32 + g * 8);
#pragma unroll
      for (int s2 = 0; s2 < 2; ++s2) {
        const bf16x8 bfr = *(const bf16x8*)(sB + ((ch * 2 + s2) * 16 + lr) * 72 + ks * 32 + g * 8);
        gacc[s2] = MFMA(cf, bfr, gacc[s2]);
      }
    }
    int opq;
    asm volatile("v_mov_b32 %0, 0" : "=v"(opq));
#pragma unroll
    for (int s2 = 0; s2 < 2; ++s2) {
      const int si = (ch * 2 + s2) * 16 + lr + opq;
      const float acs_s = sacs[si], dt_s = sdt[si];
#pragma unroll
      for (int i = 0; i < 4; ++i) {
        const int li = rt * 16 + g * 4 + i;
        const float acs_l = sacs[li];
        const bool ok = dir ? (si >= li) : (si <= li);
        const float mval = ok ? gacc[s2][i] * __expf(acs_l - acs_s) * dt_s : 0.f;
        sM[li * 72 + si] = f2bf(mval);
      }
    }
    __syncthreads();
    f32x4 yd[2], yo[2];
#pragma unroll
    for (int p2 = 0; p2 < 2; ++p2) { yd[p2] = (f32x4){0.f, 0.f, 0.f, 0.f}; yo[p2] = (f32x4){0.f, 0.f, 0.f, 0.f}; }
#pragma unroll
    for (int ks = 0; ks < 2; ++ks) {
      const bf16x8 mf = *(const bf16x8*)(sM + (rt * 16 + lr) * 72 + ks * 32 + g * 8);
      const bf16x8 cf = *(const bf16x8*)(sC + (rt * 16 + lr) * 72 + ks * 32 + g * 8);
#pragma unroll
      for (int p2 = 0; p2 < 2; ++p2) {
        const bf16x8 xf = *(const bf16x8*)(sXt + ((ch * 2 + p2) * 16 + lr) * 72 + ks * 32 + g * 8);
        const bf16x8 hf = *(const bf16x8*)(sH + ((ch * 2 + p2) * 16 + lr) * 72 + ks * 32 + g * 8);
        yd[p2] = MFMA(mf, xf, yd[p2]);
        yo[p2] = MFMA(cf, hf, yo[p2]);
      }
    }
#pragma unroll
    for (int i = 0; i < 4; ++i) {
      const int li = rt * 16 + g * 4 + i;
      const float e = __expf(sacs[li]);
      float* yrow = p.ydir + ((size_t)dir * NTOK + tok0 + li) * 256 + h * 64 + ch * 32 + lr;
#pragma unroll
      for (int p2 = 0; p2 < 2; ++p2) yrow[p2 * 16] = yd[p2][i] + e * yo[p2][i];
    }
    f32x4 hn[2];
#pragma unroll
    for (int n2 = 0; n2 < 2; ++n2) hn[n2] = (f32x4){0.f, 0.f, 0.f, 0.f};
#pragma unroll
    for (int ks = 0; ks < 2; ++ks) {
      const bf16x8 xw = *(const bf16x8*)(sXw + (rt * 16 + lr) * 72 + ks * 32 + g * 8);
#pragma unroll
      for (int n2 = 0; n2 < 2; ++n2) {
        const bf16x8 bt = *(const bf16x8*)(sBt + ((ch * 2 + n2) * 16 + lr) * 72 + ks * 32 + g * 8);
        hn[n2] = MFMA(xw, bt, hn[n2]);
      }
    }
    const float et = __expf(total);
#pragma unroll
    for (int n2 = 0; n2 < 2; ++n2) hacc[n2] = hacc[n2] * et + hn[n2];
    __syncthreads();
#pragma unroll
    for (int n2 = 0; n2 < 2; ++n2)
#pragma unroll
      for (int i = 0; i < 4; ++i) sH[(rt * 16 + g * 4 + i) * 72 + (ch * 2 + n2) * 16 + lr] = f2bf(hacc[n2][i]);
  }
  if (!lat) {
    float* dst = p.out + O_SSD + ((size_t)(((b * 4 + l) * 2 + dir) * 4 + h)) * 4096;
#pragma unroll
    for (int n2 = 0; n2 < 2; ++n2)
#pragma unroll
      for (int i = 0; i < 4; ++i) dst[(rt * 16 + g * 4 + i) * 64 + (ch * 2 + n2) * 16 + lr] = hacc[n2][i];
  }
}

DI void ssd_final_rows4(CP& p, int l, int tok0) {
  const int lane = opaque_tid() & 63;
  const int c = lane * 4, h = c >> 6;
  const float dd = p.ssd_d[(l * 2 + 0) * 4 + h] + p.ssd_d[(l * 2 + 1) * 4 + h];
  const f32x4 gg = *(const f32x4*)(p.ssd_norm_g + l * 256 + c);
  f32x4 y0[4], y1[4], xs[4];
  u32x2 zr[4];
#pragma unroll
  for (int a = 0; a < 4; ++a) {
    const int tok = tok0 + a;
    y0[a] = *(const f32x4*)(p.ydir + (size_t)tok * 256 + c);
    y1[a] = *(const f32x4*)(p.ydir + ((size_t)NTOK + tok) * 256 + c);
    xs[a] = *(const f32x4*)(p.xbc + (size_t)tok * 512 + c);
    zr[a] = *(const u32x2*)(p.comb + (size_t)tok * INW + 416 + c);
  }
#pragma unroll
  for (int a = 0; a < 4; ++a) {
    const int tok = tok0 + a;
    const f32x4 z = {__uint_as_float(zr[a][0] << 16), __uint_as_float(zr[a][0] & 0xffff0000u), __uint_as_float(zr[a][1] << 16),
                     __uint_as_float(zr[a][1] & 0xffff0000u)};
    f32x4 v;
    float ss = 0.f;
#pragma unroll
    for (int j = 0; j < 4; ++j) {
      v[j] = (y0[a][j] + y1[a][j] + dd * xs[a][j]) * siluf(z[j]);
      ss += v[j] * v[j];
    }
    ss = wave_sum(ss);
    const float rstd = rsqrtf(ss * (1.f / 256.f) + 1e-6f);
    u32x2 pk = {pack2(v[0] * rstd * gg[0], v[1] * rstd * gg[1]), pack2(v[2] * rstd * gg[2], v[3] * rstd * gg[3])};
    *(u32x2*)(p.hb + (size_t)tok * 1024 + 512 + c) = pk;
  }
}

DI void attn_item(CP& p, int seq, int h, int qb, char* smem) {
  const int tid = opaque_tid(), lane = tid & 63, wave = tid >> 6, lr = lane & 15, g = lane >> 4;
  const bool lat = seq >= 16;
  int Tk, kvbase, qtok0;
  if (!lat) { Tk = 256; kvbase = seq * 256; qtok0 = seq * 256; }
  else { const int b = seq - 16; Tk = 2304; kvbase = NCTX + b * 2304; qtok0 = NCTX + b * 2048 + qb * 256; }
  LAS u16* sKb = (LAS u16*)smem;
  LAS u16* sVb = sKb + 256 * 104;
  bf16x8 qf[2][3];
#pragma unroll
  for (int qt = 0; qt < 2; ++qt) {
    const int tok = qtok0 + wave * 32 + qt * 16 + lr;
#pragma unroll
    for (int ks = 0; ks < 3; ++ks) qf[qt][ks] = *(const bf16x8*)(p.qbuf + (size_t)tok * 768 + h * 96 + ks * 32 + g * 8);
    if (lat) {
      const int t = (tok - NCTX) & 2047;
      const int axis = g >> 1, half = g & 1;
      const float* cs = p.ropec + t * 16 + axis * 8;
      const float* sn = p.ropes + t * 16 + axis * 8;
      bf16x8 r;
#pragma unroll
      for (int j = 0; j < 8; ++j) {
        const float x = bf2f((u16)qf[qt][2][j]);
        const float pr = __shfl_xor(x, 16);
        const float c = cs[j], s = sn[j];
        const float o = half ? x * c + pr * s : x * c - pr * s;
        r[j] = (short)f2bf(o);
      }
      qf[qt][2] = r;
    }
  }
  f32x4 o[2][4];
#pragma unroll
  for (int qt = 0; qt < 2; ++qt)
#pragma unroll
    for (int dt = 0; dt < 4; ++dt) o[qt][dt] = (f32x4){0.f, 0.f, 0.f, 0.f};
  float mrow[2] = {-1e30f, -1e30f}, lrow[2] = {0.f, 0.f};
  const float cs2 = 0.10206207261596574f * 1.4426950408889634f;
  const int nst = Tk >> 8;
  const u16* gk = p.knope + (size_t)(kvbase + (tid >> 3)) * 512 + h * 64 + (tid & 7) * 8;
  const u16* gr = p.krope + (size_t)(kvbase + (tid >> 2)) * 32 + (tid & 3) * 8;
  const u16* gv = p.vt + (size_t)512 * kvbase + (size_t)(h * 64 + (tid >> 5)) * Tk + (tid & 31) * 8;
  u32x4 rk[4], rr[2], rv[4];
#pragma unroll
  for (int i = 0; i < 4; ++i) { rk[i] = *(const u32x4*)(gk + (size_t)i * 64 * 512); rv[i] = *(const u32x4*)(gv + (size_t)i * 16 * Tk); }
#pragma unroll
  for (int i = 0; i < 2; ++i) rr[i] = *(const u32x4*)(gr + (size_t)i * 128 * 32);
#pragma unroll 1
  for (int st = 0; st < nst; ++st) {
    __syncthreads();
#pragma unroll
    for (int i = 0; i < 4; ++i) {
      *(LAS u32x4*)(sKb + ((tid >> 3) + i * 64) * 104 + (tid & 7) * 8) = rk[i];
      *(LAS u32x4*)(sVb + ((tid >> 5) + i * 16) * 264 + (tid & 31) * 8) = rv[i];
    }
#pragma unroll
    for (int i = 0; i < 2; ++i) *(LAS u32x4*)(sKb + ((tid >> 2) + i * 128) * 104 + 64 + (tid & 3) * 8) = rr[i];
    __syncthreads();
    if (st + 1 < nst) {
      const size_t ko = (size_t)(st + 1) * 256;
#pragma unroll
      for (int i = 0; i < 4; ++i) { rk[i] = *(const u32x4*)(gk + (ko + i * 64) * 512); rv[i] = *(const u32x4*)(gv + (size_t)i * 16 * Tk + ko); }
#pragma unroll
      for (int i = 0; i < 2; ++i) rr[i] = *(const u32x4*)(gr + (ko + i * 128) * 32);
    }
#pragma unroll 1
    for (int kt = 0; kt < 4; ++kt) {
      const LAS u16* sK = sKb + kt * 64 * 104;
      const LAS u16* sV = sVb + kt * 64;
      f32x4 s[4][2];
#pragma unroll
      for (int k4 = 0; k4 < 4; ++k4) {
        s[k4][0] = (f32x4){0.f, 0.f, 0.f, 0.f};
        s[k4][1] = (f32x4){0.f, 0.f, 0.f, 0.f};
#pragma unroll
        for (int ks = 0; ks < 3; ++ks) {
          const bf16x8 kf = *(const LAS bf16x8*)(sK + (k4 * 16 + lr) * 104 + ks * 32 + g * 8);
          s[k4][0] = MFMA(kf, qf[0][ks], s[k4][0]);
          s[k4][1] = MFMA(kf, qf[1][ks], s[k4][1]);
        }
      }
      bf16x8 pf[2][2];
#pragma unroll
      for (int qt = 0; qt < 2; ++qt) {
        float mx = -1e30f;
#pragma unroll
        for (int k4 = 0; k4 < 4; ++k4)
#pragma unroll
          for (int i = 0; i < 4; ++i) mx = fmaxf(mx, s[k4][qt][i]);
        mx = xrow16_max(mx);
        const float mnew = fmaxf(mrow[qt], mx * cs2);
        const float alpha = __builtin_amdgcn_exp2f(mrow[qt] - mnew);
        mrow[qt] = mnew;
        float psum = 0.f;
        float pv[4][4];
#pragma unroll
        for (int k4 = 0; k4 < 4; ++k4)
#pragma unroll
          for (int i = 0; i < 4; ++i) {
            pv[k4][i] = __builtin_amdgcn_exp2f(s[k4][qt][i] * cs2 - mnew);
            psum += pv[k4][i];
          }
        lrow[qt] = lrow[qt] * alpha + psum;
        if (__builtin_amdgcn_ballot_w64(alpha != 1.f) != 0ull) {
#pragma unroll
          for (int dt = 0; dt < 4; ++dt) o[qt][dt] *= alpha;
        }
#pragma unroll
        for (int s2 = 0; s2 < 2; ++s2) {
          u32x4 pk = {pack2(pv[2 * s2][0], pv[2 * s2][1]), pack2(pv[2 * s2][2], pv[2 * s2][3]),
                      pack2(pv[2 * s2 + 1][0], pv[2 * s2 + 1][1]), pack2(pv[2 * s2 + 1][2], pv[2 * s2 + 1][3])};
          pf[qt][s2] = __builtin_bit_cast(bf16x8, pk);
        }
      }
#pragma unroll
      for (int s2 = 0; s2 < 2; ++s2)
#pragma unroll
        for (int dt = 0; dt < 4; ++dt) {
          const s16x4 lo = *(const LAS s16x4*)(sV + (dt * 16 + lr) * 264 + s2 * 32 + g * 4);
          const s16x4 hi = *(const LAS s16x4*)(sV + (dt * 16 + lr) * 264 + s2 * 32 + 16 + g * 4);
          const bf16x8 vf = __builtin_shufflevector(lo, hi, 0, 1, 2, 3, 4, 5, 6, 7);
          o[0][dt] = MFMA(vf, pf[0][s2], o[0][dt]);
          o[1][dt] = MFMA(vf, pf[1][s2], o[1][dt]);
        }
    }
  }
#pragma unroll
  for (int qt = 0; qt < 2; ++qt) {
    float lsum = lrow[qt];
    lsum = xrow16_sum(lsum);
    const float inv = frcp(lsum);
    const int tok = qtok0 + wave * 32 + qt * 16 + lr;
#pragma unroll
    for (int dt = 0; dt < 4; ++dt) {
      u32x2 pk = {pack2(o[qt][dt][0] * inv, o[qt][dt][1] * inv), pack2(o[qt][dt][2] * inv, o[qt][dt][3] * inv)};
      *(u32x2*)(p.hb + (size_t)tok * 1024 + h * 64 + dt * 16 + g * 4) = pk;
    }
  }
}

DI int next_item(unsigned* ctr, int* slot) {
  __syncthreads();
  if (threadIdx.x == 0) *slot = (int)atomicAdd(ctr, 1u);
  __syncthreads();
  return *slot;
}

DI void forward(char* smem) {
  const int G = gridDim.x, bid = blockIdx.x;
  const int wave = threadIdx.x >> 6;
  int* slot = (int*)(smem + LDS_MAIN + 32);
  int ph = 0;
  XcdBarrier xb;
  {
    unsigned* stw = (unsigned*)(smem + LDS_MAIN);
    if (threadIdx.x == 0) { stw[0] = 0u; stw[1] = 0u; }
    __syncthreads();
    CP& p0 = get_params();
    xb = xcd_barrier_post(p0.bar, (volatile LAS unsigned*)stw);
    (void)xb;
  }
#define PH_BEGIN { CP& p = get_params();
#if USE_CG_SYNC
#define PH_END } { if (ph == 0) cg::this_grid().sync(); else { XcdBarrier xq; xq.bar = nullptr; xq.x = 0u; xq.st = (volatile LAS unsigned*)(smem + LDS_MAIN); xcd_barrier(xq); } } ++ph;
#else
#define PH_END } { XcdBarrier xq; xq.bar = nullptr; xq.x = 0u; xq.st = (volatile LAS unsigned*)(smem + LDS_MAIN); xcd_barrier(xq); } ++ph;
#endif

  PH_BEGIN
    phase0(p, smem);
  PH_END

#pragma unroll 1
  for (int l = 0; l < 4; ++l) {
    PH_BEGIN
      norm_phase(p, l, 0);
    PH_END
    PH_BEGIN
      gemm_phase<E_COMB, 192>(p, l, p.hb, p.wt_in + (size_t)l * INWP * 1024, 1024, 64, 7, 0, bid, G, 64 * 7, false, smem);
    PH_END
    PH_BEGIN
      for (int t = bid; t < 768 + 128; t += G) {
        if (t < 768) prep_tile(p, l, t, smem);
        else prep_cache_row(p, l, NTOK + (t - 768) * 8 + wave);
      }
    PH_END
    PH_BEGIN
      for (;;) {
        const int it = next_item(p.ctr + ph, slot);
        if (it >= 160 + 384 + 208 + 144) break;
        if (it < 32 || (it >= 416 && it < 544)) {
          const int j = it < 32 ? it : it - 416;
          ssd_item(p, l, (it < 32 ? 16 : 0) + (j >> 3), (j >> 1) & 3, j & 1, smem);
        } else if (it < 416) {
          cm_tile(p, l, it - 32, smem);
        } else if (it < 752) {
          const int t = it - 544;
          gemm_phase<E_KV, 256>(p, l, p.ckvn, p.wt_ukv + (size_t)l * 1024 * 128, 128, 52, 4, 0, t, 1 << 20, 208, false, smem);
        } else {
          const int t = it - 752;
          gemm_phase<E_Q, 256>(p, l, p.qn, p.wt_uq + (size_t)l * 768 * 256, 256, 48, 3, 0, t, 1 << 20, 144, false, smem);
        }
      }
      if (l < 3) conv_fill(p, l + 1, 0, 5792, p.ctr + 128 + ph, slot, smem);
    PH_END
    PH_BEGIN
      for (;;) {
        const int it = next_item(p.ctr + ph, slot);
        if (it >= 384 + 384) break;
        if (it < 384) {
          int sq, hh, qb;
          if (it < 256) { sq = 16 + (it >> 6); hh = (it >> 3) & 7; qb = it & 7; }
          else { const int j = it - 256; sq = j >> 3; hh = j & 7; qb = 0; }
          attn_item(p, sq, hh, qb, smem);
        } else {
          const int t0 = (it - 384) * 32 + wave * 4;
          ssd_final_rows4(p, l, t0);
        }
      }
    PH_END
    PH_BEGIN
      gemm_phase<E_RES, 192>(p, l, p.hb, p.wt_out + (size_t)l * 1024 * 1024, 1024, 64, 4, 2048, bid, G, 64 * 4, false, smem);
    PH_END
    PH_BEGIN
      norm_phase(p, l, 1);
    PH_END
    PH_BEGIN
      gemm_phase<E_SWIGLU, 192>(p, l, p.hb, p.wt_gu + (size_t)l * 2 * DFF * 1024, 1024, 64, 22, 0, bid, G, 64 * 22, false, smem);
    PH_END
    PH_BEGIN
      gemm_phase<E_RES, 192>(p, l, p.act, p.wt_down + (size_t)l * 1024 * DFF, DFF, 64, 4, 5120, bid, G, 64 * 4, false, smem);
    PH_END
  }
  { CP& p = get_params(); final_norm(p); }
}

extern __shared__ __attribute__((aligned(1024))) char dyn_smem[];

__global__ void __launch_bounds__(NTHREADS, 2) k_mega(P p) { forward(dyn_smem); }

extern "C" void kernel_launch(void* const* d_in, const int* in_sizes, int n_in, void* d_out, int out_size, void* d_ws,
                              size_t ws_size, hipStream_t stream) {
  P p{};
  const float** fp = (const float**)&p;
  for (int i = 0; i < 31; ++i) fp[i] = (const float*)d_in[i];
  p.out = (float*)d_out;
  char* ws = (char*)d_ws;
  size_t off = 0;
  auto take = [&](size_t bytes) { char* r = ws + off; off += (bytes + 255) & ~(size_t)255; return r; };
  p.bar = (unsigned*)take(16384);
  p.ctr = (unsigned*)take(16384);
  p.wt_in = (u16*)take((size_t)4 * INWP * 1024 * 2);
  p.wt_uq = (u16*)take((size_t)4 * 768 * 256 * 2);
  p.wt_ukv = (u16*)take((size_t)4 * 1024 * 128 * 2);
  p.wt_out = (u16*)take((size_t)4 * 1024 * 1024 * 2);
  p.wt_gu = (u16*)take((size_t)4 * 2 * DFF * 1024 * 2);
  p.wt_down = (u16*)take((size_t)4 * 1024 * DFF * 2);
  p.mod = (float*)take((size_t)4 * 5 * 6144 * 4);
  p.ropec = (float*)take(2048 * 16 * 4);
  p.ropes = (float*)take(2048 * 16 * 4);
  p.hb = (u16*)take((size_t)NTOK * 1024 * 2);
  p.comb = (u16*)take((size_t)NTOK * DFF * 2);
  p.act = p.comb;
  p.qn = (u16*)take((size_t)NTOK * 256 * 2);
  p.ckvn = (u16*)take((size_t)KVROWS * 128 * 2);
  p.qbuf = (u16*)take((size_t)NTOK * 768 * 2);
  p.knope = (u16*)take((size_t)KVROWS * 512 * 2);
  p.vt = (u16*)take((size_t)KVROWS * 512 * 2);
  p.krope = (u16*)take((size_t)KVROWS * 32 * 2);
  p.xbc = (float*)take((size_t)NTOK * 512 * 4);
  p.dtb = (float*)take((size_t)NTOK * 8 * 4);
  p.ydir = (float*)take((size_t)2 * NTOK * 256 * 4);
  if (off > ws_size) { fprintf(stderr, "workspace too small: need %zu have %zu\n", off, ws_size); return; }

  static int grid_blocks = 0;
  if (!grid_blocks) {
    int dev = 0, cus = 0, per_cu = 0;
    (void)hipGetDevice(&dev);
    (void)hipDeviceGetAttribute(&cus, hipDeviceAttributeMultiprocessorCount, dev);
    (void)hipFuncSetAttribute((const void*)k_mega, hipFuncAttributeMaxDynamicSharedMemorySize, LDS_BYTES);
    (void)hipOccupancyMaxActiveBlocksPerMultiprocessor(&per_cu, (const void*)k_mega, NTHREADS, LDS_BYTES);
    if (per_cu > 1) per_cu = 1;
    if (per_cu < 1) per_cu = 1;
    grid_blocks = cus * per_cu;
  }
  (void)hipMemsetAsync(d_ws, 0, 32768, stream);
  void* args[] = {&p};
  hipError_t e = hipLaunchCooperativeKernel((const void*)k_mega, dim3(grid_blocks), dim3(NTHREADS), args, LDS_BYTES, stream);
  if (e != hipSuccess) fprintf(stderr, "cooperative launch failed: %s (grid %d)\n", hipGetErrorString(e), grid_blocks);
}
```

```cpp
#include <hip/hip_runtime.h>
#include <hip/hip_cooperative_groups.h>
#include <stdint.h>
#include <stdio.h>
namespace cg = cooperative_groups;

#ifndef USE_CG_SYNC
#define USE_CG_SYNC 0
#endif

#define DI __device__ __forceinline__
#define LAS __attribute__((address_space(3)))
typedef unsigned short u16;
typedef __bf16 bf2_t __attribute__((ext_vector_type(2)));
typedef float f2_t __attribute__((ext_vector_type(2)));
using bf16x8 = __attribute__((ext_vector_type(8))) short;
using s16x4 = __attribute__((ext_vector_type(4))) short;
using f32x4 = __attribute__((ext_vector_type(4))) float;
using u32x4 = __attribute__((ext_vector_type(4))) unsigned;
using u32x2 = __attribute__((ext_vector_type(2))) unsigned;

#define MFMA(a, b, c) __builtin_amdgcn_mfma_f32_16x16x32_bf16((a), (b), (c), 0, 0, 0)

constexpr int NTOK = 12288, NCTX = 4096, KVROWS = 13312;
constexpr int INW = 1704, INWP = 1792, DFF = 2816;
constexpr size_t O_CKV = 12582912, O_KR = 14680064, O_SSD = 15204352;
constexpr int LDS_MAIN = 131072;
constexpr int LDS_BYTES = LDS_MAIN + 64;
constexpr int NTHREADS = 512;

struct P {
  const float *x_prompt, *x_sample, *c, *cache_ckv, *cache_krope, *state_ssd, *c_ctx, *w_ada, *b_ada, *g_mix, *w_in,
      *g_q, *w_uq, *g_kv, *w_ukv, *ssd_conv_w, *ssd_conv_b, *ssd_dt_bias, *ssd_a_log, *ssd_d, *ssd_norm_g, *cm_conv_w,
      *cm_conv_b, *cm_ln_g, *cm_ln_b, *w_out, *g_ffn, *w_gate, *w_up, *w_down, *g_final;
  float* out;
  unsigned* bar;
  unsigned* ctr;
  u16 *wt_in, *wt_uq, *wt_ukv, *wt_out, *wt_gu, *wt_down;
  float *mod, *ropec, *ropes;
  u16* hb;
  u16* comb;
  u16* act;
  u16 *qn, *ckvn, *qbuf, *knope, *vt, *krope;
  float *xbc, *dtb, *ydir;
};

typedef const __attribute__((address_space(4))) P CP;
DI CP& get_params() {
  unsigned long long kp = (unsigned long long)__builtin_amdgcn_kernarg_segment_ptr();
  asm volatile("" : "+s"(kp));
  return *(CP*)kp;
}
DI int opaque_tid() { int t = threadIdx.x; asm volatile("" : "+v"(t)); return t; }

DI unsigned pack2(float a, float b) {
  f2_t v = {a, b};
  bf2_t r = __builtin_convertvector(v, bf2_t);
  return __builtin_bit_cast(unsigned, r);
}
DI u16 f2bf(float a) { return (u16)(pack2(a, 0.f) & 0xffffu); }
DI float bf2f(u16 v) { return __uint_as_float(((unsigned)v) << 16); }
DI float frcp(float x) { return __builtin_amdgcn_rcpf(x); }
DI float xrow16_max(float x) {
  auto s = __builtin_amdgcn_permlane16_swap(__float_as_uint(x), __float_as_uint(x), false, false);
  x = fmaxf(__uint_as_float(s[0]), __uint_as_float(s[1]));
  auto t = __builtin_amdgcn_permlane32_swap(__float_as_uint(x), __float_as_uint(x), false, false);
  return fmaxf(__uint_as_float(t[0]), __uint_as_float(t[1]));
}
DI float xrow16_sum(float x) {
  auto s = __builtin_amdgcn_permlane16_swap(__float_as_uint(x), __float_as_uint(x), false, false);
  x = __uint_as_float(s[0]) + __uint_as_float(s[1]);
  auto t = __builtin_amdgcn_permlane32_swap(__float_as_uint(x), __float_as_uint(x), false, false);
  return __uint_as_float(t[0]) + __uint_as_float(t[1]);
}
template <int CTRL> DI float dppf(float x) {
  return __builtin_bit_cast(float, __builtin_amdgcn_mov_dpp(__builtin_bit_cast(int, x), CTRL, 0xf, 0xf, true));
}
DI float wave_sum(float x) {
  x += dppf<0xB1>(x);
  x += dppf<0x4E>(x);
  x += dppf<0x141>(x);
  x += dppf<0x128>(x);
  return xrow16_sum(x);
}
DI float sigmoidf(float x) { return frcp(1.f + __expf(-x)); }
DI float siluf(float x) { return x * frcp(1.f + __expf(-x)); }

#define XB_TMO      128
#define XB_XCNT(j)  (256  + 64 * (j))
#define XB_XSUB(j)  (1280 + 64 * (j))
#define XB_XGEN(j)  (2304 + 64 * (j))
#define XB_TOP      3328
#define XB_TOPGEN   3392
#define XB_SPIN_CAP (1u << 20)
DI unsigned xb_ld(unsigned* p) { return __hip_atomic_load(p, __ATOMIC_RELAXED, __HIP_MEMORY_SCOPE_AGENT); }
DI unsigned xb_add(unsigned* p, unsigned v) { return __hip_atomic_fetch_add(p, v, __ATOMIC_RELAXED, __HIP_MEMORY_SCOPE_AGENT); }
DI unsigned xb_xcc_id() { return (unsigned)__builtin_amdgcn_s_getreg((3 << 11) | 20) & 0xFu; }
#define XB_SPIN(cond, bar) do { unsigned _sp = 0; while (cond) { __builtin_amdgcn_s_sleep(1); \
    if ((++_sp & 255u) == 0u) { if (xb_ld(&(bar)[XB_TMO])) break; if (_sp > XB_SPIN_CAP) { atomicAdd(&(bar)[XB_TMO], 1u); break; } } } } while (0)
struct XcdBarrier { unsigned* bar; unsigned x; volatile LAS unsigned* st; };
DI XcdBarrier xcd_barrier_post(unsigned* bar, volatile LAS unsigned* st) {
  XcdBarrier b; b.bar = bar; b.x = xb_xcc_id(); b.st = st;
  if (threadIdx.x == 0) (void)xb_add(&bar[XB_XCNT(b.x)], 1u);
  return b;
}
DI void xcd_barrier_complete(unsigned* bar, unsigned x, unsigned& nloc, unsigned& nx) {
  const unsigned G = gridDim.x * gridDim.y * gridDim.z;
  unsigned sum, cnt, mine, sp = 0u;
  for (;;) {
    sum = 0u; cnt = 0u; mine = 0u;
#pragma unroll
    for (unsigned j = 0; j < 16; ++j) { const unsigned c = xb_ld(&bar[XB_XCNT(j)]); sum += c; cnt += (c > 0u) ? 1u : 0u; mine = (j == x) ? c : mine; }
    if (sum == G) break;
    __builtin_amdgcn_s_sleep(1);
    if ((++sp & 255u) == 0u) { if (xb_ld(&bar[XB_TMO])) break; if (sp > XB_SPIN_CAP) { atomicAdd(&bar[XB_TMO], 1u); break; } }
  }
  nloc = mine > 0u ? mine : 1u; nx = cnt > 0u ? cnt : 1u;
}
DI void xcd_barrier(const XcdBarrier& b0) {
  asm volatile("s_waitcnt vmcnt(0)" ::: "memory");
  __syncthreads();
  if (threadIdx.x == 0) {
    XcdBarrier b; b.bar = get_params().bar; b.x = xb_xcc_id(); b.st = b0.st;
    unsigned* bar = b.bar;
    __builtin_amdgcn_s_waitcnt(0);
    unsigned nloc = b.st[0], nx = b.st[1];
    if (nloc == 0u) { xcd_barrier_complete(bar, b.x, nloc, nx); b.st[0] = nloc; b.st[1] = nx; }
    const unsigned old = xb_add(&bar[XB_XSUB(b.x)], 1u);
    const unsigned gen = old / nloc;
    if (old + 1u == (gen + 1u) * nloc) {
      __builtin_amdgcn_fence(__ATOMIC_RELEASE, "agent");
      asm volatile("s_waitcnt vmcnt(0)" ::: "memory");
      const unsigned og = xb_add(&bar[XB_TOP], 1u);
      const unsigned tg = og / nx;
      if (og + 1u == (tg + 1u) * nx) xb_add(&bar[XB_TOPGEN], 1u);
      else XB_SPIN(xb_ld(&bar[XB_TOPGEN]) == tg, bar);
      __builtin_amdgcn_fence(__ATOMIC_ACQUIRE, "agent");
      xb_add(&bar[XB_XGEN(b.x)], 1u);
      asm volatile("s_waitcnt vmcnt(0)" ::: "memory");
    } else {
      XB_SPIN(xb_ld(&bar[XB_XGEN(b.x)]) == gen, bar);
      __builtin_amdgcn_fence(__ATOMIC_ACQUIRE, "agent");
      asm volatile("s_waitcnt vmcnt(0)" ::: "memory");
    }
  }
  __syncthreads();
}

enum { E_COMB = 0, E_Q = 1, E_KV = 2, E_RES = 3, E_SWIGLU = 4 };

DI int lds_byte(int r, int c) {
  const int st = (r >> 4) * 2 + (c >> 5), ob = (r & 15) * 64 + (c & 31) * 2;
  return st * 1024 + (ob ^ (((ob >> 9) & 1) << 5));
}
DI void stage_rc(int b, int& R, int& C) {
  const int st = b >> 10, sb = b & 1023, swz = sb ^ (((sb >> 9) & 1) << 5);
  R = (st >> 1) * 16 + swz / 64;
  C = (st & 1) * 32 + (swz % 64) / 2;
}
DI void tile_rc(int t, int nM, int nN, int& pm, int& pn) {
  const int nwg = nM * nN;
  const int q = nwg / 8, r = nwg % 8, xcd = t % 8, off = t / 8;
  const int w = (xcd < r ? xcd * (q + 1) : r * (q + 1) + (xcd - r) * q) + off;
  const int nig = 8 * nN, gid = w / nig, fm = gid * 8;
  const int gsz = (nM - fm) < 8 ? (nM - fm) : 8;
  pm = fm + ((w % nig) % gsz);
  pn = (w % nig) / gsz;
}

DI u32x4 widen16(u32x2 a, u32x2 b) {
  auto s0 = __builtin_amdgcn_permlane16_swap(a[0], b[0], false, false);
  auto s1 = __builtin_amdgcn_permlane16_swap(a[1], b[1], false, false);
  u32x4 r = {s0[0], s1[0], s0[1], s1[1]};
  return r;
}

template <int EPI, int MT>
DI void gemm_epilogue(CP& p, int l, const f32x4 (&acc)[MT][4], int mb, int nb, int goff, int fr, int fq) {
  if (EPI == E_COMB || EPI == E_Q || EPI == E_SWIGLU) {
    const int tsel = fq & 1, csel = (fq >> 1) * 8;
#pragma unroll
    for (int mi = 0; mi < MT; ++mi) {
      const int m = mb + mi * 16 + fr;
      if (EPI == E_SWIGLU) {
        u32x2 r[2];
#pragma unroll
        for (int q = 0; q < 2; ++q) {
          const f32x4 gv = acc[mi][2 * q], uv = acc[mi][2 * q + 1];
          r[q] = (u32x2){pack2(siluf(gv[0]) * uv[0], siluf(gv[1]) * uv[1]), pack2(siluf(gv[2]) * uv[2], siluf(gv[3]) * uv[3])};
        }
        const u32x4 w = widen16(r[0], r[1]);
        *(u32x4*)(p.act + (size_t)m * DFF + (nb >> 1) + tsel * 16 + csel) = w;
      } else {
#pragma unroll
        for (int q = 0; q < 2; ++q) {
          const f32x4 va = acc[mi][2 * q], vb = acc[mi][2 * q + 1];
          const u32x2 a = {pack2(va[0], va[1]), pack2(va[2], va[3])};
          const u32x2 b = {pack2(vb[0], vb[1]), pack2(vb[2], vb[3])};
          const u32x4 w = widen16(a, b);
          const int n = nb + (2 * q + tsel) * 16 + csel;
          if (EPI == E_COMB) { if (n < INW) *(u32x4*)(p.comb + (size_t)m * INW + n) = w; }
          else *(u32x4*)(p.qbuf + (size_t)m * 768 + n) = w;
        }
      }
    }
    return;
  }
#pragma unroll
  for (int mi = 0; mi < MT; ++mi) {
    const int m = mb + mi * 16 + fr;
#pragma unroll
    for (int ni = 0; ni < 4; ++ni) {
      const int n = nb + ni * 16 + fq * 4;
      const f32x4 v = acc[mi][ni];
      if (EPI == E_COMB) {
        if (n < INW) { u32x2 o = {pack2(v[0], v[1]), pack2(v[2], v[3])}; *(u32x2*)(p.comb + (size_t)m * INW + n) = o; }
      } else if (EPI == E_Q) {
        u32x2 o = {pack2(v[0], v[1]), pack2(v[2], v[3])};
        *(u32x2*)(p.qbuf + (size_t)m * 768 + n) = o;
      } else if (EPI == E_KV) {
        const int hh = n >> 7, c = n & 127;
        if (c < 64) {
          u32x2 o = {pack2(v[0], v[1]), pack2(v[2], v[3])};
          *(u32x2*)(p.knope + (size_t)m * 512 + hh * 64 + c) = o;
        } else {
          int kvbase, Tk;
          if (m < NCTX) { kvbase = m & ~255; Tk = 256; }
          else { const int b = (m - NCTX) / 2304; kvbase = NCTX + b * 2304; Tk = 2304; }
          u16* dst = p.vt + (size_t)512 * kvbase + (size_t)(hh * 64 + (c - 64)) * Tk + (m - kvbase);
#pragma unroll
          for (int i = 0; i < 4; ++i) dst[(size_t)i * Tk] = f2bf(v[i]);
        }
      } else if (EPI == E_RES) {
        const int vs = m < NCTX ? 0 : 1 + ((m - NCTX) >> 11);
        const f32x4 gt = *(const f32x4*)(p.mod + (size_t)(l * 5 + vs) * 6144 + goff + n);
        float* xp = p.out + (size_t)m * 1024 + n;
        const float* xs = xp;
        if (l == 0 && goff == 2048) xs = (m < NCTX ? p.x_prompt + (size_t)m * 1024 : p.x_sample + (size_t)(m - NCTX) * 1024) + n;
        f32x4 xv = *(const f32x4*)xs;
        xv += gt * v;
        *(f32x4*)xp = xv;
      } else if (EPI == E_SWIGLU) {
        if ((ni & 1) == 0) {
          const f32x4 u = acc[mi][ni + 1];
          u32x2 o = {pack2(siluf(v[0]) * u[0], siluf(v[1]) * u[1]), pack2(siluf(v[2]) * u[2], siluf(v[3]) * u[3])};
          *(u32x2*)(p.act + (size_t)m * DFF + ((nb + ni * 16) >> 1) + fq * 4) = o;
        }
      }
    }
  }
}

#define GEMM_STAGE(buf, Ap, Wp, kt) do {                                                                                  \
    _Pragma("unroll") for (int i = 0; i < GLA; ++i)                                                                       \
      __builtin_amdgcn_global_load_lds((const unsigned*)((Ap) + (size_t)sR[i] * K + (kt) * 64 + sC[i]),                    \
                                       (LAS unsigned*)(ls + (buf) * STAGE_B + wid * 1024 + i * 8192), 16, 0, 0);         \
    _Pragma("unroll") for (int i = 0; i < 4; ++i)                                                                         \
      __builtin_amdgcn_global_load_lds((const unsigned*)((Wp) + (size_t)sR[i] * K + (kt) * 64 + sC[i]),                    \
                                       (LAS unsigned*)(ls + (buf) * STAGE_B + TILE_A + wid * 1024 + i * 8192), 16, 0, 0); \
  } while (0)

template <int EPI, int BM>
DI void gemm_phase(CP& p, int l, const u16* __restrict__ A, const u16* __restrict__ W, int K, int nM, int nN, int goff,
                   int t0, int tstride, int ntiles, bool raster, char* smem) {
  const int tid = opaque_tid(), lane = tid & 63, wid = tid >> 6;
  const int wr = wid >> 2, wc = wid & 3, fr = lane & 15, fq = lane >> 4;
  constexpr int MT = BM / 32, GLA = BM / 64;
  constexpr int TILE_A = BM * 128, TILE_B = 256 * 128, STAGE_B = TILE_A + TILE_B;
  LAS char* ls = (LAS char*)smem;
  int sR[4], sC[4];
#pragma unroll
  for (int i = 0; i < 4; ++i) stage_rc(wid * 1024 + i * 8192 + lane * 16, sR[i], sC[i]);
  int t = t0;
  if (t >= ntiles) return;
  int pm, pn;
  if (raster) tile_rc(t, nM, nN, pm, pn); else { pn = t / nM; pm = t - pn * nM; }
  const u16* Ab = A + (size_t)pm * BM * K;
  const u16* Wb = W + (size_t)pn * 256 * K;
  const int nt = K >> 6;
  __syncthreads();
  GEMM_STAGE(0, Ab, Wb, 0);
  asm volatile("s_waitcnt vmcnt(0)" ::: "memory");
  __syncthreads();
  for (;;) {
    const int tn = t + tstride;
    const bool has_next = tn < ntiles;
    int pmn = 0, pnn = 0;
    if (has_next) { if (raster) tile_rc(tn, nM, nN, pmn, pnn); else { pnn = tn / nM; pmn = tn - pnn * nM; } }
    const u16* Abn = A + (size_t)pmn * BM * K;
    const u16* Wbn = W + (size_t)pnn * 256 * K;
    f32x4 acc[MT][4];
#pragma unroll
    for (int m = 0; m < MT; ++m)
#pragma unroll
      for (int n = 0; n < 4; ++n) acc[m][n] = (f32x4){0.f, 0.f, 0.f, 0.f};
    for (int kt = 0; kt < nt; ++kt) {
      const int cur = kt & 1;
      if (kt + 1 < nt) GEMM_STAGE(cur ^ 1, Ab, Wb, kt + 1);
      else if (has_next) GEMM_STAGE(cur ^ 1, Abn, Wbn, 0);
      const char* sa = smem + cur * STAGE_B;
      const char* sb = sa + TILE_A;
#pragma unroll
      for (int ks = 0; ks < 2; ++ks) {
        bf16x8 At[MT], Bf[4];
#pragma unroll
        for (int m = 0; m < MT; ++m) At[m] = *(const bf16x8*)(sa + lds_byte(wr * (BM / 2) + m * 16 + fr, ks * 32 + fq * 8));
#pragma unroll
        for (int n = 0; n < 4; ++n) Bf[n] = *(const bf16x8*)(sb + lds_byte(wc * 64 + n * 16 + fr, ks * 32 + fq * 8));
        __builtin_amdgcn_s_setprio(1);
#pragma unroll
        for (int m = 0; m < MT; ++m)
#pragma unroll
          for (int n = 0; n < 4; ++n) acc[m][n] = MFMA(Bf[n], At[m], acc[m][n]);
        __builtin_amdgcn_s_setprio(0);
        __builtin_amdgcn_sched_barrier(0);
      }
      if (kt + 1 < nt) {
        asm volatile("s_waitcnt vmcnt(0)" ::: "memory");
        __syncthreads();
      }
    }
    gemm_epilogue<EPI, MT>(p, l, acc, pm * BM + wr * (BM / 2), pn * 256 + wc * 64, goff, fr, fq);
    asm volatile("s_waitcnt vmcnt(0)" ::: "memory");
    __syncthreads();
    if (!has_next) break;
    t = tn; pm = pmn; pn = pnn; Ab = Abn; Wb = Wbn;
  }
}
#undef GEMM_STAGE

DI void conv_wtile(const float* __restrict__ src, int K, int N, u16* __restrict__ dst, int rowmul, int rowoff, int kt,
                   int nt, LAS float* wt, int lane) {
  const int k0 = kt * 32, n0 = nt * 64;
  float v[32];
  const bool ok = n0 + lane < N;
  const float* sp = src + (size_t)k0 * N + n0 + lane;
#pragma unroll
  for (int i = 0; i < 32; ++i) v[i] = ok ? sp[(size_t)i * N] : 0.f;
#pragma unroll
  for (int i = 0; i < 32; ++i) wt[i * 65 + lane] = v[i];
#pragma unroll
  for (int i = 0; i < 16; ++i) {
    const int n = i * 4 + (lane >> 4), kp = lane & 15;
    const float lo = wt[(2 * kp) * 65 + n], hi = wt[(2 * kp + 1) * 65 + n];
    const int nn = n0 + n;
    const int drow = rowmul == 1 ? nn : ((nn >> 4) << 5) + (nn & 15) + 16 * rowoff;
    *(unsigned*)(dst + (size_t)drow * K + k0 + 2 * kp) = pack2(lo, hi);
  }
}

DI void conv_dispatch(CP& p, int l, int r, LAS float* wt, int lane) {
  if (r < 896) {
    conv_wtile(p.w_in + (size_t)l * 1024 * INW, 1024, INW, p.wt_in + (size_t)l * INWP * 1024, 1, 0, r & 31, r >> 5, wt, lane);
  } else if ((r -= 896) < 96) {
    conv_wtile(p.w_uq + (size_t)l * 256 * 768, 256, 768, p.wt_uq + (size_t)l * 768 * 256, 1, 0, r & 7, r >> 3, wt, lane);
  } else if ((r -= 96) < 64) {
    conv_wtile(p.w_ukv + (size_t)l * 128 * 1024, 128, 1024, p.wt_ukv + (size_t)l * 1024 * 128, 1, 0, r & 3, r >> 2, wt, lane);
  } else if ((r -= 64) < 512) {
    conv_wtile(p.w_out + (size_t)l * 1024 * 1024, 1024, 1024, p.wt_out + (size_t)l * 1024 * 1024, 1, 0, r & 31, r >> 5, wt, lane);
  } else if ((r -= 512) < 1408) {
    conv_wtile(p.w_gate + (size_t)l * 1024 * DFF, 1024, DFF, p.wt_gu + (size_t)l * 2 * DFF * 1024, 2, 0, r & 31, r >> 5, wt, lane);
  } else if ((r -= 1408) < 1408) {
    conv_wtile(p.w_up + (size_t)l * 1024 * DFF, 1024, DFF, p.wt_gu + (size_t)l * 2 * DFF * 1024, 2, 1, r & 31, r >> 5, wt, lane);
  } else {
    r -= 1408;
    conv_wtile(p.w_down + (size_t)l * DFF * 1024, DFF, 1024, p.wt_down + (size_t)l * 1024 * DFF, 1, 0, r % 88, r / 88, wt, lane);
  }
}

DI void conv_fill(CP& p, int l, int r_lo, int r_hi, unsigned* ctr, int* slot, char* smem) {
  const int tid = opaque_tid(), lane = tid & 63, wave = tid >> 6;
  LAS float* wt = (LAS float*)smem + wave * (32 * 65);
  const int nitems = (r_hi - r_lo + 7) >> 3;
  for (;;) {
    __syncthreads();
    if (tid == 0) *slot = (int)atomicAdd(ctr, 1u);
    __syncthreads();
    const int it = *slot;
    if (it >= nitems) break;
    const int r = r_lo + it * 8 + wave;
    if (r < r_hi) conv_dispatch(p, l, r, wt, lane);
  }
}

DI void phase0(CP& p, char* smem) {
  const int tid = opaque_tid();
  const int G = gridDim.x, bid = blockIdx.x;
  {
    const int lane = tid & 63, wave = tid >> 6;
    LAS float* wt = (LAS float*)smem + wave * (32 * 65);
    __syncthreads();
    for (int idx = bid * 8 + wave; idx < 5792; idx += G * 8) conv_dispatch(p, 0, idx, wt, lane);
  }
  {
    float* scond = (float*)(smem + 32768);
    float* red = scond + 5120;
    __syncthreads();
    for (int i = tid; i < 5120; i += NTHREADS) {
      const int v = i >> 10, k = i & 1023;
      const float x = v == 0 ? p.c_ctx[k] : p.c[(v - 1) * 1024 + k];
      scond[i] = siluf(x);
    }
    __syncthreads();
    for (int job = bid; job < 384; job += G) {
      const int l = job / 96, chunk = job - l * 96;
      const int c = tid & 63, kg = tid >> 6, col = chunk * 64 + c;
      float a0 = 0.f, a1 = 0.f, a2 = 0.f, a3 = 0.f, a4 = 0.f;
      const float* w = p.w_ada + ((size_t)l * 1024 + kg * 128) * 6144 + col;
      const float* sc = scond + kg * 128;
#pragma unroll 32
      for (int k = 0; k < 128; ++k) {
        const float wv = w[(size_t)k * 6144];
        a0 += sc[k] * wv; a1 += sc[1024 + k] * wv; a2 += sc[2048 + k] * wv; a3 += sc[3072 + k] * wv; a4 += sc[4096 + k] * wv;
      }
      red[(kg * 5 + 0) * 64 + c] = a0; red[(kg * 5 + 1) * 64 + c] = a1; red[(kg * 5 + 2) * 64 + c] = a2;
      red[(kg * 5 + 3) * 64 + c] = a3; red[(kg * 5 + 4) * 64 + c] = a4;
      __syncthreads();
      if (kg == 0) {
        const float bb = p.b_ada[l * 6144 + col];
#pragma unroll
        for (int v = 0; v < 5; ++v) {
          float s = 0.f;
#pragma unroll
          for (int q = 0; q < 8; ++q) s += red[(q * 5 + v) * 64 + c];
          p.mod[(size_t)(l * 5 + v) * 6144 + col] = s + bb;
        }
      }
      __syncthreads();
    }
  }
  for (int i = bid * NTHREADS + tid; i < 2048 * 16; i += G * NTHREADS) {
    const int t = i >> 4, a = (i >> 3) & 1, f = i & 7;
    const float pos = a == 0 ? (float)(t >> 6) : (float)(t & 63);
    const float inv = powf(10000.0f, -(float)f / 8.0f);
    const float ang = pos * inv;
    p.ropec[i] = cosf(ang);
    p.ropes[i] = sinf(ang);
  }
}

DI void norm_phase(CP& p, int l, int which) {
  const int tid = opaque_tid(), lane = tid & 63, wave = tid >> 6;
  const float* gw = (which == 0 ? p.g_mix : p.g_ffn) + l * 1024;
  const int shoff = which == 0 ? 0 : 3072, scoff = shoff + 1024;
  f32x4 gg[4];
#pragma unroll
  for (int i = 0; i < 4; ++i) gg[i] = *(const f32x4*)(gw + i * 256 + lane * 4);
  const int stride = gridDim.x * 8;
  for (int tok0 = blockIdx.x * 8 + wave; tok0 < NTOK; tok0 += 2 * stride) {
    f32x4 v[2][4], sc[2][4], sh[2][4];
    bool ok[2];
#pragma unroll
    for (int a = 0; a < 2; ++a) {
      const int tok = tok0 + a * stride;
      ok[a] = tok < NTOK;
      const int tk = ok[a] ? tok : tok0;
      const float* xr = p.out + (size_t)tk * 1024;
      if (l == 0 && which == 0) xr = tk < NCTX ? p.x_prompt + (size_t)tk * 1024 : p.x_sample + (size_t)(tk - NCTX) * 1024;
      const int vs = tk < NCTX ? 0 : 1 + ((tk - NCTX) >> 11);
      const float* md = p.mod + (size_t)(l * 5 + vs) * 6144;
#pragma unroll
      for (int i = 0; i < 4; ++i) {
        const int col = i * 256 + lane * 4;
        v[a][i] = *(const f32x4*)(xr + col);
        sc[a][i] = *(const f32x4*)(md + scoff + col);
        sh[a][i] = *(const f32x4*)(md + shoff + col);
      }
    }
#pragma unroll
    for (int a = 0; a < 2; ++a) {
      const int tok = tok0 + a * stride;
      float ss = 0.f;
#pragma unroll
      for (int i = 0; i < 4; ++i) ss += v[a][i][0] * v[a][i][0] + v[a][i][1] * v[a][i][1] + v[a][i][2] * v[a][i][2] + v[a][i][3] * v[a][i][3];
      ss = wave_sum(ss);
      const float rstd = rsqrtf(ss * (1.f / 1024.f) + 1e-6f);
      if (ok[a]) {
#pragma unroll
        for (int i = 0; i < 4; ++i) {
          const int col = i * 256 + lane * 4;
          f32x4 o;
#pragma unroll
          for (int j = 0; j < 4; ++j) o[j] = v[a][i][j] * rstd * gg[i][j] * (1.f + sc[a][i][j]) + sh[a][i][j];
          u32x2 pk = {pack2(o[0], o[1]), pack2(o[2], o[3])};
          *(u32x2*)(p.hb + (size_t)tok * 1024 + col) = pk;
        }
      }
    }
  }
}

DI void final_norm(CP& p) {
  const int tid = opaque_tid(), lane = tid & 63, wave = tid >> 6;
  f32x4 gg[4];
#pragma unroll
  for (int i = 0; i < 4; ++i) gg[i] = *(const f32x4*)(p.g_final + i * 256 + lane * 4);
  const int stride = gridDim.x * 8;
  for (int tok0 = blockIdx.x * 8 + wave; tok0 < NTOK; tok0 += 2 * stride) {
    f32x4 v[2][4];
    bool ok[2];
#pragma unroll
    for (int a = 0; a < 2; ++a) {
      const int tok = tok0 + a * stride;
      ok[a] = tok < NTOK;
      const float* xr = p.out + (size_t)(ok[a] ? tok : tok0) * 1024;
#pragma unroll
      for (int i = 0; i < 4; ++i) v[a][i] = *(const f32x4*)(xr + i * 256 + lane * 4);
    }
#pragma unroll
    for (int a = 0; a < 2; ++a) {
      const int tok = tok0 + a * stride;
      float ss = 0.f;
#pragma unroll
      for (int i = 0; i < 4; ++i) ss += v[a][i][0] * v[a][i][0] + v[a][i][1] * v[a][i][1] + v[a][i][2] * v[a][i][2] + v[a][i][3] * v[a][i][3];
      ss = wave_sum(ss);
      const float rstd = rsqrtf(ss * (1.f / 1024.f) + 1e-6f);
      if (ok[a]) {
        float* xr = p.out + (size_t)tok * 1024;
#pragma unroll
        for (int i = 0; i < 4; ++i) {
          f32x4 o;
#pragma unroll
          for (int j = 0; j < 4; ++j) o[j] = v[a][i][j] * rstd * gg[i][j];
          *(f32x4*)(xr + i * 256 + lane * 4) = o;
        }
      }
    }
  }
}

DI void prep_cache_row(CP& p, int l, int row) {
  const int lane = opaque_tid() & 63;
  {
    const int r = row - NTOK, b = r >> 8, j = r & 255;
    const int kvrow = NCTX + b * 2304 + j;
    const float* ck = p.cache_ckv + ((size_t)(b * 4 + l) * 256 + j) * 128;
    const f2_t v = *(const f2_t*)(ck + lane * 2);
    *(unsigned*)(p.ckvn + (size_t)kvrow * 128 + lane * 2) = pack2(v[0], v[1]);
    if (lane < 16) {
      const float* kr = p.cache_krope + ((size_t)(b * 4 + l) * 256 + j) * 32;
      const f2_t w = *(const f2_t*)(kr + lane * 2);
      *(unsigned*)(p.krope + (size_t)kvrow * 32 + lane * 2) = pack2(w[0], w[1]);
    }
  }
}

constexpr int PSTR = 1192;
struct PrepW { f32x4 gq; f2_t gkv; float cw[8][5]; float cb[8]; float dtb; };
DI void prep_load_w(CP& p, int l, int lane, PrepW& w) {
  w.gq = *(const f32x4*)(p.g_q + l * 256 + lane * 4);
  w.gkv = *(const f2_t*)(p.g_kv + l * 128 + lane * 2);
  const float* cw = p.ssd_conv_w + (size_t)l * 5 * 512;
  const float* cb = p.ssd_conv_b + l * 512;
#pragma unroll
  for (int i = 0; i < 8; ++i) {
    w.cb[i] = cb[i * 64 + lane];
#pragma unroll
    for (int j = 0; j < 5; ++j) w.cw[i][j] = cw[j * 512 + i * 64 + lane];
  }
  w.dtb = p.ssd_dt_bias[l * 8 + (lane & 7)];
}
DI void prep_row(CP& p, int l, int tok, const LAS float* cr, const PrepW& w, int lane) {
  int b, t, T, kvrow;
  const bool lat = tok >= NCTX;
  if (!lat) { b = tok >> 8; t = tok & 255; T = 256; kvrow = tok; }
  else { const int q = tok - NCTX; b = q >> 11; t = q & 2047; T = 2048; kvrow = NCTX + b * 2304 + 256 + t; }
  {
    const f32x4 v = *(const LAS f32x4*)(cr + lane * 4);
    float ss = v[0] * v[0] + v[1] * v[1] + v[2] * v[2] + v[3] * v[3];
    ss = wave_sum(ss);
    const float rstd = rsqrtf(ss * (1.f / 256.f) + 1e-6f);
    const f32x4 gg = w.gq;
    u32x2 pk = {pack2(v[0] * rstd * gg[0], v[1] * rstd * gg[1]), pack2(v[2] * rstd * gg[2], v[3] * rstd * gg[3])};
    *(u32x2*)(p.qn + (size_t)tok * 256 + lane * 4) = pk;
  }
  {
    const f2_t v = *(const LAS f2_t*)(cr + 256 + lane * 2);
    float ss = v[0] * v[0] + v[1] * v[1];
    ss = wave_sum(ss);
    const float rstd = rsqrtf(ss * (1.f / 128.f) + 1e-6f);
    const f2_t gg = w.gkv;
    const float o0 = v[0] * rstd * gg[0], o1 = v[1] * rstd * gg[1];
    *(unsigned*)(p.ckvn + (size_t)kvrow * 128 + lane * 2) = pack2(o0, o1);
    if (!lat) {
      f2_t o = {o0, o1};
      *(f2_t*)(p.out + O_CKV + ((size_t)(b * 4 + l) * 256 + t) * 128 + lane * 2) = o;
    }
  }
  if (lane < 16) {
    const int a = lane >> 3, f = lane & 7;
    const float x1 = cr[384 + a * 16 + f], x2 = cr[384 + a * 16 + 8 + f];
    float o1 = x1, o2 = x2;
    if (!lat) {
      float* dst = p.out + O_KR + ((size_t)(b * 4 + l) * 256 + t) * 32;
      dst[a * 16 + f] = x1;
      dst[a * 16 + 8 + f] = x2;
    } else {
      const float c = p.ropec[t * 16 + a * 8 + f], s = p.ropes[t * 16 + a * 8 + f];
      o1 = x1 * c - x2 * s;
      o2 = x2 * c + x1 * s;
    }
    p.krope[(size_t)kvrow * 32 + a * 16 + f] = f2bf(o1);
    p.krope[(size_t)kvrow * 32 + a * 16 + 8 + f] = f2bf(o2);
  }
  {
#pragma unroll
    for (int i = 0; i < 8; ++i) {
      const int c = i * 64 + lane;
      float acc = w.cb[i];
#pragma unroll
      for (int j = 0; j < 5; ++j) {
        acc += w.cw[i][j] * cr[(j - 2) * PSTR + 672 + c];
      }
      p.xbc[(size_t)tok * 512 + c] = siluf(acc);
    }
  }
  if (lane < 8) {
    const float x = cr[1184 + lane] + w.dtb;
    const float sp = x > 20.f ? x : log1pf(expf(x));
    p.dtb[(size_t)tok * 8 + lane] = sp;
  }
}

DI void prep_tile(CP& p, int l, int ti, char* smem) {
  const int tid = opaque_tid(), wave = tid >> 6;
  int base, t0, T;
  if (ti < 256) { base = (ti >> 4) * 256; t0 = (ti & 15) * 16; T = 256; }
  else { const int j = ti - 256; base = NCTX + (j >> 7) * 2048; t0 = (j & 127) * 16; T = 2048; }
  LAS float* sr = (LAS float*)smem;
  const int lane = tid & 63;
  PrepW pw;
  prep_load_w(p, l, lane, pw);
  __syncthreads();
  u32x4 stg[6];
#pragma unroll
  for (int i = 0; i < 6; ++i) {
    const int idx = tid + i * 512;
    const int row = idx / 149, c8 = idx - row * 149;
    const int t = t0 - 2 + row;
    stg[i] = (u32x4){0u, 0u, 0u, 0u};
    if (idx < 2980 && t >= 0 && t < T) stg[i] = *(const u32x4*)(p.comb + (size_t)(base + t) * INW + c8 * 8);
  }
#pragma unroll
  for (int i = 0; i < 6; ++i) {
    const int idx = tid + i * 512;
    const int row = idx / 149, c8 = idx - row * 149;
    if (idx < 2980) {
      f32x4 lo, hi;
      lo[0] = __uint_as_float(stg[i][0] << 16); lo[1] = __uint_as_float(stg[i][0] & 0xffff0000u);
      lo[2] = __uint_as_float(stg[i][1] << 16); lo[3] = __uint_as_float(stg[i][1] & 0xffff0000u);
      hi[0] = __uint_as_float(stg[i][2] << 16); hi[1] = __uint_as_float(stg[i][2] & 0xffff0000u);
      hi[2] = __uint_as_float(stg[i][3] << 16); hi[3] = __uint_as_float(stg[i][3] & 0xffff0000u);
      *(LAS f32x4*)(sr + row * PSTR + c8 * 8) = lo;
      *(LAS f32x4*)(sr + row * PSTR + c8 * 8 + 4) = hi;
    }
  }
  __syncthreads();
#pragma unroll
  for (int i = 0; i < 2; ++i) {
    const int tt = wave * 2 + i;
    prep_row(p, l, base + t0 + tt, sr + (tt + 2) * PSTR, pw, lane);
  }
}

DI void cm_tile(CP& p, int l, int ti, char* smem) {
  const int tid = opaque_tid(), lane = tid & 63, wave = tid >> 6;
  int base, t0, T;
  if (ti < 128) { base = (ti >> 3) * 256; t0 = (ti & 7) * 32; T = 256; }
  else { const int j = ti - 128; base = NCTX + (j >> 6) * 2048; t0 = (j & 63) * 32; T = 2048; }
  LAS float* sg = (LAS float*)smem;
  LAS float* so = sg + 62 * 256;
  const int c = tid & 255, half = tid >> 8;
  float w[31];
#pragma unroll
  for (int j = 0; j < 31; ++j) w[j] = p.cm_conv_w[(size_t)(l * 31 + j) * 256 + c];
  const float bias = p.cm_conv_b[l * 256 + c];
  __syncthreads();
  {
    u32x4 ra[4], rb[4];
#pragma unroll
    for (int i = 0; i < 4; ++i) {
      const int idx = tid + i * 512;
      const int r = idx >> 5, c8 = idx & 31;
      const int t = t0 - 15 + r;
      ra[i] = (u32x4){0u, 0u, 0u, 0u}; rb[i] = (u32x4){0u, 0u, 0u, 0u};
      if (idx < 62 * 32 && t >= 0 && t < T) {
        const u16* cr = p.comb + (size_t)(base + t) * INW;
        ra[i] = *(const u32x4*)(cr + 1192 + c8 * 8);
        rb[i] = *(const u32x4*)(cr + 1448 + c8 * 8);
      }
    }
#pragma unroll
    for (int i = 0; i < 4; ++i) {
      const int idx = tid + i * 512;
      const int r = idx >> 5, c8 = idx & 31;
      if (idx < 62 * 32) {
        f32x4 lo, hi;
#pragma unroll
        for (int q = 0; q < 2; ++q) {
          lo[2 * q] = __uint_as_float(ra[i][q] << 16) * sigmoidf(__uint_as_float(rb[i][q] << 16));
          lo[2 * q + 1] = __uint_as_float(ra[i][q] & 0xffff0000u) * sigmoidf(__uint_as_float(rb[i][q] & 0xffff0000u));
          hi[2 * q] = __uint_as_float(ra[i][q + 2] << 16) * sigmoidf(__uint_as_float(rb[i][q + 2] << 16));
          hi[2 * q + 1] = __uint_as_float(ra[i][q + 2] & 0xffff0000u) * sigmoidf(__uint_as_float(rb[i][q + 2] & 0xffff0000u));
        }
        *(LAS f32x4*)(sg + r * 256 + c8 * 8) = lo;
        *(LAS f32x4*)(sg + r * 256 + c8 * 8 + 4) = hi;
      }
    }
  }
  __syncthreads();
#pragma unroll 1
  for (int t4 = 0; t4 < 4; ++t4) {
    const int tb = half * 16 + t4 * 4;
    float a0 = bias, a1 = bias, a2 = bias, a3 = bias;
#pragma unroll
    for (int j = 0; j < 34; ++j) {
      const float x = sg[(tb + j) * 256 + c];
      if (j < 31) a0 += w[j] * x;
      if (j >= 1 && j < 32) a1 += w[j - 1] * x;
      if (j >= 2 && j < 33) a2 += w[j - 2] * x;
      if (j >= 3) a3 += w[j - 3] * x;
    }
    so[tb * 256 + c] = a0;
    so[(tb + 1) * 256 + c] = a1;
    so[(tb + 2) * 256 + c] = a2;
    so[(tb + 3) * 256 + c] = a3;
  }
  __syncthreads();
  {
    float lg[4], lb[4];
#pragma unroll
    for (int i = 0; i < 4; ++i) { lg[i] = p.cm_ln_g[l * 256 + lane + 64 * i]; lb[i] = p.cm_ln_b[l * 256 + lane + 64 * i]; }
#pragma unroll
    for (int tt = 0; tt < 4; ++tt) {
      const int t = wave * 4 + tt;
      float v[4];
      float sm = 0.f;
#pragma unroll
      for (int i = 0; i < 4; ++i) { v[i] = so[t * 256 + lane + 64 * i]; sm += v[i]; }
      const float mean = wave_sum(sm) * (1.f / 256.f);
      float q = 0.f;
#pragma unroll
      for (int i = 0; i < 4; ++i) { const float d = v[i] - mean; q += d * d; }
      const float var = wave_sum(q) * (1.f / 256.f);
      const float rstd = rsqrtf(var + 1e-5f);
#pragma unroll
      for (int i = 0; i < 4; ++i) {
        const int cc = lane + 64 * i;
        float y = (v[i] - mean) * rstd * lg[i] + lb[i];
        y = siluf(y);
        p.hb[(size_t)(base + t0 + t) * 1024 + 768 + cc] = f2bf(y);
      }
    }
  }
}

DI void ssd_item(CP& p, int l, int seq, int h, int dir, char* smem) {
  const int tid = opaque_tid(), lane = tid & 63, wave = tid >> 6, lr = lane & 15, g = lane >> 4;
  const int rt = wave & 3, ch = wave >> 2;
  const bool lat = seq >= 16;
  const int b = lat ? seq - 16 : seq;
  const int T = lat ? 2048 : 256;
  const int qbase = lat ? NCTX + b * 2048 : b * 256;
  u16* sC = (u16*)smem;
  u16* sB = sC + 64 * 72;
  u16* sBt = sB + 64 * 72;
  u16* sXt = sBt + 64 * 72;
  u16* sXw = sXt + 64 * 72;
  u16* sM = sXw + 64 * 72;
  u16* sH = sM + 64 * 72;
  float* sdtA = (float*)(sH + 64 * 72);
  float* sacsA = sdtA + 2048;
  const float Aneg = -expf(p.ssd_a_log[(l * 2 + dir) * 4 + h]);
  const int grp = h >> 1;
  f32x4 hacc[2];
  if (lat) {
    const float* src = p.state_ssd + ((size_t)(((b * 4 + l) * 2 + dir) * 4 + h)) * 4096;
#pragma unroll
    for (int n2 = 0; n2 < 2; ++n2)
#pragma unroll
      for (int i = 0; i < 4; ++i) hacc[n2][i] = src[(rt * 16 + g * 4 + i) * 64 + (ch * 2 + n2) * 16 + lr];
  } else {
#pragma unroll
    for (int n2 = 0; n2 < 2; ++n2) hacc[n2] = (f32x4){0.f, 0.f, 0.f, 0.f};
  }
  __syncthreads();
#pragma unroll
  for (int n2 = 0; n2 < 2; ++n2)
#pragma unroll
    for (int i = 0; i < 4; ++i) sH[(rt * 16 + g * 4 + i) * 72 + (ch * 2 + n2) * 16 + lr] = f2bf(hacc[n2][i]);
  const int nch = T >> 6;
  {
    float dv[4];
#pragma unroll
    for (int i = 0; i < 4; ++i) {
      const int cq = wave + 8 * i;
      dv[i] = cq < nch ? p.dtb[(size_t)(qbase + cq * 64 + lane) * 8 + dir * 4 + h] : 0.f;
    }
#pragma unroll
    for (int i = 0; i < 4; ++i) {
      const int cq = wave + 8 * i;
      float sc = dv[i] * Aneg;
      if (!dir) {
#pragma unroll
        for (int o = 1; o < 64; o <<= 1) { const float tv = __shfl_up(sc, o); if (lane >= o) sc += tv; }
      } else {
#pragma unroll
        for (int o = 1; o < 64; o <<= 1) { const float tv = __shfl_down(sc, o); if (lane + o < 64) sc += tv; }
      }
      if (cq < nch) { sdtA[cq * 64 + lane] = dv[i]; sacsA[cq * 64 + lane] = sc; }
    }
  }
  const int r = tid >> 3, cc = (tid & 7) * 8;
  f32x4 xv[2], bv[2], cv[2];
  {
    const int c0 = dir ? nch - 1 : 0;
    const float* rowp = p.xbc + (size_t)(qbase + c0 * 64 + r) * 512;
#pragma unroll
    for (int i = 0; i < 2; ++i) {
      xv[i] = *(const f32x4*)(rowp + h * 64 + cc + i * 4);
      bv[i] = *(const f32x4*)(rowp + 256 + grp * 64 + cc + i * 4);
      cv[i] = *(const f32x4*)(rowp + 384 + grp * 64 + cc + i * 4);
    }
  }
  __syncthreads();
#pragma unroll 1
  for (int ci = 0; ci < nch; ++ci) {
    const int c = dir ? nch - 1 - ci : ci;
    const int tok0 = qbase + c * 64;
    const float* sdt = sdtA + c * 64;
    const float* sacs = sacsA + c * 64;
    const float total = dir ? sacs[0] : sacs[63];
    const float wr = __expf(total - sacs[r]) * sdt[r];
    {
      u32x4 c0 = {pack2(cv[0][0], cv[0][1]), pack2(cv[0][2], cv[0][3]), pack2(cv[1][0], cv[1][1]), pack2(cv[1][2], cv[1][3])};
      *(u32x4*)(sC + r * 72 + cc) = c0;
      u32x4 b0 = {pack2(bv[0][0], bv[0][1]), pack2(bv[0][2], bv[0][3]), pack2(bv[1][0], bv[1][1]), pack2(bv[1][2], bv[1][3])};
      *(u32x4*)(sB + r * 72 + cc) = b0;
#pragma unroll
      for (int i = 0; i < 2; ++i)
#pragma unroll
        for (int j = 0; j < 4; ++j) {
          const int e = cc + i * 4 + j;
          sBt[e * 72 + r] = f2bf(bv[i][j]);
          sXt[e * 72 + r] = f2bf(xv[i][j]);
          sXw[e * 72 + r] = f2bf(xv[i][j] * wr);
        }
    }
    if (ci + 1 < nch) {
      const int cn = dir ? nch - 2 - ci : ci + 1;
      const float* rowp = p.xbc + (size_t)(qbase + cn * 64 + r) * 512;
#pragma unroll
      for (int i = 0; i < 2; ++i) {
        xv[i] = *(const f32x4*)(rowp + h * 64 + cc + i * 4);
        bv[i] = *(const f32x4*)(rowp + 256 + grp * 64 + cc + i * 4);
        cv[i] = *(const f32x4*)(rowp + 384 + grp * 64 + cc + i * 4);
      }
    }
    __syncthreads();
    f32x4 gacc[2];
#pragma unroll
    for (int s2 = 0; s2 < 2; ++s2) gacc[s2] = (f32x4){0.f, 0.f, 0.f, 0.f};
#pragma unroll
    for (int ks = 0; ks < 2; ++ks) {
      const bf16x8 cf = *(const bf16x8*)(sC + (rt * 16 + lr) * 72 + ks * 32 + g * 8);
#pragma unroll
      for (int s2 = 0; s2 < 2; ++s2) {
        const bf16x8 bfr = *(const bf16x8*)(sB + ((ch * 2 + s2) * 16 + lr) * 72 + ks * 32 + g * 8);
        gacc[s2] = MFMA(cf, bfr, gacc[s2]);
      }
    }
    int opq;
    asm volatile("v_mov_b32 %0, 0" : "=v"(opq));
#pragma unroll
    for (int s2 = 0; s2 < 2; ++s2) {
      const int si = (ch * 2 + s2) * 16 + lr + opq;
      const float acs_s = sacs[si], dt_s = sdt[si];
#pragma unroll
      for (int i = 0; i < 4; ++i) {
        const int li = rt * 16 + g * 4 + i;
        const float acs_l = sacs[li];
        const bool ok = dir ? (si >= li) : (si <= li);
        const float mval = ok ? gacc[s2][i] * __expf(acs_l - acs_s) * dt_s : 0.f;
        sM[li * 72 + si] = f2bf(mval);
      }
    }
    __syncthreads();
    f32x4 yd[2], yo[2];
#pragma unroll
    for (int p2 = 0; p2 < 2; ++p2) { yd[p2] = (f32x4){0.f, 0.f, 0.f, 0.f}; yo[p2] = (f32x4){0.f, 0.f, 0.f, 0.f}; }
#pragma unroll
    for (int ks = 0; ks < 2; ++ks) {
      const bf16x8 mf = *(const bf16x8*)(sM + (rt * 16 + lr) * 72 + ks * 32 + g * 8);
      const bf16x8 cf = *(const bf16x8*)(sC + (rt * 16 + lr) * 72 + ks * 32 + g * 8);
#pragma unroll
      for (int p2 = 0; p2 < 2; ++p2) {
        const bf16x8 xf = *(const bf16x8*)(sXt + ((ch * 2 + p2) * 16 + lr) * 72 + ks * 32 + g * 8);
        const bf16x8 hf = *(const bf16x8*)(sH + ((ch * 2 + p2) * 16 + lr) * 72 + ks * 32 + g * 8);
        yd[p2] = MFMA(mf, xf, yd[p2]);
        yo[p2] = MFMA(cf, hf, yo[p2]);
      }
    }
#pragma unroll
    for (int i = 0; i < 4; ++i) {
      const int li = rt * 16 + g * 4 + i;
      const float e = __expf(sacs[li]);
      float* yrow = p.ydir + ((size_t)dir * NTOK + tok0 + li) * 256 + h * 64 + ch * 32 + lr;
#pragma unroll
      for (int p2 = 0; p2 < 2; ++p2) yrow[p2 * 16] = yd[p2][i] + e * yo[p2][i];
    }
    f32x4 hn[2];
#pragma unroll
    for (int n2 = 0; n2 < 2; ++n2) hn[n2] = (f32x4){0.f, 0.f, 0.f, 0.f};
#pragma unroll
    for (int ks = 0; ks < 2; ++ks) {
      const bf16x8 xw = *(const bf16x8*)(sXw + (rt * 16 + lr) * 72 + ks * 32 + g * 8);
#pragma unroll
      for (int n2 = 0; n2 < 2; ++n2) {
        const bf16x8 bt = *(const bf16x8*)(sBt + ((ch * 2 + n2) * 16 + lr) * 72 + ks * 32 + g * 8);
        hn[n2] = MFMA(xw, bt, hn[n2]);
      }
    }
    const float et = __expf(total);
#pragma unroll
    for (int n2 = 0; n2 < 2; ++n2) hacc[n2] = hacc[n2] * et + hn[n2];
    __syncthreads();
#pragma unroll
    for (int n2 = 0; n2 < 2; ++n2)
#pragma unroll
      for (int i = 0; i < 4; ++i) sH[(rt * 16 + g * 4 + i) * 72 + (ch * 2 + n2) * 16 + lr] = f2bf(hacc[n2][i]);
  }
  if (!lat) {
    float* dst = p.out + O_SSD + ((size_t)(((b * 4 + l) * 2 + dir) * 4 + h)) * 4096;
#pragma unroll
    for (int n2 = 0; n2 < 2; ++n2)
#pragma unroll
      for (int i = 0; i < 4; ++i) dst[(rt * 16 + g * 4 + i) * 64 + (ch * 2 + n2) * 16 + lr] = hacc[n2][i];
  }
}

DI void ssd_final_rows4(CP& p, int l, int tok0) {
  const int lane = opaque_tid() & 63;
  const int c = lane * 4, h = c >> 6;
  const float dd = p.ssd_d[(l * 2 + 0) * 4 + h] + p.ssd_d[(l * 2 + 1) * 4 + h];
  const f32x4 gg = *(const f32x4*)(p.ssd_norm_g + l * 256 + c);
  f32x4 y0[4], y1[4], xs[4];
  u32x2 zr[4];
#pragma unroll
  for (int a = 0; a < 4; ++a) {
    const int tok = tok0 + a;
    y0[a] = *(const f32x4*)(p.ydir + (size_t)tok * 256 + c);
    y1[a] = *(const f32x4*)(p.ydir + ((size_t)NTOK + tok) * 256 + c);
    xs[a] = *(const f32x4*)(p.xbc + (size_t)tok * 512 + c);
    zr[a] = *(const u32x2*)(p.comb + (size_t)tok * INW + 416 + c);
  }
#pragma unroll
  for (int a = 0; a < 4; ++a) {
    const int tok = tok0 + a;
    const f32x4 z = {__uint_as_float(zr[a][0] << 16), __uint_as_float(zr[a][0] & 0xffff0000u), __uint_as_float(zr[a][1] << 16),
                     __uint_as_float(zr[a][1] & 0xffff0000u)};
    f32x4 v;
    float ss = 0.f;
#pragma unroll
    for (int j = 0; j < 4; ++j) {
      v[j] = (y0[a][j] + y1[a][j] + dd * xs[a][j]) * siluf(z[j]);
      ss += v[j] * v[j];
    }
    ss = wave_sum(ss);
    const float rstd = rsqrtf(ss * (1.f / 256.f) + 1e-6f);
    u32x2 pk = {pack2(v[0] * rstd * gg[0], v[1] * rstd * gg[1]), pack2(v[2] * rstd * gg[2], v[3] * rstd * gg[3])};
    *(u32x2*)(p.hb + (size_t)tok * 1024 + 512 + c) = pk;
  }
}

DI void attn_item(CP& p, int seq, int h, int qb, char* smem) {
  const int tid = opaque_tid(), lane = tid & 63, wave = tid >> 6, lr = lane & 15, g = lane >> 4;
  const bool lat = seq >= 16;
  int Tk, kvbase, qtok0;
  if (!lat) { Tk = 256; kvbase = seq * 256; qtok0 = seq * 256; }
  else { const int b = seq - 16; Tk = 2304; kvbase = NCTX + b * 2304; qtok0 = NCTX + b * 2048 + qb * 256; }
  LAS u16* sKb = (LAS u16*)smem;
  LAS u16* sVb = sKb + 256 * 104;
  bf16x8 qf[2][3];
#pragma unroll
  for (int qt = 0; qt < 2; ++qt) {
    const int tok = qtok0 + wave * 32 + qt * 16 + lr;
#pragma unroll
    for (int ks = 0; ks < 3; ++ks) qf[qt][ks] = *(const bf16x8*)(p.qbuf + (size_t)tok * 768 + h * 96 + ks * 32 + g * 8);
    if (lat) {
      const int t = (tok - NCTX) & 2047;
      const int axis = g >> 1, half = g & 1;
      const float* cs = p.ropec + t * 16 + axis * 8;
      const float* sn = p.ropes + t * 16 + axis * 8;
      bf16x8 r;
#pragma unroll
      for (int j = 0; j < 8; ++j) {
        const float x = bf2f((u16)qf[qt][2][j]);
        const float pr = __shfl_xor(x, 16);
        const float c = cs[j], s = sn[j];
        const float o = half ? x * c + pr * s : x * c - pr * s;
        r[j] = (short)f2bf(o);
      }
      qf[qt][2] = r;
    }
  }
  f32x4 o[2][4];
#pragma unroll
  for (int qt = 0; qt < 2; ++qt)
#pragma unroll
    for (int dt = 0; dt < 4; ++dt) o[qt][dt] = (f32x4){0.f, 0.f, 0.f, 0.f};
  float mrow[2] = {-1e30f, -1e30f}, lrow[2] = {0.f, 0.f};
  const float cs2 = 0.10206207261596574f * 1.4426950408889634f;
  const int nst = Tk >> 8;
  const u16* gk = p.knope + (size_t)(kvbase + (tid >> 3)) * 512 + h * 64 + (tid & 7) * 8;
  const u16* gr = p.krope + (size_t)(kvbase + (tid >> 2)) * 32 + (tid & 3) * 8;
  const u16* gv = p.vt + (size_t)512 * kvbase + (size_t)(h * 64 + (tid >> 5)) * Tk + (tid & 31) * 8;
  u32x4 rk[4], rr[2], rv[4];
#pragma unroll
  for (int i = 0; i < 4; ++i) { rk[i] = *(const u32x4*)(gk + (size_t)i * 64 * 512); rv[i] = *(const u32x4*)(gv + (size_t)i * 16 * Tk); }
#pragma unroll
  for (int i = 0; i < 2; ++i) rr[i] = *(const u32x4*)(gr + (size_t)i * 128 * 32);
#pragma unroll 1
  for (int st = 0; st < nst; ++st) {
    __syncthreads();
#pragma unroll
    for (int i = 0; i < 4; ++i) {
      *(LAS u32x4*)(sKb + ((tid >> 3) + i * 64) * 104 + (tid & 7) * 8) = rk[i];
      *(LAS u32x4*)(sVb + ((tid >> 5) + i * 16) * 264 + (tid & 31) * 8) = rv[i];
    }
#pragma unroll
    for (int i = 0; i < 2; ++i) *(LAS u32x4*)(sKb + ((tid >> 2) + i * 128) * 104 + 64 + (tid & 3) * 8) = rr[i];
    __syncthreads();
    if (st + 1 < nst) {
      const size_t ko = (size_t)(st + 1) * 256;
#pragma unroll
      for (int i = 0; i < 4; ++i) { rk[i] = *(const u32x4*)(gk + (ko + i * 64) * 512); rv[i] = *(const u32x4*)(gv + (size_t)i * 16 * Tk + ko); }
#pragma unroll
      for (int i = 0; i < 2; ++i) rr[i] = *(const u32x4*)(gr + (ko + i * 128) * 32);
    }
#pragma unroll 1
    for (int kt = 0; kt < 4; ++kt) {
      const LAS u16* sK = sKb + kt * 64 * 104;
      const LAS u16* sV = sVb + kt * 64;
      f32x4 s[4][2];
#pragma unroll
      for (int k4 = 0; k4 < 4; ++k4) {
        s[k4][0] = (f32x4){0.f, 0.f, 0.f, 0.f};
        s[k4][1] = (f32x4){0.f, 0.f, 0.f, 0.f};
#pragma unroll
        for (int ks = 0; ks < 3; ++ks) {
          const bf16x8 kf = *(const LAS bf16x8*)(sK + (k4 * 16 + lr) * 104 + ks * 32 + g * 8);
          s[k4][0] = MFMA(kf, qf[0][ks], s[k4][0]);
          s[k4][1] = MFMA(kf, qf[1][ks], s[k4][1]);
        }
      }
      bf16x8 pf[2][2];
#pragma unroll
      for (int qt = 0; qt < 2; ++qt) {
        float mx = -1e30f;
#pragma unroll
        for (int k4 = 0; k4 < 4; ++k4)
#pragma unroll
          for (int i = 0; i < 4; ++i) mx = fmaxf(mx, s[k4][qt][i]);
        mx = xrow16_max(mx);
        const float mnew = fmaxf(mrow[qt], mx * cs2);
        const float alpha = __builtin_amdgcn_exp2f(mrow[qt] - mnew);
        mrow[qt] = mnew;
        float psum = 0.f;
        float pv[4][4];
#pragma unroll
        for (int k4 = 0; k4 < 4; ++k4)
#pragma unroll
          for (int i = 0; i < 4; ++i) {
            pv[k4][i] = __builtin_amdgcn_exp2f(s[k4][qt][i] * cs2 - mnew);
            psum += pv[k4][i];
          }
        lrow[qt] = lrow[qt] * alpha + psum;
        if (__builtin_amdgcn_ballot_w64(alpha != 1.f) != 0ull) {
#pragma unroll
          for (int dt = 0; dt < 4; ++dt) o[qt][dt] *= alpha;
        }
#pragma unroll
        for (int s2 = 0; s2 < 2; ++s2) {
          u32x4 pk = {pack2(pv[2 * s2][0], pv[2 * s2][1]), pack2(pv[2 * s2][2], pv[2 * s2][3]),
                      pack2(pv[2 * s2 + 1][0], pv[2 * s2 + 1][1]), pack2(pv[2 * s2 + 1][2], pv[2 * s2 + 1][3])};
          pf[qt][s2] = __builtin_bit_cast(bf16x8, pk);
        }
      }
#pragma unroll
      for (int s2 = 0; s2 < 2; ++s2)
#pragma unroll
        for (int dt = 0; dt < 4; ++dt) {
          const s16x4 lo = *(const LAS s16x4*)(sV + (dt * 16 + lr) * 264 + s2 * 32 + g * 4);
          const s16x4 hi = *(const LAS s16x4*)(sV + (dt * 16 + lr) * 264 + s2 * 32 + 16 + g * 4);
          const bf16x8 vf = __builtin_shufflevector(lo, hi, 0, 1, 2, 3, 4, 5, 6, 7);
          o[0][dt] = MFMA(vf, pf[0][s2], o[0][dt]);
          o[1][dt] = MFMA(vf, pf[1][s2], o[1][dt]);
        }
    }
  }
#pragma unroll
  for (int qt = 0; qt < 2; ++qt) {
    float lsum = lrow[qt];
    lsum = xrow16_sum(lsum);
    const float inv = frcp(lsum);
    const int tok = qtok0 + wave * 32 + qt * 16 + lr;
#pragma unroll
    for (int dt = 0; dt < 4; ++dt) {
      u32x2 pk = {pack2(o[qt][dt][0] * inv, o[qt][dt][1] * inv), pack2(o[qt][dt][2] * inv, o[qt][dt][3] * inv)};
      *(u32x2*)(p.hb + (size_t)tok * 1024 + h * 64 + dt * 16 + g * 4) = pk;
    }
  }
}

DI int next_item(unsigned* ctr, int* slot) {
  __syncthreads();
  if (threadIdx.x == 0) *slot = (int)atomicAdd(ctr, 1u);
  __syncthreads();
  return *slot;
}

DI void forward(char* smem) {
  const int G = gridDim.x, bid = blockIdx.x;
  const int wave = threadIdx.x >> 6;
  int* slot = (int*)(smem + LDS_MAIN + 32);
  int ph = 0;
  XcdBarrier xb;
  {
    unsigned* stw = (unsigned*)(smem + LDS_MAIN);
    if (threadIdx.x == 0) { stw[0] = 0u; stw[1] = 0u; }
    __syncthreads();
    CP& p0 = get_params();
    xb = xcd_barrier_post(p0.bar, (volatile LAS unsigned*)stw);
    (void)xb;
  }
#define PH_BEGIN { CP& p = get_params();
#if USE_CG_SYNC
#define PH_END } { if (ph == 0) cg::this_grid().sync(); else { XcdBarrier xq; xq.bar = nullptr; xq.x = 0u; xq.st = (volatile LAS unsigned*)(smem + LDS_MAIN); xcd_barrier(xq); } } ++ph;
#else
#define PH_END } { XcdBarrier xq; xq.bar = nullptr; xq.x = 0u; xq.st = (volatile LAS unsigned*)(smem + LDS_MAIN); xcd_barrier(xq); } ++ph;
#endif

  PH_BEGIN
    phase0(p, smem);
  PH_END

#pragma unroll 1
  for (int l = 0; l < 4; ++l) {
    PH_BEGIN
      norm_phase(p, l, 0);
    PH_END
    PH_BEGIN
      gemm_phase<E_COMB, 192>(p, l, p.hb, p.wt_in + (size_t)l * INWP * 1024, 1024, 64, 7, 0, bid, G, 64 * 7, true, smem);
    PH_END
    PH_BEGIN
      for (int t = bid; t < 768 + 128; t += G) {
        if (t < 768) prep_tile(p, l, t, smem);
        else prep_cache_row(p, l, NTOK + (t - 768) * 8 + wave);
      }
    PH_END
    PH_BEGIN
      for (;;) {
        const int it = next_item(p.ctr + ph, slot);
        if (it >= 160 + 384 + 208 + 144) break;
        if (it < 32 || (it >= 416 && it < 544)) {
          const int j = it < 32 ? it : it - 416;
          ssd_item(p, l, (it < 32 ? 16 : 0) + (j >> 3), (j >> 1) & 3, j & 1, smem);
        } else if (it < 416) {
          cm_tile(p, l, it - 32, smem);
        } else if (it < 752) {
          const int t = it - 544;
          gemm_phase<E_KV, 256>(p, l, p.ckvn, p.wt_ukv + (size_t)l * 1024 * 128, 128, 52, 4, 0, t, 1 << 20, 208, false, smem);
        } else {
          const int t = it - 752;
          gemm_phase<E_Q, 256>(p, l, p.qn, p.wt_uq + (size_t)l * 768 * 256, 256, 48, 3, 0, t, 1 << 20, 144, false, smem);
        }
      }
      if (l < 3) conv_fill(p, l + 1, 0, 5792, p.ctr + 128 + ph, slot, smem);
    PH_END
    PH_BEGIN
      for (;;) {
        const int it = next_item(p.ctr + ph, slot);
        if (it >= 384 + 384) break;
        if (it < 384) {
          int sq, hh, qb;
          if (it < 256) { sq = 16 + (it >> 6); hh = (it >> 3) & 7; qb = it & 7; }
          else { const int j = it - 256; sq = j >> 3; hh = j & 7; qb = 0; }
          attn_item(p, sq, hh, qb, smem);
        } else {
          const int t0 = (it - 384) * 32 + wave * 4;
          ssd_final_rows4(p, l, t0);
        }
      }
    PH_END
    PH_BEGIN
      gemm_phase<E_RES, 192>(p, l, p.hb, p.wt_out + (size_t)l * 1024 * 1024, 1024, 64, 4, 2048, bid, G, 64 * 4, true, smem);
    PH_END
    PH_BEGIN
      norm_phase(p, l, 1);
    PH_END
    PH_BEGIN
      gemm_phase<E_SWIGLU, 192>(p, l, p.hb, p.wt_gu + (size_t)l * 2 * DFF * 1024, 1024, 64, 22, 0, bid, G, 64 * 22, true, smem);
    PH_END
    PH_BEGIN
      gemm_phase<E_RES, 192>(p, l, p.act, p.wt_down + (size_t)l * 1024 * DFF, DFF, 64, 4, 5120, bid, G, 64 * 4, true, smem);
    PH_END
  }
  { CP& p = get_params(); final_norm(p); }
}

extern __shared__ __attribute__((aligned(1024))) char dyn_smem[];

__global__ void __launch_bounds__(NTHREADS, 2) k_mega(P p) { forward(dyn_smem); }

extern "C" void kernel_launch(void* const* d_in, const int* in_sizes, int n_in, void* d_out, int out_size, void* d_ws,
                              size_t ws_size, hipStream_t stream) {
  P p{};
  const float** fp = (const float**)&p;
  for (int i = 0; i < 31; ++i) fp[i] = (const float*)d_in[i];
  p.out = (float*)d_out;
  char* ws = (char*)d_ws;
  size_t off = 0;
  auto take = [&](size_t bytes) { char* r = ws + off; off += (bytes + 255) & ~(size_t)255; return r; };
  p.bar = (unsigned*)take(16384);
  p.ctr = (unsigned*)take(16384);
  p.wt_in = (u16*)take((size_t)4 * INWP * 1024 * 2);
  p.wt_uq = (u16*)take((size_t)4 * 768 * 256 * 2);
  p.wt_ukv = (u16*)take((size_t)4 * 1024 * 128 * 2);
  p.wt_out = (u16*)take((size_t)4 * 1024 * 1024 * 2);
  p.wt_gu = (u16*)take((size_t)4 * 2 * DFF * 1024 * 2);
  p.wt_down = (u16*)take((size_t)4 * 1024 * DFF * 2);
  p.mod = (float*)take((size_t)4 * 5 * 6144 * 4);
  p.ropec = (float*)take(2048 * 16 * 4);
  p.ropes = (float*)take(2048 * 16 * 4);
  p.hb = (u16*)take((size_t)NTOK * 1024 * 2);
  p.comb = (u16*)take((size_t)NTOK * DFF * 2);
  p.act = p.comb;
  p.qn = (u16*)take((size_t)NTOK * 256 * 2);
  p.ckvn = (u16*)take((size_t)KVROWS * 128 * 2);
  p.qbuf = (u16*)take((size_t)NTOK * 768 * 2);
  p.knope = (u16*)take((size_t)KVROWS * 512 * 2);
  p.vt = (u16*)take((size_t)KVROWS * 512 * 2);
  p.krope = (u16*)take((size_t)KVROWS * 32 * 2);
  p.xbc = (float*)take((size_t)NTOK * 512 * 4);
  p.dtb = (float*)take((size_t)NTOK * 8 * 4);
  p.ydir = (float*)take((size_t)2 * NTOK * 256 * 4);
  if (off > ws_size) { fprintf(stderr, "workspace too small: need %zu have %zu\n", off, ws_size); return; }

  static int grid_blocks = 0;
  if (!grid_blocks) {
    int dev = 0, cus = 0, per_cu = 0;
    (void)hipGetDevice(&dev);
    (void)hipDeviceGetAttribute(&cus, hipDeviceAttributeMultiprocessorCount, dev);
    (void)hipFuncSetAttribute((const void*)k_mega, hipFuncAttributeMaxDynamicSharedMemorySize, LDS_BYTES);
    (void)hipOccupancyMaxActiveBlocksPerMultiprocessor(&per_cu, (const void*)k_mega, NTHREADS, LDS_BYTES);
    if (per_cu > 1) per_cu = 1;
    if (per_cu < 1) per_cu = 1;
    grid_blocks = cus * per_cu;
  }
  (void)hipMemsetAsync(d_ws, 0, 32768, stream);
  void* args[] = {&p};
  hipError_t e = hipLaunchCooperativeKernel((const void*)k_mega, dim3(grid_blocks), dim3(NTHREADS), args, LDS_BYTES, stream);
  if (e != hipSuccess) fprintf(stderr, "cooperative launch failed: %s (grid %d)\n", hipGetErrorString(e), grid_blocks);
}
```

```cpp
#include <hip/hip_runtime.h>
#include <hip/hip_cooperative_groups.h>
#include <stdint.h>
#include <stdio.h>
namespace cg = cooperative_groups;

#ifndef USE_CG_SYNC
#define USE_CG_SYNC 0
#endif

#define DI __device__ __forceinline__
#define LAS __attribute__((address_space(3)))
typedef unsigned short u16;
typedef __bf16 bf2_t __attribute__((ext_vector_type(2)));
typedef float f2_t __attribute__((ext_vector_type(2)));
using bf16x8 = __attribute__((ext_vector_type(8))) short;
using s16x4 = __attribute__((ext_vector_type(4))) short;
using f32x4 = __attribute__((ext_vector_type(4))) float;
using u32x4 = __attribute__((ext_vector_type(4))) unsigned;
using u32x2 = __attribute__((ext_vector_type(2))) unsigned;

#define MFMA(a, b, c) __builtin_amdgcn_mfma_f32_16x16x32_bf16((a), (b), (c), 0, 0, 0)

constexpr int NTOK = 12288, NCTX = 4096, KVROWS = 13312;
constexpr int INW = 1704, INWP = 1792, DFF = 2816;
constexpr size_t O_CKV = 12582912, O_KR = 14680064, O_SSD = 15204352;
constexpr int LDS_MAIN = 131072;
constexpr int LDS_BYTES = LDS_MAIN + 64;
constexpr int NTHREADS = 512;

struct P {
  const float *x_prompt, *x_sample, *c, *cache_ckv, *cache_krope, *state_ssd, *c_ctx, *w_ada, *b_ada, *g_mix, *w_in,
      *g_q, *w_uq, *g_kv, *w_ukv, *ssd_conv_w, *ssd_conv_b, *ssd_dt_bias, *ssd_a_log, *ssd_d, *ssd_norm_g, *cm_conv_w,
      *cm_conv_b, *cm_ln_g, *cm_ln_b, *w_out, *g_ffn, *w_gate, *w_up, *w_down, *g_final;
  float* out;
  unsigned* bar;
  unsigned* ctr;
  u16 *wt_in, *wt_uq, *wt_ukv, *wt_out, *wt_gu, *wt_down;
  float *mod, *ropec, *ropes;
  u16* hb;
  u16* comb;
  u16* act;
  u16 *qn, *ckvn, *qbuf, *knope, *vt, *krope;
  float *xbc, *dtb, *ydir;
};

typedef const __attribute__((address_space(4))) P CP;
DI CP& get_params() {
  unsigned long long kp = (unsigned long long)__builtin_amdgcn_kernarg_segment_ptr();
  asm volatile("" : "+s"(kp));
  return *(CP*)kp;
}
DI int opaque_tid() { int t = threadIdx.x; asm volatile("" : "+v"(t)); return t; }

DI unsigned pack2(float a, float b) {
  f2_t v = {a, b};
  bf2_t r = __builtin_convertvector(v, bf2_t);
  return __builtin_bit_cast(unsigned, r);
}
DI u16 f2bf(float a) { return (u16)(pack2(a, 0.f) & 0xffffu); }
DI float bf2f(u16 v) { return __uint_as_float(((unsigned)v) << 16); }
DI float frcp(float x) { return __builtin_amdgcn_rcpf(x); }
DI float xrow16_max(float x) {
  auto s = __builtin_amdgcn_permlane16_swap(__float_as_uint(x), __float_as_uint(x), false, false);
  x = fmaxf(__uint_as_float(s[0]), __uint_as_float(s[1]));
  auto t = __builtin_amdgcn_permlane32_swap(__float_as_uint(x), __float_as_uint(x), false, false);
  return fmaxf(__uint_as_float(t[0]), __uint_as_float(t[1]));
}
DI float xrow16_sum(float x) {
  auto s = __builtin_amdgcn_permlane16_swap(__float_as_uint(x), __float_as_uint(x), false, false);
  x = __uint_as_float(s[0]) + __uint_as_float(s[1]);
  auto t = __builtin_amdgcn_permlane32_swap(__float_as_uint(x), __float_as_uint(x), false, false);
  return __uint_as_float(t[0]) + __uint_as_float(t[1]);
}
template <int CTRL> DI float dppf(float x) {
  return __builtin_bit_cast(float, __builtin_amdgcn_mov_dpp(__builtin_bit_cast(int, x), CTRL, 0xf, 0xf, true));
}
DI float wave_sum(float x) {
  x += dppf<0xB1>(x);
  x += dppf<0x4E>(x);
  x += dppf<0x141>(x);
  x += dppf<0x128>(x);
  return xrow16_sum(x);
}
DI float sigmoidf(float x) { return frcp(1.f + __expf(-x)); }
DI float siluf(float x) { return x * frcp(1.f + __expf(-x)); }

#define XB_TMO      128
#define XB_XCNT(j)  (256  + 64 * (j))
#define XB_XSUB(j)  (1280 + 64 * (j))
#define XB_XGEN(j)  (2304 + 64 * (j))
#define XB_TOP      3328
#define XB_TOPGEN   3392
#define XB_SPIN_CAP (1u << 20)
DI unsigned xb_ld(unsigned* p) { return __hip_atomic_load(p, __ATOMIC_RELAXED, __HIP_MEMORY_SCOPE_AGENT); }
DI unsigned xb_add(unsigned* p, unsigned v) { return __hip_atomic_fetch_add(p, v, __ATOMIC_RELAXED, __HIP_MEMORY_SCOPE_AGENT); }
DI unsigned xb_xcc_id() { return (unsigned)__builtin_amdgcn_s_getreg((3 << 11) | 20) & 0xFu; }
#define XB_SPIN(cond, bar) do { unsigned _sp = 0; while (cond) { __builtin_amdgcn_s_sleep(1); \
    if ((++_sp & 255u) == 0u) { if (xb_ld(&(bar)[XB_TMO])) break; if (_sp > XB_SPIN_CAP) { atomicAdd(&(bar)[XB_TMO], 1u); break; } } } } while (0)
struct XcdBarrier { unsigned* bar; unsigned x; volatile LAS unsigned* st; };
DI XcdBarrier xcd_barrier_post(unsigned* bar, volatile LAS unsigned* st) {
  XcdBarrier b; b.bar = bar; b.x = xb_xcc_id(); b.st = st;
  if (threadIdx.x == 0) (void)xb_add(&bar[XB_XCNT(b.x)], 1u);
  return b;
}
DI void xcd_barrier_complete(unsigned* bar, unsigned x, unsigned& nloc, unsigned& nx) {
  const unsigned G = gridDim.x * gridDim.y * gridDim.z;
  unsigned sum, cnt, mine, sp = 0u;
  for (;;) {
    sum = 0u; cnt = 0u; mine = 0u;
#pragma unroll
    for (unsigned j = 0; j < 16; ++j) { const unsigned c = xb_ld(&bar[XB_XCNT(j)]); sum += c; cnt += (c > 0u) ? 1u : 0u; mine = (j == x) ? c : mine; }
    if (sum == G) break;
    __builtin_amdgcn_s_sleep(1);
    if ((++sp & 255u) == 0u) { if (xb_ld(&bar[XB_TMO])) break; if (sp > XB_SPIN_CAP) { atomicAdd(&bar[XB_TMO], 1u); break; } }
  }
  nloc = mine > 0u ? mine : 1u; nx = cnt > 0u ? cnt : 1u;
}
DI void xcd_barrier(const XcdBarrier& b0) {
  asm volatile("s_waitcnt vmcnt(0)" ::: "memory");
  __syncthreads();
  if (threadIdx.x == 0) {
    XcdBarrier b; b.bar = get_params().bar; b.x = xb_xcc_id(); b.st = b0.st;
    unsigned* bar = b.bar;
    __builtin_amdgcn_s_waitcnt(0);
    unsigned nloc = b.st[0], nx = b.st[1];
    if (nloc == 0u) { xcd_barrier_complete(bar, b.x, nloc, nx); b.st[0] = nloc; b.st[1] = nx; }
    const unsigned old = xb_add(&bar[XB_XSUB(b.x)], 1u);
    const unsigned gen = old / nloc;
    if (old + 1u == (gen + 1u) * nloc) {
      __builtin_amdgcn_fence(__ATOMIC_RELEASE, "agent");
      asm volatile("s_waitcnt vmcnt(0)" ::: "memory");
      const unsigned og = xb_add(&bar[XB_TOP], 1u);
      const unsigned tg = og / nx;
      if (og + 1u == (tg + 1u) * nx) xb_add(&bar[XB_TOPGEN], 1u);
      else XB_SPIN(xb_ld(&bar[XB_TOPGEN]) == tg, bar);
      __builtin_amdgcn_fence(__ATOMIC_ACQUIRE, "agent");
      xb_add(&bar[XB_XGEN(b.x)], 1u);
      asm volatile("s_waitcnt vmcnt(0)" ::: "memory");
    } else {
      XB_SPIN(xb_ld(&bar[XB_XGEN(b.x)]) == gen, bar);
      __builtin_amdgcn_fence(__ATOMIC_ACQUIRE, "agent");
      asm volatile("s_waitcnt vmcnt(0)" ::: "memory");
    }
  }
  __syncthreads();
}

enum { E_COMB = 0, E_Q = 1, E_KV = 2, E_RES = 3, E_SWIGLU = 4 };

DI int lds_byte(int r, int c) {
  const int st = (r >> 4) * 2 + (c >> 5), ob = (r & 15) * 64 + (c & 31) * 2;
  return st * 1024 + (ob ^ (((ob >> 9) & 1) << 5));
}
DI void stage_rc(int b, int& R, int& C) {
  const int st = b >> 10, sb = b & 1023, swz = sb ^ (((sb >> 9) & 1) << 5);
  R = (st >> 1) * 16 + swz / 64;
  C = (st & 1) * 32 + (swz % 64) / 2;
}
DI void tile_rc(int t, int nM, int nN, int& pm, int& pn) {
  const int nwg = nM * nN;
  const int q = nwg / 8, r = nwg % 8, xcd = t % 8, off = t / 8;
  const int w = (xcd < r ? xcd * (q + 1) : r * (q + 1) + (xcd - r) * q) + off;
  const int nig = 8 * nN, gid = w / nig, fm = gid * 8;
  const int gsz = (nM - fm) < 8 ? (nM - fm) : 8;
  pm = fm + ((w % nig) % gsz);
  pn = (w % nig) / gsz;
}

DI u32x4 widen16(u32x2 a, u32x2 b) {
  auto s0 = __builtin_amdgcn_permlane16_swap(a[0], b[0], false, false);
  auto s1 = __builtin_amdgcn_permlane16_swap(a[1], b[1], false, false);
  u32x4 r = {s0[0], s1[0], s0[1], s1[1]};
  return r;
}

template <int EPI, int MT>
DI void gemm_epilogue(CP& p, int l, const f32x4 (&acc)[MT][4], int mb, int nb, int goff, int fr, int fq) {
  if (EPI == E_COMB || EPI == E_Q || EPI == E_SWIGLU) {
    const int tsel = fq & 1, csel = (fq >> 1) * 8;
#pragma unroll
    for (int mi = 0; mi < MT; ++mi) {
      const int m = mb + mi * 16 + fr;
      if (EPI == E_SWIGLU) {
        u32x2 r[2];
#pragma unroll
        for (int q = 0; q < 2; ++q) {
          const f32x4 gv = acc[mi][2 * q], uv = acc[mi][2 * q + 1];
          r[q] = (u32x2){pack2(siluf(gv[0]) * uv[0], siluf(gv[1]) * uv[1]), pack2(siluf(gv[2]) * uv[2], siluf(gv[3]) * uv[3])};
        }
        const u32x4 w = widen16(r[0], r[1]);
        *(u32x4*)(p.act + (size_t)m * DFF + (nb >> 1) + tsel * 16 + csel) = w;
      } else {
#pragma unroll
        for (int q = 0; q < 2; ++q) {
          const f32x4 va = acc[mi][2 * q], vb = acc[mi][2 * q + 1];
          const u32x2 a = {pack2(va[0], va[1]), pack2(va[2], va[3])};
          const u32x2 b = {pack2(vb[0], vb[1]), pack2(vb[2], vb[3])};
          const u32x4 w = widen16(a, b);
          const int n = nb + (2 * q + tsel) * 16 + csel;
          if (EPI == E_COMB) { if (n < INW) *(u32x4*)(p.comb + (size_t)m * INW + n) = w; }
          else *(u32x4*)(p.qbuf + (size_t)m * 768 + n) = w;
        }
      }
    }
    return;
  }
#pragma unroll
  for (int mi = 0; mi < MT; ++mi) {
    const int m = mb + mi * 16 + fr;
#pragma unroll
    for (int ni = 0; ni < 4; ++ni) {
      const int n = nb + ni * 16 + fq * 4;
      const f32x4 v = acc[mi][ni];
      if (EPI == E_COMB) {
        if (n < INW) { u32x2 o = {pack2(v[0], v[1]), pack2(v[2], v[3])}; *(u32x2*)(p.comb + (size_t)m * INW + n) = o; }
      } else if (EPI == E_Q) {
        u32x2 o = {pack2(v[0], v[1]), pack2(v[2], v[3])};
        *(u32x2*)(p.qbuf + (size_t)m * 768 + n) = o;
      } else if (EPI == E_KV) {
        const int hh = n >> 7, c = n & 127;
        if (c < 64) {
          u32x2 o = {pack2(v[0], v[1]), pack2(v[2], v[3])};
          *(u32x2*)(p.knope + (size_t)m * 512 + hh * 64 + c) = o;
        } else {
          int kvbase, Tk;
          if (m < NCTX) { kvbase = m & ~255; Tk = 256; }
          else { const int b = (m - NCTX) / 2304; kvbase = NCTX + b * 2304; Tk = 2304; }
          u16* dst = p.vt + (size_t)512 * kvbase + (size_t)(hh * 64 + (c - 64)) * Tk + (m - kvbase);
#pragma unroll
          for (int i = 0; i < 4; ++i) dst[(size_t)i * Tk] = f2bf(v[i]);
        }
      } else if (EPI == E_RES) {
        const int vs = m < NCTX ? 0 : 1 + ((m - NCTX) >> 11);
        const f32x4 gt = *(const f32x4*)(p.mod + (size_t)(l * 5 + vs) * 6144 + goff + n);
        float* xp = p.out + (size_t)m * 1024 + n;
        const float* xs = xp;
        if (l == 0 && goff == 2048) xs = (m < NCTX ? p.x_prompt + (size_t)m * 1024 : p.x_sample + (size_t)(m - NCTX) * 1024) + n;
        f32x4 xv = *(const f32x4*)xs;
        xv += gt * v;
        *(f32x4*)xp = xv;
      } else if (EPI == E_SWIGLU) {
        if ((ni & 1) == 0) {
          const f32x4 u = acc[mi][ni + 1];
          u32x2 o = {pack2(siluf(v[0]) * u[0], siluf(v[1]) * u[1]), pack2(siluf(v[2]) * u[2], siluf(v[3]) * u[3])};
          *(u32x2*)(p.act + (size_t)m * DFF + ((nb + ni * 16) >> 1) + fq * 4) = o;
        }
      }
    }
  }
}

#define GEMM_STAGE(buf, Ap, Wp, kt) do {                                                                                  \
    _Pragma("unroll") for (int i = 0; i < GLA; ++i)                                                                       \
      __builtin_amdgcn_global_load_lds((const unsigned*)((Ap) + (size_t)sR[i] * K + (kt) * 64 + sC[i]),                    \
                                       (LAS unsigned*)(ls + (buf) * STAGE_B + wid * 1024 + i * 8192), 16, 0, 0);         \
    _Pragma("unroll") for (int i = 0; i < 4; ++i)                                                                         \
      __builtin_amdgcn_global_load_lds((const unsigned*)((Wp) + (size_t)sR[i] * K + (kt) * 64 + sC[i]),                    \
                                       (LAS unsigned*)(ls + (buf) * STAGE_B + TILE_A + wid * 1024 + i * 8192), 16, 0, 0); \
  } while (0)

template <int EPI, int BM>
DI void gemm_phase(CP& p, int l, const u16* __restrict__ A, const u16* __restrict__ W, int K, int nM, int nN, int goff,
                   int t0, int tstride, int ntiles, bool raster, char* smem) {
  const int tid = opaque_tid(), lane = tid & 63, wid = tid >> 6;
  const int wr = wid >> 2, wc = wid & 3, fr = lane & 15, fq = lane >> 4;
  constexpr int MT = BM / 32, GLA = BM / 64;
  constexpr int TILE_A = BM * 128, TILE_B = 256 * 128, STAGE_B = TILE_A + TILE_B;
  LAS char* ls = (LAS char*)smem;
  int sR[4], sC[4];
#pragma unroll
  for (int i = 0; i < 4; ++i) stage_rc(wid * 1024 + i * 8192 + lane * 16, sR[i], sC[i]);
  int t = t0;
  if (t >= ntiles) return;
  int pm, pn;
  if (raster) tile_rc(t, nM, nN, pm, pn); else { pn = t / nM; pm = t - pn * nM; }
  const u16* Ab = A + (size_t)pm * BM * K;
  const u16* Wb = W + (size_t)pn * 256 * K;
  const int nt = K >> 6;
  const int obf = fr * 64 + fq * 16, swzf = obf ^ (((obf >> 9) & 1) << 5);
  const char* fragA = smem + wr * (BM / 32) * 2048 + swzf;
  const char* fragB = smem + TILE_A + wc * 4 * 2048 + swzf;
  __syncthreads();
  GEMM_STAGE(0, Ab, Wb, 0);
  asm volatile("s_waitcnt vmcnt(0)" ::: "memory");
  __syncthreads();
  for (;;) {
    const int tn = t + tstride;
    const bool has_next = tn < ntiles;
    int pmn = 0, pnn = 0;
    if (has_next) { if (raster) tile_rc(tn, nM, nN, pmn, pnn); else { pnn = tn / nM; pmn = tn - pnn * nM; } }
    const u16* Abn = A + (size_t)pmn * BM * K;
    const u16* Wbn = W + (size_t)pnn * 256 * K;
    f32x4 acc[MT][4];
#pragma unroll
    for (int m = 0; m < MT; ++m)
#pragma unroll
      for (int n = 0; n < 4; ++n) acc[m][n] = (f32x4){0.f, 0.f, 0.f, 0.f};
    for (int kt = 0; kt < nt; ++kt) {
      const int cur = kt & 1;
      if (kt + 1 < nt) GEMM_STAGE(cur ^ 1, Ab, Wb, kt + 1);
      else if (has_next) GEMM_STAGE(cur ^ 1, Abn, Wbn, 0);
      const char* sa = fragA + cur * STAGE_B;
      const char* sb = fragB + cur * STAGE_B;
#pragma unroll
      for (int ks = 0; ks < 2; ++ks) {
        bf16x8 At[MT], Bf[4];
#pragma unroll
        for (int m = 0; m < MT; ++m) At[m] = *(const bf16x8*)(sa + m * 2048 + ks * 1024);
#pragma unroll
        for (int n = 0; n < 4; ++n) Bf[n] = *(const bf16x8*)(sb + n * 2048 + ks * 1024);
        __builtin_amdgcn_s_setprio(1);
#pragma unroll
        for (int m = 0; m < MT; ++m)
#pragma unroll
          for (int n = 0; n < 4; ++n) acc[m][n] = MFMA(Bf[n], At[m], acc[m][n]);
        __builtin_amdgcn_s_setprio(0);
        __builtin_amdgcn_sched_barrier(0);
      }
      if (kt + 1 < nt) {
        asm volatile("s_waitcnt vmcnt(0)" ::: "memory");
        __syncthreads();
      }
    }
    gemm_epilogue<EPI, MT>(p, l, acc, pm * BM + wr * (BM / 2), pn * 256 + wc * 64, goff, fr, fq);
    asm volatile("s_waitcnt vmcnt(0)" ::: "memory");
    __syncthreads();
    if (!has_next) break;
    t = tn; pm = pmn; pn = pnn; Ab = Abn; Wb = Wbn;
  }
}
#undef GEMM_STAGE

DI void conv_wtile(const float* __restrict__ src, int K, int N, u16* __restrict__ dst, int rowmul, int rowoff, int kt,
                   int nt, LAS float* wt, int lane) {
  const int k0 = kt * 32, n0 = nt * 64;
  float v[32];
  const bool ok = n0 + lane < N;
  const float* sp = src + (size_t)k0 * N + n0 + lane;
#pragma unroll
  for (int i = 0; i < 32; ++i) v[i] = ok ? sp[(size_t)i * N] : 0.f;
#pragma unroll
  for (int i = 0; i < 32; ++i) wt[i * 65 + lane] = v[i];
#pragma unroll
  for (int i = 0; i < 16; ++i) {
    const int n = i * 4 + (lane >> 4), kp = lane & 15;
    const float lo = wt[(2 * kp) * 65 + n], hi = wt[(2 * kp + 1) * 65 + n];
    const int nn = n0 + n;
    const int drow = rowmul == 1 ? nn : ((nn >> 4) << 5) + (nn & 15) + 16 * rowoff;
    *(unsigned*)(dst + (size_t)drow * K + k0 + 2 * kp) = pack2(lo, hi);
  }
}

DI void conv_dispatch(CP& p, int l, int r, LAS float* wt, int lane) {
  if (r < 896) {
    conv_wtile(p.w_in + (size_t)l * 1024 * INW, 1024, INW, p.wt_in + (size_t)l * INWP * 1024, 1, 0, r & 31, r >> 5, wt, lane);
  } else if ((r -= 896) < 96) {
    conv_wtile(p.w_uq + (size_t)l * 256 * 768, 256, 768, p.wt_uq + (size_t)l * 768 * 256, 1, 0, r & 7, r >> 3, wt, lane);
  } else if ((r -= 96) < 64) {
    conv_wtile(p.w_ukv + (size_t)l * 128 * 1024, 128, 1024, p.wt_ukv + (size_t)l * 1024 * 128, 1, 0, r & 3, r >> 2, wt, lane);
  } else if ((r -= 64) < 512) {
    conv_wtile(p.w_out + (size_t)l * 1024 * 1024, 1024, 1024, p.wt_out + (size_t)l * 1024 * 1024, 1, 0, r & 31, r >> 5, wt, lane);
  } else if ((r -= 512) < 1408) {
    conv_wtile(p.w_gate + (size_t)l * 1024 * DFF, 1024, DFF, p.wt_gu + (size_t)l * 2 * DFF * 1024, 2, 0, r & 31, r >> 5, wt, lane);
  } else if ((r -= 1408) < 1408) {
    conv_wtile(p.w_up + (size_t)l * 1024 * DFF, 1024, DFF, p.wt_gu + (size_t)l * 2 * DFF * 1024, 2, 1, r & 31, r >> 5, wt, lane);
  } else {
    r -= 1408;
    conv_wtile(p.w_down + (size_t)l * DFF * 1024, DFF, 1024, p.wt_down + (size_t)l * 1024 * DFF, 1, 0, r % 88, r / 88, wt, lane);
  }
}

DI void conv_fill(CP& p, int l, int r_lo, int r_hi, unsigned* ctr, int* slot, char* smem) {
  const int tid = opaque_tid(), lane = tid & 63, wave = tid >> 6;
  LAS float* wt = (LAS float*)smem + wave * (32 * 65);
  const int nitems = (r_hi - r_lo + 7) >> 3;
  for (;;) {
    __syncthreads();
    if (tid == 0) *slot = (int)atomicAdd(ctr, 1u);
    __syncthreads();
    const int it = *slot;
    if (it >= nitems) break;
    const int r = r_lo + it * 8 + wave;
    if (r < r_hi) conv_dispatch(p, l, r, wt, lane);
  }
}

DI void phase0(CP& p, char* smem) {
  const int tid = opaque_tid();
  const int G = gridDim.x, bid = blockIdx.x;
  {
    const int lane = tid & 63, wave = tid >> 6;
    LAS float* wt = (LAS float*)smem + wave * (32 * 65);
    __syncthreads();
    for (int idx = bid * 8 + wave; idx < 5792; idx += G * 8) conv_dispatch(p, 0, idx, wt, lane);
  }
  {
    float* scond = (float*)(smem + 32768);
    float* red = scond + 5120;
    __syncthreads();
    for (int i = tid; i < 5120; i += NTHREADS) {
      const int v = i >> 10, k = i & 1023;
      const float x = v == 0 ? p.c_ctx[k] : p.c[(v - 1) * 1024 + k];
      scond[i] = siluf(x);
    }
    __syncthreads();
    for (int job = bid; job < 384; job += G) {
      const int l = job / 96, chunk = job - l * 96;
      const int c = tid & 63, kg = tid >> 6, col = chunk * 64 + c;
      float a0 = 0.f, a1 = 0.f, a2 = 0.f, a3 = 0.f, a4 = 0.f;
      const float* w = p.w_ada + ((size_t)l * 1024 + kg * 128) * 6144 + col;
      const float* sc = scond + kg * 128;
#pragma unroll 32
      for (int k = 0; k < 128; ++k) {
        const float wv = w[(size_t)k * 6144];
        a0 += sc[k] * wv; a1 += sc[1024 + k] * wv; a2 += sc[2048 + k] * wv; a3 += sc[3072 + k] * wv; a4 += sc[4096 + k] * wv;
      }
      red[(kg * 5 + 0) * 64 + c] = a0; red[(kg * 5 + 1) * 64 + c] = a1; red[(kg * 5 + 2) * 64 + c] = a2;
      red[(kg * 5 + 3) * 64 + c] = a3; red[(kg * 5 + 4) * 64 + c] = a4;
      __syncthreads();
      if (kg == 0) {
        const float bb = p.b_ada[l * 6144 + col];
#pragma unroll
        for (int v = 0; v < 5; ++v) {
          float s = 0.f;
#pragma unroll
          for (int q = 0; q < 8; ++q) s += red[(q * 5 + v) * 64 + c];
          p.mod[(size_t)(l * 5 + v) * 6144 + col] = s + bb;
        }
      }
      __syncthreads();
    }
  }
  for (int i = bid * NTHREADS + tid; i < 2048 * 16; i += G * NTHREADS) {
    const int t = i >> 4, a = (i >> 3) & 1, f = i & 7;
    const float pos = a == 0 ? (float)(t >> 6) : (float)(t & 63);
    const float inv = powf(10000.0f, -(float)f / 8.0f);
    const float ang = pos * inv;
    p.ropec[i] = cosf(ang);
    p.ropes[i] = sinf(ang);
  }
}

DI void norm_phase(CP& p, int l, int which) {
  const int tid = opaque_tid(), lane = tid & 63, wave = tid >> 6;
  const float* gw = (which == 0 ? p.g_mix : p.g_ffn) + l * 1024;
  const int shoff = which == 0 ? 0 : 3072, scoff = shoff + 1024;
  f32x4 gg[4];
#pragma unroll
  for (int i = 0; i < 4; ++i) gg[i] = *(const f32x4*)(gw + i * 256 + lane * 4);
  const int stride = gridDim.x * 8;
  for (int tok0 = blockIdx.x * 8 + wave; tok0 < NTOK; tok0 += 2 * stride) {
    f32x4 v[2][4], sc[2][4], sh[2][4];
    bool ok[2];
#pragma unroll
    for (int a = 0; a < 2; ++a) {
      const int tok = tok0 + a * stride;
      ok[a] = tok < NTOK;
      const int tk = ok[a] ? tok : tok0;
      const float* xr = p.out + (size_t)tk * 1024;
      if (l == 0 && which == 0) xr = tk < NCTX ? p.x_prompt + (size_t)tk * 1024 : p.x_sample + (size_t)(tk - NCTX) * 1024;
      const int vs = tk < NCTX ? 0 : 1 + ((tk - NCTX) >> 11);
      const float* md = p.mod + (size_t)(l * 5 + vs) * 6144;
#pragma unroll
      for (int i = 0; i < 4; ++i) {
        const int col = i * 256 + lane * 4;
        v[a][i] = *(const f32x4*)(xr + col);
        sc[a][i] = *(const f32x4*)(md + scoff + col);
        sh[a][i] = *(const f32x4*)(md + shoff + col);
      }
    }
#pragma unroll
    for (int a = 0; a < 2; ++a) {
      const int tok = tok0 + a * stride;
      float ss = 0.f;
#pragma unroll
      for (int i = 0; i < 4; ++i) ss += v[a][i][0] * v[a][i][0] + v[a][i][1] * v[a][i][1] + v[a][i][2] * v[a][i][2] + v[a][i][3] * v[a][i][3];
      ss = wave_sum(ss);
      const float rstd = rsqrtf(ss * (1.f / 1024.f) + 1e-6f);
      if (ok[a]) {
#pragma unroll
        for (int i = 0; i < 4; ++i) {
          const int col = i * 256 + lane * 4;
          f32x4 o;
#pragma unroll
          for (int j = 0; j < 4; ++j) o[j] = v[a][i][j] * rstd * gg[i][j] * (1.f + sc[a][i][j]) + sh[a][i][j];
          u32x2 pk = {pack2(o[0], o[1]), pack2(o[2], o[3])};
          *(u32x2*)(p.hb + (size_t)tok * 1024 + col) = pk;
        }
      }
    }
  }
}

DI void final_norm(CP& p) {
  const int tid = opaque_tid(), lane = tid & 63, wave = tid >> 6;
  f32x4 gg[4];
#pragma unroll
  for (int i = 0; i < 4; ++i) gg[i] = *(const f32x4*)(p.g_final + i * 256 + lane * 4);
  const int stride = gridDim.x * 8;
  for (int tok0 = blockIdx.x * 8 + wave; tok0 < NTOK; tok0 += 2 * stride) {
    f32x4 v[2][4];
    bool ok[2];
#pragma unroll
    for (int a = 0; a < 2; ++a) {
      const int tok = tok0 + a * stride;
      ok[a] = tok < NTOK;
      const float* xr = p.out + (size_t)(ok[a] ? tok : tok0) * 1024;
#pragma unroll
      for (int i = 0; i < 4; ++i) v[a][i] = *(const f32x4*)(xr + i * 256 + lane * 4);
    }
#pragma unroll
    for (int a = 0; a < 2; ++a) {
      const int tok = tok0 + a * stride;
      float ss = 0.f;
#pragma unroll
      for (int i = 0; i < 4; ++i) ss += v[a][i][0] * v[a][i][0] + v[a][i][1] * v[a][i][1] + v[a][i][2] * v[a][i][2] + v[a][i][3] * v[a][i][3];
      ss = wave_sum(ss);
      const float rstd = rsqrtf(ss * (1.f / 1024.f) + 1e-6f);
      if (ok[a]) {
        float* xr = p.out + (size_t)tok * 1024;
#pragma unroll
        for (int i = 0; i < 4; ++i) {
          f32x4 o;
#pragma unroll
          for (int j = 0; j < 4; ++j) o[j] = v[a][i][j] * rstd * gg[i][j];
          *(f32x4*)(xr + i * 256 + lane * 4) = o;
        }
      }
    }
  }
}

DI void prep_cache_row(CP& p, int l, int row) {
  const int lane = opaque_tid() & 63;
  {
    const int r = row - NTOK, b = r >> 8, j = r & 255;
    const int kvrow = NCTX + b * 2304 + j;
    const float* ck = p.cache_ckv + ((size_t)(b * 4 + l) * 256 + j) * 128;
    const f2_t v = *(const f2_t*)(ck + lane * 2);
    *(unsigned*)(p.ckvn + (size_t)kvrow * 128 + lane * 2) = pack2(v[0], v[1]);
    if (lane < 16) {
      const float* kr = p.cache_krope + ((size_t)(b * 4 + l) * 256 + j) * 32;
      const f2_t w = *(const f2_t*)(kr + lane * 2);
      *(unsigned*)(p.krope + (size_t)kvrow * 32 + lane * 2) = pack2(w[0], w[1]);
    }
  }
}

constexpr int PSTR = 1192;
struct PrepW { f32x4 gq; f2_t gkv; float cw[8][5]; float cb[8]; float dtb; };
DI void prep_load_w(CP& p, int l, int lane, PrepW& w) {
  w.gq = *(const f32x4*)(p.g_q + l * 256 + lane * 4);
  w.gkv = *(const f2_t*)(p.g_kv + l * 128 + lane * 2);
  const float* cw = p.ssd_conv_w + (size_t)l * 5 * 512;
  const float* cb = p.ssd_conv_b + l * 512;
#pragma unroll
  for (int i = 0; i < 8; ++i) {
    w.cb[i] = cb[i * 64 + lane];
#pragma unroll
    for (int j = 0; j < 5; ++j) w.cw[i][j] = cw[j * 512 + i * 64 + lane];
  }
  w.dtb = p.ssd_dt_bias[l * 8 + (lane & 7)];
}
DI void prep_row(CP& p, int l, int tok, const LAS float* cr, const PrepW& w, int lane) {
  int b, t, T, kvrow;
  const bool lat = tok >= NCTX;
  if (!lat) { b = tok >> 8; t = tok & 255; T = 256; kvrow = tok; }
  else { const int q = tok - NCTX; b = q >> 11; t = q & 2047; T = 2048; kvrow = NCTX + b * 2304 + 256 + t; }
  {
    const f32x4 v = *(const LAS f32x4*)(cr + lane * 4);
    float ss = v[0] * v[0] + v[1] * v[1] + v[2] * v[2] + v[3] * v[3];
    ss = wave_sum(ss);
    const float rstd = rsqrtf(ss * (1.f / 256.f) + 1e-6f);
    const f32x4 gg = w.gq;
    u32x2 pk = {pack2(v[0] * rstd * gg[0], v[1] * rstd * gg[1]), pack2(v[2] * rstd * gg[2], v[3] * rstd * gg[3])};
    *(u32x2*)(p.qn + (size_t)tok * 256 + lane * 4) = pk;
  }
  {
    const f2_t v = *(const LAS f2_t*)(cr + 256 + lane * 2);
    float ss = v[0] * v[0] + v[1] * v[1];
    ss = wave_sum(ss);
    const float rstd = rsqrtf(ss * (1.f / 128.f) + 1e-6f);
    const f2_t gg = w.gkv;
    const float o0 = v[0] * rstd * gg[0], o1 = v[1] * rstd * gg[1];
    *(unsigned*)(p.ckvn + (size_t)kvrow * 128 + lane * 2) = pack2(o0, o1);
    if (!lat) {
      f2_t o = {o0, o1};
      *(f2_t*)(p.out + O_CKV + ((size_t)(b * 4 + l) * 256 + t) * 128 + lane * 2) = o;
    }
  }
  if (lane < 16) {
    const int a = lane >> 3, f = lane & 7;
    const float x1 = cr[384 + a * 16 + f], x2 = cr[384 + a * 16 + 8 + f];
    float o1 = x1, o2 = x2;
    if (!lat) {
      float* dst = p.out + O_KR + ((size_t)(b * 4 + l) * 256 + t) * 32;
      dst[a * 16 + f] = x1;
      dst[a * 16 + 8 + f] = x2;
    } else {
      const float c = p.ropec[t * 16 + a * 8 + f], s = p.ropes[t * 16 + a * 8 + f];
      o1 = x1 * c - x2 * s;
      o2 = x2 * c + x1 * s;
    }
    p.krope[(size_t)kvrow * 32 + a * 16 + f] = f2bf(o1);
    p.krope[(size_t)kvrow * 32 + a * 16 + 8 + f] = f2bf(o2);
  }
  {
#pragma unroll
    for (int i = 0; i < 8; ++i) {
      const int c = i * 64 + lane;
      float acc = w.cb[i];
#pragma unroll
      for (int j = 0; j < 5; ++j) {
        acc += w.cw[i][j] * cr[(j - 2) * PSTR + 672 + c];
      }
      p.xbc[(size_t)tok * 512 + c] = siluf(acc);
    }
  }
  if (lane < 8) {
    const float x = cr[1184 + lane] + w.dtb;
    const float sp = x > 20.f ? x : log1pf(expf(x));
    p.dtb[(size_t)tok * 8 + lane] = sp;
  }
}

DI void prep_tile(CP& p, int l, int ti, char* smem) {
  const int tid = opaque_tid(), wave = tid >> 6;
  int base, t0, T;
  if (ti < 256) { base = (ti >> 4) * 256; t0 = (ti & 15) * 16; T = 256; }
  else { const int j = ti - 256; base = NCTX + (j >> 7) * 2048; t0 = (j & 127) * 16; T = 2048; }
  LAS float* sr = (LAS float*)smem;
  const int lane = tid & 63;
  PrepW pw;
  prep_load_w(p, l, lane, pw);
  __syncthreads();
  u32x4 stg[6];
#pragma unroll
  for (int i = 0; i < 6; ++i) {
    const int idx = tid + i * 512;
    const int row = idx / 149, c8 = idx - row * 149;
    const int t = t0 - 2 + row;
    stg[i] = (u32x4){0u, 0u, 0u, 0u};
    if (idx < 2980 && t >= 0 && t < T) stg[i] = *(const u32x4*)(p.comb + (size_t)(base + t) * INW + c8 * 8);
  }
#pragma unroll
  for (int i = 0; i < 6; ++i) {
    const int idx = tid + i * 512;
    const int row = idx / 149, c8 = idx - row * 149;
    if (idx < 2980) {
      f32x4 lo, hi;
      lo[0] = __uint_as_float(stg[i][0] << 16); lo[1] = __uint_as_float(stg[i][0] & 0xffff0000u);
      lo[2] = __uint_as_float(stg[i][1] << 16); lo[3] = __uint_as_float(stg[i][1] & 0xffff0000u);
      hi[0] = __uint_as_float(stg[i][2] << 16); hi[1] = __uint_as_float(stg[i][2] & 0xffff0000u);
      hi[2] = __uint_as_float(stg[i][3] << 16); hi[3] = __uint_as_float(stg[i][3] & 0xffff0000u);
      *(LAS f32x4*)(sr + row * PSTR + c8 * 8) = lo;
      *(LAS f32x4*)(sr + row * PSTR + c8 * 8 + 4) = hi;
    }
  }
  __syncthreads();
#pragma unroll
  for (int i = 0; i < 2; ++i) {
    const int tt = wave * 2 + i;
    prep_row(p, l, base + t0 + tt, sr + (tt + 2) * PSTR, pw, lane);
  }
}

DI void cm_tile(CP& p, int l, int ti, char* smem) {
  const int tid = opaque_tid(), lane = tid & 63, wave = tid >> 6;
  int base, t0, T;
  if (ti < 128) { base = (ti >> 3) * 256; t0 = (ti & 7) * 32; T = 256; }
  else { const int j = ti - 128; base = NCTX + (j >> 6) * 2048; t0 = (j & 63) * 32; T = 2048; }
  LAS float* sg = (LAS float*)smem;
  LAS float* so = sg + 62 * 256;
  const int c = tid & 255, half = tid >> 8;
  float w[31];
#pragma unroll
  for (int j = 0; j < 31; ++j) w[j] = p.cm_conv_w[(size_t)(l * 31 + j) * 256 + c];
  const float bias = p.cm_conv_b[l * 256 + c];
  __syncthreads();
  {
    u32x4 ra[4], rb[4];
#pragma unroll
    for (int i = 0; i < 4; ++i) {
      const int idx = tid + i * 512;
      const int r = idx >> 5, c8 = idx & 31;
      const int t = t0 - 15 + r;
      ra[i] = (u32x4){0u, 0u, 0u, 0u}; rb[i] = (u32x4){0u, 0u, 0u, 0u};
      if (idx < 62 * 32 && t >= 0 && t < T) {
        const u16* cr = p.comb + (size_t)(base + t) * INW;
        ra[i] = *(const u32x4*)(cr + 1192 + c8 * 8);
        rb[i] = *(const u32x4*)(cr + 1448 + c8 * 8);
      }
    }
#pragma unroll
    for (int i = 0; i < 4; ++i) {
      const int idx = tid + i * 512;
      const int r = idx >> 5, c8 = idx & 31;
      if (idx < 62 * 32) {
        f32x4 lo, hi;
#pragma unroll
        for (int q = 0; q < 2; ++q) {
          lo[2 * q] = __uint_as_float(ra[i][q] << 16) * sigmoidf(__uint_as_float(rb[i][q] << 16));
          lo[2 * q + 1] = __uint_as_float(ra[i][q] & 0xffff0000u) * sigmoidf(__uint_as_float(rb[i][q] & 0xffff0000u));
          hi[2 * q] = __uint_as_float(ra[i][q + 2] << 16) * sigmoidf(__uint_as_float(rb[i][q + 2] << 16));
          hi[2 * q + 1] = __uint_as_float(ra[i][q + 2] & 0xffff0000u) * sigmoidf(__uint_as_float(rb[i][q + 2] & 0xffff0000u));
        }
        *(LAS f32x4*)(sg + r * 256 + c8 * 8) = lo;
        *(LAS f32x4*)(sg + r * 256 + c8 * 8 + 4) = hi;
      }
    }
  }
  __syncthreads();
#pragma unroll 1
  for (int t4 = 0; t4 < 4; ++t4) {
    const int tb = half * 16 + t4 * 4;
    float a0 = bias, a1 = bias, a2 = bias, a3 = bias;
#pragma unroll
    for (int j = 0; j < 34; ++j) {
      const float x = sg[(tb + j) * 256 + c];
      if (j < 31) a0 += w[j] * x;
      if (j >= 1 && j < 32) a1 += w[j - 1] * x;
      if (j >= 2 && j < 33) a2 += w[j - 2] * x;
      if (j >= 3) a3 += w[j - 3] * x;
    }
    so[tb * 256 + c] = a0;
    so[(tb + 1) * 256 + c] = a1;
    so[(tb + 2) * 256 + c] = a2;
    so[(tb + 3) * 256 + c] = a3;
  }
  __syncthreads();
  {
    float lg[4], lb[4];
#pragma unroll
    for (int i = 0; i < 4; ++i) { lg[i] = p.cm_ln_g[l * 256 + lane + 64 * i]; lb[i] = p.cm_ln_b[l * 256 + lane + 64 * i]; }
#pragma unroll
    for (int tt = 0; tt < 4; ++tt) {
      const int t = wave * 4 + tt;
      float v[4];
      float sm = 0.f;
#pragma unroll
      for (int i = 0; i < 4; ++i) { v[i] = so[t * 256 + lane + 64 * i]; sm += v[i]; }
      const float mean = wave_sum(sm) * (1.f / 256.f);
      float q = 0.f;
#pragma unroll
      for (int i = 0; i < 4; ++i) { const float d = v[i] - mean; q += d * d; }
      const float var = wave_sum(q) * (1.f / 256.f);
      const float rstd = rsqrtf(var + 1e-5f);
#pragma unroll
      for (int i = 0; i < 4; ++i) {
        const int cc = lane + 64 * i;
        float y = (v[i] - mean) * rstd * lg[i] + lb[i];
        y = siluf(y);
        p.hb[(size_t)(base + t0 + t) * 1024 + 768 + cc] = f2bf(y);
      }
    }
  }
}

DI void ssd_item(CP& p, int l, int seq, int h, int dir, char* smem) {
  const int tid = opaque_tid(), lane = tid & 63, wave = tid >> 6, lr = lane & 15, g = lane >> 4;
  const int rt = wave & 3, ch = wave >> 2;
  const bool lat = seq >= 16;
  const int b = lat ? seq - 16 : seq;
  const int T = lat ? 2048 : 256;
  const int qbase = lat ? NCTX + b * 2048 : b * 256;
  u16* sC = (u16*)smem;
  u16* sB = sC + 64 * 72;
  u16* sBt = sB + 64 * 72;
  u16* sXt = sBt + 64 * 72;
  u16* sXw = sXt + 64 * 72;
  u16* sM = sXw + 64 * 72;
  u16* sH = sM + 64 * 72;
  float* sdtA = (float*)(sH + 64 * 72);
  float* sacsA = sdtA + 2048;
  const float Aneg = -expf(p.ssd_a_log[(l * 2 + dir) * 4 + h]);
  const int grp = h >> 1;
  f32x4 hacc[2];
  if (lat) {
    const float* src = p.state_ssd + ((size_t)(((b * 4 + l) * 2 + dir) * 4 + h)) * 4096;
#pragma unroll
    for (int n2 = 0; n2 < 2; ++n2)
#pragma unroll
      for (int i = 0; i < 4; ++i) hacc[n2][i] = src[(rt * 16 + g * 4 + i) * 64 + (ch * 2 + n2) * 16 + lr];
  } else {
#pragma unroll
    for (int n2 = 0; n2 < 2; ++n2) hacc[n2] = (f32x4){0.f, 0.f, 0.f, 0.f};
  }
  __syncthreads();
#pragma unroll
  for (int n2 = 0; n2 < 2; ++n2)
#pragma unroll
    for (int i = 0; i < 4; ++i) sH[(rt * 16 + g * 4 + i) * 72 + (ch * 2 + n2) * 16 + lr] = f2bf(hacc[n2][i]);
  const int nch = T >> 6;
  {
    float dv[4];
#pragma unroll
    for (int i = 0; i < 4; ++i) {
      const int cq = wave + 8 * i;
      dv[i] = cq < nch ? p.dtb[(size_t)(qbase + cq * 64 + lane) * 8 + dir * 4 + h] : 0.f;
    }
#pragma unroll
    for (int i = 0; i < 4; ++i) {
      const int cq = wave + 8 * i;
      float sc = dv[i] * Aneg;
      if (!dir) {
#pragma unroll
        for (int o = 1; o < 64; o <<= 1) { const float tv = __shfl_up(sc, o); if (lane >= o) sc += tv; }
      } else {
#pragma unroll
        for (int o = 1; o < 64; o <<= 1) { const float tv = __shfl_down(sc, o); if (lane + o < 64) sc += tv; }
      }
      if (cq < nch) { sdtA[cq * 64 + lane] = dv[i]; sacsA[cq * 64 + lane] = sc; }
    }
  }
  const int r = tid >> 3, cc = (tid & 7) * 8;
  f32x4 xv[2], bv[2], cv[2];
  {
    const int c0 = dir ? nch - 1 : 0;
    const float* rowp = p.xbc + (size_t)(qbase + c0 * 64 + r) * 512;
#pragma unroll
    for (int i = 0; i < 2; ++i) {
      xv[i] = *(const f32x4*)(rowp + h * 64 + cc + i * 4);
      bv[i] = *(const f32x4*)(rowp + 256 + grp * 64 + cc + i * 4);
      cv[i] = *(const f32x4*)(rowp + 384 + grp * 64 + cc + i * 4);
    }
  }
  __syncthreads();
#pragma unroll 1
  for (int ci = 0; ci < nch; ++ci) {
    const int c = dir ? nch - 1 - ci : ci;
    const int tok0 = qbase + c * 64;
    const float* sdt = sdtA + c * 64;
    const float* sacs = sacsA + c * 64;
    const float total = dir ? sacs[0] : sacs[63];
    const float wr = __expf(total - sacs[r]) * sdt[r];
    {
      u32x4 c0 = {pack2(cv[0][0], cv[0][1]), pack2(cv[0][2], cv[0][3]), pack2(cv[1][0], cv[1][1]), pack2(cv[1][2], cv[1][3])};
      *(u32x4*)(sC + r * 72 + cc) = c0;
      u32x4 b0 = {pack2(bv[0][0], bv[0][1]), pack2(bv[0][2], bv[0][3]), pack2(bv[1][0], bv[1][1]), pack2(bv[1][2], bv[1][3])};
      *(u32x4*)(sB + r * 72 + cc) = b0;
#pragma unroll
      for (int i = 0; i < 2; ++i)
#pragma unroll
        for (int j = 0; j < 4; ++j) {
          const int e = cc + i * 4 + j;
          sBt[e * 72 + r] = f2bf(bv[i][j]);
          sXt[e * 72 + r] = f2bf(xv[i][j]);
          sXw[e * 72 + r] = f2bf(xv[i][j] * wr);
        }
    }
    if (ci + 1 < nch) {
      const int cn = dir ? nch - 2 - ci : ci + 1;
      const float* rowp = p.xbc + (size_t)(qbase + cn * 64 + r) * 512;
#pragma unroll
      for (int i = 0; i < 2; ++i) {
        xv[i] = *(const f32x4*)(rowp + h * 64 + cc + i * 4);
        bv[i] = *(const f32x4*)(rowp + 256 + grp * 64 + cc + i * 4);
        cv[i] = *(const f32x4*)(rowp + 384 + grp * 64 + cc + i * 4);
      }
    }
    __syncthreads();
    f32x4 gacc[2];
#pragma unroll
    for (int s2 = 0; s2 < 2; ++s2) gacc[s2] = (f32x4){0.f, 0.f, 0.f, 0.f};
#pragma unroll
    for (int ks = 0; ks < 2; ++ks) {
      const bf16x8 cf = *(const bf16x8*)(sC + (rt * 16 + lr) * 72 + ks * 32 + g * 8);
#pragma unroll
      for (int s2 = 0; s2 < 2; ++s2) {
        const bf16x8 bfr = *(const bf16x8*)(sB + ((ch * 2 + s2) * 16 + lr) * 72 + ks * 32 + g * 8);
        gacc[s2] = MFMA(cf, bfr, gacc[s2]);
      }
    }
    int opq;
    asm volatile("v_mov_b32 %0, 0" : "=v"(opq));
#pragma unroll
    for (int s2 = 0; s2 < 2; ++s2) {
      const int si = (ch * 2 + s2) * 16 + lr + opq;
      const float acs_s = sacs[si], dt_s = sdt[si];
#pragma unroll
      for (int i = 0; i < 4; ++i) {
        const int li = rt * 16 + g * 4 + i;
        const float acs_l = sacs[li];
        const bool ok = dir ? (si >= li) : (si <= li);
        const float mval = ok ? gacc[s2][i] * __expf(acs_l - acs_s) * dt_s : 0.f;
        sM[li * 72 + si] = f2bf(mval);
      }
    }
    __syncthreads();
    f32x4 yd[2], yo[2];
#pragma unroll
    for (int p2 = 0; p2 < 2; ++p2) { yd[p2] = (f32x4){0.f, 0.f, 0.f, 0.f}; yo[p2] = (f32x4){0.f, 0.f, 0.f, 0.f}; }
#pragma unroll
    for (int ks = 0; ks < 2; ++ks) {
      const bf16x8 mf = *(const bf16x8*)(sM + (rt * 16 + lr) * 72 + ks * 32 + g * 8);
      const bf16x8 cf = *(const bf16x8*)(sC + (rt * 16 + lr) * 72 + ks * 32 + g * 8);
#pragma unroll
      for (int p2 = 0; p2 < 2; ++p2) {
        const bf16x8 xf = *(const bf16x8*)(sXt + ((ch * 2 + p2) * 16 + lr) * 72 + ks * 32 + g * 8);
        const bf16x8 hf = *(const bf16x8*)(sH + ((ch * 2 + p2) * 16 + lr) * 72 + ks * 32 + g * 8);
        yd[p2] = MFMA(mf, xf, yd[p2]);
        yo[p2] = MFMA(cf, hf, yo[p2]);
      }
    }
#pragma unroll
    for (int i = 0; i < 4; ++i) {
      const int li = rt * 16 + g * 4 + i;
      const float e = __expf(sacs[li]);
      float* yrow = p.ydir + ((size_t)dir * NTOK + tok0 + li) * 256 + h * 64 + ch * 32 + lr;
#pragma unroll
      for (int p2 = 0; p2 < 2; ++p2) yrow[p2 * 16] = yd[p2][i] + e * yo[p2][i];
    }
    f32x4 hn[2];
#pragma unroll
    for (int n2 = 0; n2 < 2; ++n2) hn[n2] = (f32x4){0.f, 0.f, 0.f, 0.f};
#pragma unroll
    for (int ks = 0; ks < 2; ++ks) {
      const bf16x8 xw = *(const bf16x8*)(sXw + (rt * 16 + lr) * 72 + ks * 32 + g * 8);
#pragma unroll
      for (int n2 = 0; n2 < 2; ++n2) {
        const bf16x8 bt = *(const bf16x8*)(sBt + ((ch * 2 + n2) * 16 + lr) * 72 + ks * 32 + g * 8);
        hn[n2] = MFMA(xw, bt, hn[n2]);
      }
    }
    const float et = __expf(total);
#pragma unroll
    for (int n2 = 0; n2 < 2; ++n2) hacc[n2] = hacc[n2] * et + hn[n2];
    __syncthreads();
#pragma unroll
    for (int n2 = 0; n2 < 2; ++n2)
#pragma unroll
      for (int i = 0; i < 4; ++i) sH[(rt * 16 + g * 4 + i) * 72 + (ch * 2 + n2) * 16 + lr] = f2bf(hacc[n2][i]);
  }
  if (!lat) {
    float* dst = p.out + O_SSD + ((size_t)(((b * 4 + l) * 2 + dir) * 4 + h)) * 4096;
#pragma unroll
    for (int n2 = 0; n2 < 2; ++n2)
#pragma unroll
      for (int i = 0; i < 4; ++i) dst[(rt * 16 + g * 4 + i) * 64 + (ch * 2 + n2) * 16 + lr] = hacc[n2][i];
  }
}

DI void ssd_final_rows4(CP& p, int l, int tok0) {
  const int lane = opaque_tid() & 63;
  const int c = lane * 4, h = c >> 6;
  const float dd = p.ssd_d[(l * 2 + 0) * 4 + h] + p.ssd_d[(l * 2 + 1) * 4 + h];
  const f32x4 gg = *(const f32x4*)(p.ssd_norm_g + l * 256 + c);
  f32x4 y0[4], y1[4], xs[4];
  u32x2 zr[4];
#pragma unroll
  for (int a = 0; a < 4; ++a) {
    const int tok = tok0 + a;
    y0[a] = *(const f32x4*)(p.ydir + (size_t)tok * 256 + c);
    y1[a] = *(const f32x4*)(p.ydir + ((size_t)NTOK + tok) * 256 + c);
    xs[a] = *(const f32x4*)(p.xbc + (size_t)tok * 512 + c);
    zr[a] = *(const u32x2*)(p.comb + (size_t)tok * INW + 416 + c);
  }
#pragma unroll
  for (int a = 0; a < 4; ++a) {
    const int tok = tok0 + a;
    const f32x4 z = {__uint_as_float(zr[a][0] << 16), __uint_as_float(zr[a][0] & 0xffff0000u), __uint_as_float(zr[a][1] << 16),
                     __uint_as_float(zr[a][1] & 0xffff0000u)};
    f32x4 v;
    float ss = 0.f;
#pragma unroll
    for (int j = 0; j < 4; ++j) {
      v[j] = (y0[a][j] + y1[a][j] + dd * xs[a][j]) * siluf(z[j]);
      ss += v[j] * v[j];
    }
    ss = wave_sum(ss);
    const float rstd = rsqrtf(ss * (1.f / 256.f) + 1e-6f);
    u32x2 pk = {pack2(v[0] * rstd * gg[0], v[1] * rstd * gg[1]), pack2(v[2] * rstd * gg[2], v[3] * rstd * gg[3])};
    *(u32x2*)(p.hb + (size_t)tok * 1024 + 512 + c) = pk;
  }
}

DI void attn_item(CP& p, int seq, int h, int qb, char* smem) {
  const int tid = opaque_tid(), lane = tid & 63, wave = tid >> 6, lr = lane & 15, g = lane >> 4;
  const bool lat = seq >= 16;
  int Tk, kvbase, qtok0;
  if (!lat) { Tk = 256; kvbase = seq * 256; qtok0 = seq * 256; }
  else { const int b = seq - 16; Tk = 2304; kvbase = NCTX + b * 2304; qtok0 = NCTX + b * 2048 + qb * 256; }
  LAS u16* sKb = (LAS u16*)smem;
  LAS u16* sVb = sKb + 256 * 104;
  bf16x8 qf[2][3];
#pragma unroll
  for (int qt = 0; qt < 2; ++qt) {
    const int tok = qtok0 + wave * 32 + qt * 16 + lr;
#pragma unroll
    for (int ks = 0; ks < 3; ++ks) qf[qt][ks] = *(const bf16x8*)(p.qbuf + (size_t)tok * 768 + h * 96 + ks * 32 + g * 8);
    if (lat) {
      const int t = (tok - NCTX) & 2047;
      const int axis = g >> 1, half = g & 1;
      const float* cs = p.ropec + t * 16 + axis * 8;
      const float* sn = p.ropes + t * 16 + axis * 8;
      bf16x8 r;
#pragma unroll
      for (int j = 0; j < 8; ++j) {
        const float x = bf2f((u16)qf[qt][2][j]);
        const float pr = __shfl_xor(x, 16);
        const float c = cs[j], s = sn[j];
        const float o = half ? x * c + pr * s : x * c - pr * s;
        r[j] = (short)f2bf(o);
      }
      qf[qt][2] = r;
    }
  }
  f32x4 o[2][4];
#pragma unroll
  for (int qt = 0; qt < 2; ++qt)
#pragma unroll
    for (int dt = 0; dt < 4; ++dt) o[qt][dt] = (f32x4){0.f, 0.f, 0.f, 0.f};
  float mrow[2] = {-1e30f, -1e30f}, lrow[2] = {0.f, 0.f};
  const float cs2 = 0.10206207261596574f * 1.4426950408889634f;
  const int nst = Tk >> 8;
  const u16* gk = p.knope + (size_t)(kvbase + (tid >> 3)) * 512 + h * 64 + (tid & 7) * 8;
  const u16* gr = p.krope + (size_t)(kvbase + (tid >> 2)) * 32 + (tid & 3) * 8;
  const u16* gv = p.vt + (size_t)512 * kvbase + (size_t)(h * 64 + (tid >> 5)) * Tk + (tid & 31) * 8;
  u32x4 rk[4], rr[2], rv[4];
#pragma unroll
  for (int i = 0; i < 4; ++i) { rk[i] = *(const u32x4*)(gk + (size_t)i * 64 * 512); rv[i] = *(const u32x4*)(gv + (size_t)i * 16 * Tk); }
#pragma unroll
  for (int i = 0; i < 2; ++i) rr[i] = *(const u32x4*)(gr + (size_t)i * 128 * 32);
#pragma unroll 1
  for (int st = 0; st < nst; ++st) {
    __syncthreads();
#pragma unroll
    for (int i = 0; i < 4; ++i) {
      *(LAS u32x4*)(sKb + ((tid >> 3) + i * 64) * 104 + (tid & 7) * 8) = rk[i];
      *(LAS u32x4*)(sVb + ((tid >> 5) + i * 16) * 264 + (tid & 31) * 8) = rv[i];
    }
#pragma unroll
    for (int i = 0; i < 2; ++i) *(LAS u32x4*)(sKb + ((tid >> 2) + i * 128) * 104 + 64 + (tid & 3) * 8) = rr[i];
    __syncthreads();
    if (st + 1 < nst) {
      const size_t ko = (size_t)(st + 1) * 256;
#pragma unroll
      for (int i = 0; i < 4; ++i) { rk[i] = *(const u32x4*)(gk + (ko + i * 64) * 512); rv[i] = *(const u32x4*)(gv + (size_t)i * 16 * Tk + ko); }
#pragma unroll
      for (int i = 0; i < 2; ++i) rr[i] = *(const u32x4*)(gr + (ko + i * 128) * 32);
    }
#pragma unroll 1
    for (int kt = 0; kt < 4; ++kt) {
      const LAS u16* sK = sKb + kt * 64 * 104;
      const LAS u16* sV = sVb + kt * 64;
      f32x4 s[4][2];
#pragma unroll
      for (int k4 = 0; k4 < 4; ++k4) {
        s[k4][0] = (f32x4){0.f, 0.f, 0.f, 0.f};
        s[k4][1] = (f32x4){0.f, 0.f, 0.f, 0.f};
#pragma unroll
        for (int ks = 0; ks < 3; ++ks) {
          const bf16x8 kf = *(const LAS bf16x8*)(sK + (k4 * 16 + lr) * 104 + ks * 32 + g * 8);
          s[k4][0] = MFMA(kf, qf[0][ks], s[k4][0]);
          s[k4][1] = MFMA(kf, qf[1][ks], s[k4][1]);
        }
      }
      bf16x8 pf[2][2];
#pragma unroll
      for (int qt = 0; qt < 2; ++qt) {
        float mx = -1e30f;
#pragma unroll
        for (int k4 = 0; k4 < 4; ++k4)
#pragma unroll
          for (int i = 0; i < 4; ++i) mx = fmaxf(mx, s[k4][qt][i]);
        mx = xrow16_max(mx);
        const float mnew = fmaxf(mrow[qt], mx * cs2);
        const float alpha = __builtin_amdgcn_exp2f(mrow[qt] - mnew);
        mrow[qt] = mnew;
        float psum = 0.f;
        float pv[4][4];
#pragma unroll
        for (int k4 = 0; k4 < 4; ++k4)
#pragma unroll
          for (int i = 0; i < 4; ++i) {
            pv[k4][i] = __builtin_amdgcn_exp2f(s[k4][qt][i] * cs2 - mnew);
            psum += pv[k4][i];
          }
        lrow[qt] = lrow[qt] * alpha + psum;
        if (__builtin_amdgcn_ballot_w64(alpha != 1.f) != 0ull) {
#pragma unroll
          for (int dt = 0; dt < 4; ++dt) o[qt][dt] *= alpha;
        }
#pragma unroll
        for (int s2 = 0; s2 < 2; ++s2) {
          u32x4 pk = {pack2(pv[2 * s2][0], pv[2 * s2][1]), pack2(pv[2 * s2][2], pv[2 * s2][3]),
                      pack2(pv[2 * s2 + 1][0], pv[2 * s2 + 1][1]), pack2(pv[2 * s2 + 1][2], pv[2 * s2 + 1][3])};
          pf[qt][s2] = __builtin_bit_cast(bf16x8, pk);
        }
      }
#pragma unroll
      for (int s2 = 0; s2 < 2; ++s2)
#pragma unroll
        for (int dt = 0; dt < 4; ++dt) {
          const s16x4 lo = *(const LAS s16x4*)(sV + (dt * 16 + lr) * 264 + s2 * 32 + g * 4);
          const s16x4 hi = *(const LAS s16x4*)(sV + (dt * 16 + lr) * 264 + s2 * 32 + 16 + g * 4);
          const bf16x8 vf = __builtin_shufflevector(lo, hi, 0, 1, 2, 3, 4, 5, 6, 7);
          o[0][dt] = MFMA(vf, pf[0][s2], o[0][dt]);
          o[1][dt] = MFMA(vf, pf[1][s2], o[1][dt]);
        }
    }
  }
#pragma unroll
  for (int qt = 0; qt < 2; ++qt) {
    float lsum = lrow[qt];
    lsum = xrow16_sum(lsum);
    const float inv = frcp(lsum);
    const int tok = qtok0 + wave * 32 + qt * 16 + lr;
#pragma unroll
    for (int dt = 0; dt < 4; ++dt) {
      u32x2 pk = {pack2(o[qt][dt][0] * inv, o[qt][dt][1] * inv), pack2(o[qt][dt][2] * inv, o[qt][dt][3] * inv)};
      *(u32x2*)(p.hb + (size_t)tok * 1024 + h * 64 + dt * 16 + g * 4) = pk;
    }
  }
}

DI int next_item(unsigned* ctr, int* slot) {
  __syncthreads();
  if (threadIdx.x == 0) *slot = (int)atomicAdd(ctr, 1u);
  __syncthreads();
  return *slot;
}

DI void forward(char* smem) {
  const int G = gridDim.x, bid = blockIdx.x;
  const int wave = threadIdx.x >> 6;
  int* slot = (int*)(smem + LDS_MAIN + 32);
  int ph = 0;
  XcdBarrier xb;
  {
    unsigned* stw = (unsigned*)(smem + LDS_MAIN);
    if (threadIdx.x == 0) { stw[0] = 0u; stw[1] = 0u; }
    __syncthreads();
    CP& p0 = get_params();
    xb = xcd_barrier_post(p0.bar, (volatile LAS unsigned*)stw);
    (void)xb;
  }
#define PH_BEGIN { CP& p = get_params();
#if USE_CG_SYNC
#define PH_END } { if (ph == 0) cg::this_grid().sync(); else { XcdBarrier xq; xq.bar = nullptr; xq.x = 0u; xq.st = (volatile LAS unsigned*)(smem + LDS_MAIN); xcd_barrier(xq); } } ++ph;
#else
#define PH_END } { XcdBarrier xq; xq.bar = nullptr; xq.x = 0u; xq.st = (volatile LAS unsigned*)(smem + LDS_MAIN); xcd_barrier(xq); } ++ph;
#endif

  PH_BEGIN
    phase0(p, smem);
  PH_END

#pragma unroll 1
  for (int l = 0; l < 4; ++l) {
    PH_BEGIN
      norm_phase(p, l, 0);
    PH_END
    PH_BEGIN
      gemm_phase<E_COMB, 192>(p, l, p.hb, p.wt_in + (size_t)l * INWP * 1024, 1024, 64, 7, 0, bid, G, 64 * 7, true, smem);
    PH_END
    PH_BEGIN
      for (int t = bid; t < 768 + 128; t += G) {
        if (t < 768) prep_tile(p, l, t, smem);
        else prep_cache_row(p, l, NTOK + (t - 768) * 8 + wave);
      }
    PH_END
    PH_BEGIN
      for (;;) {
        const int it = next_item(p.ctr + ph, slot);
        if (it >= 160 + 384 + 208 + 144) break;
        if (it < 32 || (it >= 416 && it < 544)) {
          const int j = it < 32 ? it : it - 416;
          ssd_item(p, l, (it < 32 ? 16 : 0) + (j >> 3), (j >> 1) & 3, j & 1, smem);
        } else if (it < 416) {
          cm_tile(p, l, it - 32, smem);
        } else if (it < 752) {
          const int t = it - 544;
          gemm_phase<E_KV, 256>(p, l, p.ckvn, p.wt_ukv + (size_t)l * 1024 * 128, 128, 52, 4, 0, t, 1 << 20, 208, false, smem);
        } else {
          const int t = it - 752;
          gemm_phase<E_Q, 256>(p, l, p.qn, p.wt_uq + (size_t)l * 768 * 256, 256, 48, 3, 0, t, 1 << 20, 144, false, smem);
        }
      }
      if (l < 3) conv_fill(p, l + 1, 0, 5792, p.ctr + 128 + ph, slot, smem);
    PH_END
    PH_BEGIN
      for (;;) {
        const int it = next_item(p.ctr + ph, slot);
        if (it >= 384 + 384) break;
        if (it < 384) {
          int sq, hh, qb;
          if (it < 256) { sq = 16 + (it >> 6); hh = (it >> 3) & 7; qb = it & 7; }
          else { const int j = it - 256; sq = j >> 3; hh = j & 7; qb = 0; }
          attn_item(p, sq, hh, qb, smem);
        } else {
          const int t0 = (it - 384) * 32 + wave * 4;
          ssd_final_rows4(p, l, t0);
        }
      }
    PH_END
    PH_BEGIN
      gemm_phase<E_RES, 192>(p, l, p.hb, p.wt_out + (size_t)l * 1024 * 1024, 1024, 64, 4, 2048, bid, G, 64 * 4, true, smem);
    PH_END
    PH_BEGIN
      norm_phase(p, l, 1);
    PH_END
    PH_BEGIN
      gemm_phase<E_SWIGLU, 192>(p, l, p.hb, p.wt_gu + (size_t)l * 2 * DFF * 1024, 1024, 64, 22, 0, bid, G, 64 * 22, true, smem);
    PH_END
    PH_BEGIN
      gemm_phase<E_RES, 192>(p, l, p.act, p.wt_down + (size_t)l * 1024 * DFF, DFF, 64, 4, 5120, bid, G, 64 * 4, true, smem);
    PH_END
  }
  { CP& p = get_params(); final_norm(p); }
}

extern __shared__ __attribute__((aligned(1024))) char dyn_smem[];

__global__ void __launch_bounds__(NTHREADS, 2) k_mega(P p) { forward(dyn_smem); }

extern "C" void kernel_launch(void* const* d_in, const int* in_sizes, int n_in, void* d_out, int out_size, void* d_ws,
                              size_t ws_size, hipStream_t stream) {
  P p{};
  const float** fp = (const float**)&p;
  for (int i = 0; i < 31; ++i) fp[i] = (const float*)d_in[i];
  p.out = (float*)d_out;
  char* ws = (char*)d_ws;
  size_t off = 0;
  auto take = [&](size_t bytes) { char* r = ws + off; off += (bytes + 255) & ~(size_t)255; return r; };
  p.bar = (unsigned*)take(16384);
  p.ctr = (unsigned*)take(16384);
  p.wt_in = (u16*)take((size_t)4 * INWP * 1024 * 2);
  p.wt_uq = (u16*)take((size_t)4 * 768 * 256 * 2);
  p.wt_ukv = (u16*)take((size_t)4 * 1024 * 128 * 2);
  p.wt_out = (u16*)take((size_t)4 * 1024 * 1024 * 2);
  p.wt_gu = (u16*)take((size_t)4 * 2 * DFF * 1024 * 2);
  p.wt_down = (u16*)take((size_t)4 * 1024 * DFF * 2);
  p.mod = (float*)take((size_t)4 * 5 * 6144 * 4);
  p.ropec = (float*)take(2048 * 16 * 4);
  p.ropes = (float*)take(2048 * 16 * 4);
  p.hb = (u16*)take((size_t)NTOK * 1024 * 2);
  p.comb = (u16*)take((size_t)NTOK * DFF * 2);
  p.act = p.comb;
  p.qn = (u16*)take((size_t)NTOK * 256 * 2);
  p.ckvn = (u16*)take((size_t)KVROWS * 128 * 2);
  p.qbuf = (u16*)take((size_t)NTOK * 768 * 2);
  p.knope = (u16*)take((size_t)KVROWS * 512 * 2);
  p.vt = (u16*)take((size_t)KVROWS * 512 * 2);
  p.krope = (u16*)take((size_t)KVROWS * 32 * 2);
  p.xbc = (float*)take((size_t)NTOK * 512 * 4);
  p.dtb = (float*)take((size_t)NTOK * 8 * 4);
  p.ydir = (float*)take((size_t)2 * NTOK * 256 * 4);
  if (off > ws_size) { fprintf(stderr, "workspace too small: need %zu have %zu\n", off, ws_size); return; }

  static int grid_blocks = 0;
  if (!grid_blocks) {
    int dev = 0, cus = 0, per_cu = 0;
    (void)hipGetDevice(&dev);
    (void)hipDeviceGetAttribute(&cus, hipDeviceAttributeMultiprocessorCount, dev);
    (void)hipFuncSetAttribute((const void*)k_mega, hipFuncAttributeMaxDynamicSharedMemorySize, LDS_BYTES);
    (void)hipOccupancyMaxActiveBlocksPerMultiprocessor(&per_cu, (const void*)k_mega, NTHREADS, LDS_BYTES);
    if (per_cu > 1) per_cu = 1;
    if (per_cu < 1) per_cu = 1;
    grid_blocks = cus * per_cu;
  }
  (void)hipMemsetAsync(d_ws, 0, 32768, stream);
  void* args[] = {&p};
  hipError_t e = hipLaunchCooperativeKernel((const void*)k_mega, dim3(grid_blocks), dim3(NTHREADS), args, LDS_BYTES, stream);
  if (e != hipSuccess) fprintf(stderr, "cooperative launch failed: %s (grid %d)\n", hipGetErrorString(e), grid_blocks);
}
```

```cpp
#include <hip/hip_runtime.h>
#include <hip/hip_cooperative_groups.h>
#include <stdint.h>
#include <stdio.h>
namespace cg = cooperative_groups;

#ifndef USE_CG_SYNC
#define USE_CG_SYNC 0
#endif

#define DI __device__ __forceinline__
#define LAS __attribute__((address_space(3)))
typedef unsigned short u16;
typedef __bf16 bf2_t __attribute__((ext_vector_type(2)));
typedef float f2_t __attribute__((ext_vector_type(2)));
using bf16x8 = __attribute__((ext_vector_type(8))) short;
using s16x4 = __attribute__((ext_vector_type(4))) short;
using f32x4 = __attribute__((ext_vector_type(4))) float;
using u32x4 = __attribute__((ext_vector_type(4))) unsigned;
using u32x2 = __attribute__((ext_vector_type(2))) unsigned;

#define MFMA(a, b, c) __builtin_amdgcn_mfma_f32_16x16x32_bf16((a), (b), (c), 0, 0, 0)

constexpr int NTOK = 12288, NCTX = 4096, KVROWS = 13312;
constexpr int INW = 1704, INWP = 1792, DFF = 2816;
constexpr size_t O_CKV = 12582912, O_KR = 14680064, O_SSD = 15204352;
constexpr int LDS_MAIN = 131072;
constexpr int LDS_BYTES = LDS_MAIN + 64;
constexpr int NTHREADS = 512;

struct P {
  const float *x_prompt, *x_sample, *c, *cache_ckv, *cache_krope, *state_ssd, *c_ctx, *w_ada, *b_ada, *g_mix, *w_in,
      *g_q, *w_uq, *g_kv, *w_ukv, *ssd_conv_w, *ssd_conv_b, *ssd_dt_bias, *ssd_a_log, *ssd_d, *ssd_norm_g, *cm_conv_w,
      *cm_conv_b, *cm_ln_g, *cm_ln_b, *w_out, *g_ffn, *w_gate, *w_up, *w_down, *g_final;
  float* out;
  unsigned* bar;
  unsigned* ctr;
  u16 *wt_in, *wt_uq, *wt_ukv, *wt_out, *wt_gu, *wt_down;
  float *mod, *ropec, *ropes;
  u16* hb;
  u16* comb;
  u16* act;
  u16 *qn, *ckvn, *qbuf, *knope, *vt, *krope;
  float *xbc, *dtb, *ydir;
};

typedef const __attribute__((address_space(4))) P CP;
DI CP& get_params() {
  unsigned long long kp = (unsigned long long)__builtin_amdgcn_kernarg_segment_ptr();
  asm volatile("" : "+s"(kp));
  return *(CP*)kp;
}
DI int opaque_tid() { int t = threadIdx.x; asm volatile("" : "+v"(t)); return t; }

DI unsigned pack2(float a, float b) {
  f2_t v = {a, b};
  bf2_t r = __builtin_convertvector(v, bf2_t);
  return __builtin_bit_cast(unsigned, r);
}
DI u16 f2bf(float a) { return (u16)(pack2(a, 0.f) & 0xffffu); }
DI float bf2f(u16 v) { return __uint_as_float(((unsigned)v) << 16); }
DI float frcp(float x) { return __builtin_amdgcn_rcpf(x); }
DI float xrow16_max(float x) {
  auto s = __builtin_amdgcn_permlane16_swap(__float_as_uint(x), __float_as_uint(x), false, false);
  x = fmaxf(__uint_as_float(s[0]), __uint_as_float(s[1]));
  auto t = __builtin_amdgcn_permlane32_swap(__float_as_uint(x), __float_as_uint(x), false, false);
  return fmaxf(__uint_as_float(t[0]), __uint_as_float(t[1]));
}
DI float xrow16_sum(float x) {
  auto s = __builtin_amdgcn_permlane16_swap(__float_as_uint(x), __float_as_uint(x), false, false);
  x = __uint_as_float(s[0]) + __uint_as_float(s[1]);
  auto t = __builtin_amdgcn_permlane32_swap(__float_as_uint(x), __float_as_uint(x), false, false);
  return __uint_as_float(t[0]) + __uint_as_float(t[1]);
}
template <int CTRL> DI float dppf(float x) {
  return __builtin_bit_cast(float, __builtin_amdgcn_mov_dpp(__builtin_bit_cast(int, x), CTRL, 0xf, 0xf, true));
}
DI float wave_sum(float x) {
  x += dppf<0xB1>(x);
  x += dppf<0x4E>(x);
  x += dppf<0x141>(x);
  x += dppf<0x128>(x);
  return xrow16_sum(x);
}
DI float sigmoidf(float x) { return frcp(1.f + __expf(-x)); }
DI float siluf(float x) { return x * frcp(1.f + __expf(-x)); }

#define XB_TMO      128
#define XB_XCNT(j)  (256  + 64 * (j))
#define XB_XSUB(j)  (1280 + 64 * (j))
#define XB_XGEN(j)  (2304 + 64 * (j))
#define XB_TOP      3328
#define XB_TOPGEN   3392
#define XB_SPIN_CAP (1u << 20)
DI unsigned xb_ld(unsigned* p) { return __hip_atomic_load(p, __ATOMIC_RELAXED, __HIP_MEMORY_SCOPE_AGENT); }
DI unsigned xb_add(unsigned* p, unsigned v) { return __hip_atomic_fetch_add(p, v, __ATOMIC_RELAXED, __HIP_MEMORY_SCOPE_AGENT); }
DI unsigned xb_xcc_id() { return (unsigned)__builtin_amdgcn_s_getreg((3 << 11) | 20) & 0xFu; }
#define XB_SPIN(cond, bar) do { unsigned _sp = 0; while (cond) { __builtin_amdgcn_s_sleep(1); \
    if ((++_sp & 255u) == 0u) { if (xb_ld(&(bar)[XB_TMO])) break; if (_sp > XB_SPIN_CAP) { atomicAdd(&(bar)[XB_TMO], 1u); break; } } } } while (0)
struct XcdBarrier { unsigned* bar; unsigned x; volatile LAS unsigned* st; };
DI XcdBarrier xcd_barrier_post(unsigned* bar, volatile LAS unsigned* st) {
  XcdBarrier b; b.bar = bar; b.x = xb_xcc_id(); b.st = st;
  if (threadIdx.x == 0) (void)xb_add(&bar[XB_XCNT(b.x)], 1u);
  return b;
}
DI void xcd_barrier_complete(unsigned* bar, unsigned x, unsigned& nloc, unsigned& nx) {
  const unsigned G = gridDim.x * gridDim.y * gridDim.z;
  unsigned sum, cnt, mine, sp = 0u;
  for (;;) {
    sum = 0u; cnt = 0u; mine = 0u;
#pragma unroll
    for (unsigned j = 0; j < 16; ++j) { const unsigned c = xb_ld(&bar[XB_XCNT(j)]); sum += c; cnt += (c > 0u) ? 1u : 0u; mine = (j == x) ? c : mine; }
    if (sum == G) break;
    __builtin_amdgcn_s_sleep(1);
    if ((++sp & 255u) == 0u) { if (xb_ld(&bar[XB_TMO])) break; if (sp > XB_SPIN_CAP) { atomicAdd(&bar[XB_TMO], 1u); break; } }
  }
  nloc = mine > 0u ? mine : 1u; nx = cnt > 0u ? cnt : 1u;
}
DI void xcd_barrier(const XcdBarrier& b0) {
  asm volatile("s_waitcnt vmcnt(0)" ::: "memory");
  __syncthreads();
  if (threadIdx.x == 0) {
    XcdBarrier b; b.bar = get_params().bar; b.x = xb_xcc_id(); b.st = b0.st;
    unsigned* bar = b.bar;
    __builtin_amdgcn_s_waitcnt(0);
    unsigned nloc = b.st[0], nx = b.st[1];
    if (nloc == 0u) { xcd_barrier_complete(bar, b.x, nloc, nx); b.st[0] = nloc; b.st[1] = nx; }
    const unsigned old = xb_add(&bar[XB_XSUB(b.x)], 1u);
    const unsigned gen = old / nloc;
    if (old + 1u == (gen + 1u) * nloc) {
      __builtin_amdgcn_fence(__ATOMIC_RELEASE, "agent");
      asm volatile("s_waitcnt vmcnt(0)" ::: "memory");
      const unsigned og = xb_add(&bar[XB_TOP], 1u);
      const unsigned tg = og / nx;
      if (og + 1u == (tg + 1u) * nx) xb_add(&bar[XB_TOPGEN], 1u);
      else XB_SPIN(xb_ld(&bar[XB_TOPGEN]) == tg, bar);
      __builtin_amdgcn_fence(__ATOMIC_ACQUIRE, "agent");
      xb_add(&bar[XB_XGEN(b.x)], 1u);
      asm volatile("s_waitcnt vmcnt(0)" ::: "memory");
    } else {
      XB_SPIN(xb_ld(&bar[XB_XGEN(b.x)]) == gen, bar);
      __builtin_amdgcn_fence(__ATOMIC_ACQUIRE, "agent");
      asm volatile("s_waitcnt vmcnt(0)" ::: "memory");
    }
  }
  __syncthreads();
}

enum { E_COMB = 0, E_Q = 1, E_KV = 2, E_RES = 3, E_SWIGLU = 4 };

DI int lds_byte(int r, int c) {
  const int st = (r >> 4) * 2 + (c >> 5), ob = (r & 15) * 64 + (c & 31) * 2;
  return st * 1024 + (ob ^ (((ob >> 9) & 1) << 5));
}
DI void stage_rc(int b, int& R, int& C) {
  const int st = b >> 10, sb = b & 1023, swz = sb ^ (((sb >> 9) & 1) << 5);
  R = (st >> 1) * 16 + swz / 64;
  C = (st & 1) * 32 + (swz % 64) / 2;
}
DI void tile_rc(int t, int nM, int nN, int& pm, int& pn) {
  const int nwg = nM * nN;
  const int q = nwg / 8, r = nwg % 8, xcd = t % 8, off = t / 8;
  const int w = (xcd < r ? xcd * (q + 1) : r * (q + 1) + (xcd - r) * q) + off;
  const int nig = 8 * nN, gid = w / nig, fm = gid * 8;
  const int gsz = (nM - fm) < 8 ? (nM - fm) : 8;
  pm = fm + ((w % nig) % gsz);
  pn = (w % nig) / gsz;
}

DI u32x4 widen16(u32x2 a, u32x2 b) {
  auto s0 = __builtin_amdgcn_permlane16_swap(a[0], b[0], false, false);
  auto s1 = __builtin_amdgcn_permlane16_swap(a[1], b[1], false, false);
  u32x4 r = {s0[0], s1[0], s0[1], s1[1]};
  return r;
}

template <int EPI, int MT>
DI void gemm_epilogue(CP& p, int l, const f32x4 (&acc)[MT][4], int mb, int nb, int goff, int fr, int fq) {
  if (EPI == E_COMB || EPI == E_Q || EPI == E_SWIGLU) {
    const int tsel = fq & 1, csel = (fq >> 1) * 8;
#pragma unroll
    for (int mi = 0; mi < MT; ++mi) {
      const int m = mb + mi * 16 + fr;
      if (EPI == E_SWIGLU) {
        u32x2 r[2];
#pragma unroll
        for (int q = 0; q < 2; ++q) {
          const f32x4 gv = acc[mi][2 * q], uv = acc[mi][2 * q + 1];
          r[q] = (u32x2){pack2(siluf(gv[0]) * uv[0], siluf(gv[1]) * uv[1]), pack2(siluf(gv[2]) * uv[2], siluf(gv[3]) * uv[3])};
        }
        const u32x4 w = widen16(r[0], r[1]);
        *(u32x4*)(p.act + (size_t)m * DFF + (nb >> 1) + tsel * 16 + csel) = w;
      } else {
#pragma unroll
        for (int q = 0; q < 2; ++q) {
          const f32x4 va = acc[mi][2 * q], vb = acc[mi][2 * q + 1];
          const u32x2 a = {pack2(va[0], va[1]), pack2(va[2], va[3])};
          const u32x2 b = {pack2(vb[0], vb[1]), pack2(vb[2], vb[3])};
          const u32x4 w = widen16(a, b);
          const int n = nb + (2 * q + tsel) * 16 + csel;
          if (EPI == E_COMB) { if (n < INW) *(u32x4*)(p.comb + (size_t)m * INW + n) = w; }
          else *(u32x4*)(p.qbuf + (size_t)m * 768 + n) = w;
        }
      }
    }
    return;
  }
#pragma unroll
  for (int mi = 0; mi < MT; ++mi) {
    const int m = mb + mi * 16 + fr;
#pragma unroll
    for (int ni = 0; ni < 4; ++ni) {
      const int n = nb + ni * 16 + fq * 4;
      const f32x4 v = acc[mi][ni];
      if (EPI == E_COMB) {
        if (n < INW) { u32x2 o = {pack2(v[0], v[1]), pack2(v[2], v[3])}; *(u32x2*)(p.comb + (size_t)m * INW + n) = o; }
      } else if (EPI == E_Q) {
        u32x2 o = {pack2(v[0], v[1]), pack2(v[2], v[3])};
        *(u32x2*)(p.qbuf + (size_t)m * 768 + n) = o;
      } else if (EPI == E_KV) {
        const int hh = n >> 7, c = n & 127;
        if (c < 64) {
          u32x2 o = {pack2(v[0], v[1]), pack2(v[2], v[3])};
          *(u32x2*)(p.knope + (size_t)m * 512 + hh * 64 + c) = o;
        } else {
          int kvbase, Tk;
          if (m < NCTX) { kvbase = m & ~255; Tk = 256; }
          else { const int b = (m - NCTX) / 2304; kvbase = NCTX + b * 2304; Tk = 2304; }
          u16* dst = p.vt + (size_t)512 * kvbase + (size_t)(hh * 64 + (c - 64)) * Tk + (m - kvbase);
#pragma unroll
          for (int i = 0; i < 4; ++i) dst[(size_t)i * Tk] = f2bf(v[i]);
        }
      } else if (EPI == E_RES) {
        const int vs = m < NCTX ? 0 : 1 + ((m - NCTX) >> 11);
        const f32x4 gt = *(const f32x4*)(p.mod + (size_t)(l * 5 + vs) * 6144 + goff + n);
        float* xp = p.out + (size_t)m * 1024 + n;
        const float* xs = xp;
        if (l == 0 && goff == 2048) xs = (m < NCTX ? p.x_prompt + (size_t)m * 1024 : p.x_sample + (size_t)(m - NCTX) * 1024) + n;
        f32x4 xv = *(const f32x4*)xs;
        xv += gt * v;
        *(f32x4*)xp = xv;
      } else if (EPI == E_SWIGLU) {
        if ((ni & 1) == 0) {
          const f32x4 u = acc[mi][ni + 1];
          u32x2 o = {pack2(siluf(v[0]) * u[0], siluf(v[1]) * u[1]), pack2(siluf(v[2]) * u[2], siluf(v[3]) * u[3])};
          *(u32x2*)(p.act + (size_t)m * DFF + ((nb + ni * 16) >> 1) + fq * 4) = o;
        }
      }
    }
  }
}

#define GEMM_STAGE(buf, Ap, Wp, kt) do {                                                                                  \
    _Pragma("unroll") for (int i = 0; i < GLA; ++i)                                                                       \
      __builtin_amdgcn_global_load_lds((const unsigned*)((Ap) + (size_t)sR[i] * K + (kt) * 64 + sC[i]),                    \
                                       (LAS unsigned*)(ls + (buf) * STAGE_B + wid * 1024 + i * 8192), 16, 0, 0);         \
    _Pragma("unroll") for (int i = 0; i < 4; ++i)                                                                         \
      __builtin_amdgcn_global_load_lds((const unsigned*)((Wp) + (size_t)sR[i] * K + (kt) * 64 + sC[i]),                    \
                                       (LAS unsigned*)(ls + (buf) * STAGE_B + TILE_A + wid * 1024 + i * 8192), 16, 0, 0); \
  } while (0)

template <int EPI, int BM>
DI void gemm_phase(CP& p, int l, const u16* __restrict__ A, const u16* __restrict__ W, int K, int nM, int nN, int goff,
                   int t0, int tstride, int ntiles, bool raster, char* smem) {
  const int tid = opaque_tid(), lane = tid & 63, wid = tid >> 6;
  const int wr = wid >> 2, wc = wid & 3, fr = lane & 15, fq = lane >> 4;
  constexpr int MT = BM / 32, GLA = BM / 64;
  constexpr int TILE_A = BM * 128, TILE_B = 256 * 128, STAGE_B = TILE_A + TILE_B;
  LAS char* ls = (LAS char*)smem;
  int sR[4], sC[4];
#pragma unroll
  for (int i = 0; i < 4; ++i) stage_rc(wid * 1024 + i * 8192 + lane * 16, sR[i], sC[i]);
  int t = t0;
  if (t >= ntiles) return;
  int pm, pn;
  if (raster) tile_rc(t, nM, nN, pm, pn); else { pn = t / nM; pm = t - pn * nM; }
  const u16* Ab = A + (size_t)pm * BM * K;
  const u16* Wb = W + (size_t)pn * 256 * K;
  const int nt = K >> 6;
  const int obf = fr * 64 + fq * 16, swzf = obf ^ (((obf >> 9) & 1) << 5);
  const char* fragA = smem + wr * (BM / 32) * 2048 + swzf;
  const char* fragB = smem + TILE_A + wc * 4 * 2048 + swzf;
  __syncthreads();
  GEMM_STAGE(0, Ab, Wb, 0);
  asm volatile("s_waitcnt vmcnt(0)" ::: "memory");
  __syncthreads();
  for (;;) {
    const int tn = t + tstride;
    const bool has_next = tn < ntiles;
    int pmn = 0, pnn = 0;
    if (has_next) { if (raster) tile_rc(tn, nM, nN, pmn, pnn); else { pnn = tn / nM; pmn = tn - pnn * nM; } }
    const u16* Abn = A + (size_t)pmn * BM * K;
    const u16* Wbn = W + (size_t)pnn * 256 * K;
    f32x4 acc[MT][4];
#pragma unroll
    for (int m = 0; m < MT; ++m)
#pragma unroll
      for (int n = 0; n < 4; ++n) acc[m][n] = (f32x4){0.f, 0.f, 0.f, 0.f};
    for (int kt = 0; kt < nt; ++kt) {
      const int cur = kt & 1;
      if (kt + 1 < nt) GEMM_STAGE(cur ^ 1, Ab, Wb, kt + 1);
      else if (has_next) GEMM_STAGE(cur ^ 1, Abn, Wbn, 0);
      const char* sa = fragA + cur * STAGE_B;
      const char* sb = fragB + cur * STAGE_B;
#pragma unroll
      for (int ks = 0; ks < 2; ++ks) {
        bf16x8 At[MT], Bf[4];
#pragma unroll
        for (int m = 0; m < MT; ++m) At[m] = *(const bf16x8*)(sa + m * 2048 + ks * 1024);
#pragma unroll
        for (int n = 0; n < 4; ++n) Bf[n] = *(const bf16x8*)(sb + n * 2048 + ks * 1024);
        __builtin_amdgcn_s_setprio(1);
#pragma unroll
        for (int m = 0; m < MT; ++m)
#pragma unroll
          for (int n = 0; n < 4; ++n) acc[m][n] = MFMA(Bf[n], At[m], acc[m][n]);
        __builtin_amdgcn_s_setprio(0);
        __builtin_amdgcn_sched_barrier(0);
      }
      if (kt + 1 < nt) {
        asm volatile("s_waitcnt vmcnt(0)" ::: "memory");
        __syncthreads();
      }
    }
    gemm_epilogue<EPI, MT>(p, l, acc, pm * BM + wr * (BM / 2), pn * 256 + wc * 64, goff, fr, fq);
    asm volatile("s_waitcnt vmcnt(0)" ::: "memory");
    __syncthreads();
    if (!has_next) break;
    t = tn; pm = pmn; pn = pnn; Ab = Abn; Wb = Wbn;
  }
}
#undef GEMM_STAGE

DI void conv_wtile(const float* __restrict__ src, int K, int N, u16* __restrict__ dst, int rowmul, int rowoff, int kt,
                   int nt, LAS float* wt, int lane) {
  const int k0 = kt * 32, n0 = nt * 64;
  float v[32];
  const bool ok = n0 + lane < N;
  const float* sp = src + (size_t)k0 * N + n0 + lane;
#pragma unroll
  for (int i = 0; i < 32; ++i) v[i] = ok ? sp[(size_t)i * N] : 0.f;
#pragma unroll
  for (int i = 0; i < 32; ++i) wt[i * 65 + lane] = v[i];
#pragma unroll
  for (int i = 0; i < 16; ++i) {
    const int n = i * 4 + (lane >> 4), kp = lane & 15;
    const float lo = wt[(2 * kp) * 65 + n], hi = wt[(2 * kp + 1) * 65 + n];
    const int nn = n0 + n;
    const int drow = rowmul == 1 ? nn : ((nn >> 4) << 5) + (nn & 15) + 16 * rowoff;
    *(unsigned*)(dst + (size_t)drow * K + k0 + 2 * kp) = pack2(lo, hi);
  }
}

DI void conv_dispatch(CP& p, int l, int r, LAS float* wt, int lane) {
  if (r < 896) {
    conv_wtile(p.w_in + (size_t)l * 1024 * INW, 1024, INW, p.wt_in + (size_t)l * INWP * 1024, 1, 0, r & 31, r >> 5, wt, lane);
  } else if ((r -= 896) < 96) {
    conv_wtile(p.w_uq + (size_t)l * 256 * 768, 256, 768, p.wt_uq + (size_t)l * 768 * 256, 1, 0, r & 7, r >> 3, wt, lane);
  } else if ((r -= 96) < 64) {
    conv_wtile(p.w_ukv + (size_t)l * 128 * 1024, 128, 1024, p.wt_ukv + (size_t)l * 1024 * 128, 1, 0, r & 3, r >> 2, wt, lane);
  } else if ((r -= 64) < 512) {
    conv_wtile(p.w_out + (size_t)l * 1024 * 1024, 1024, 1024, p.wt_out + (size_t)l * 1024 * 1024, 1, 0, r & 31, r >> 5, wt, lane);
  } else if ((r -= 512) < 1408) {
    conv_wtile(p.w_gate + (size_t)l * 1024 * DFF, 1024, DFF, p.wt_gu + (size_t)l * 2 * DFF * 1024, 2, 0, r & 31, r >> 5, wt, lane);
  } else if ((r -= 1408) < 1408) {
    conv_wtile(p.w_up + (size_t)l * 1024 * DFF, 1024, DFF, p.wt_gu + (size_t)l * 2 * DFF * 1024, 2, 1, r & 31, r >> 5, wt, lane);
  } else {
    r -= 1408;
    conv_wtile(p.w_down + (size_t)l * DFF * 1024, DFF, 1024, p.wt_down + (size_t)l * 1024 * DFF, 1, 0, r % 88, r / 88, wt, lane);
  }
}

DI void conv_fill(CP& p, int l, int r_lo, int r_hi, unsigned* ctr, int* slot, char* smem) {
  const int tid = opaque_tid(), lane = tid & 63, wave = tid >> 6;
  LAS float* wt = (LAS float*)smem + wave * (32 * 65);
  const int nitems = (r_hi - r_lo + 7) >> 3;
  for (;;) {
    __syncthreads();
    if (tid == 0) *slot = (int)atomicAdd(ctr, 1u);
    __syncthreads();
    const int it = *slot;
    if (it >= nitems) break;
    const int r = r_lo + it * 8 + wave;
    if (r < r_hi) conv_dispatch(p, l, r, wt, lane);
  }
}

DI void phase0(CP& p, char* smem) {
  const int tid = opaque_tid();
  const int G = gridDim.x, bid = blockIdx.x;
  {
    const int lane = tid & 63, wave = tid >> 6;
    LAS float* wt = (LAS float*)smem + wave * (32 * 65);
    __syncthreads();
    for (int idx = bid * 8 + wave; idx < 5792; idx += G * 8) conv_dispatch(p, 0, idx, wt, lane);
  }
  {
    float* scond = (float*)(smem + 32768);
    float* red = scond + 5120;
    __syncthreads();
    for (int i = tid; i < 5120; i += NTHREADS) {
      const int v = i >> 10, k = i & 1023;
      const float x = v == 0 ? p.c_ctx[k] : p.c[(v - 1) * 1024 + k];
      scond[i] = siluf(x);
    }
    __syncthreads();
    for (int job = bid; job < 384; job += G) {
      const int l = job / 96, chunk = job - l * 96;
      const int c = tid & 63, kg = tid >> 6, col = chunk * 64 + c;
      float a0 = 0.f, a1 = 0.f, a2 = 0.f, a3 = 0.f, a4 = 0.f;
      const float* w = p.w_ada + ((size_t)l * 1024 + kg * 128) * 6144 + col;
      const float* sc = scond + kg * 128;
#pragma unroll 32
      for (int k = 0; k < 128; ++k) {
        const float wv = w[(size_t)k * 6144];
        a0 += sc[k] * wv; a1 += sc[1024 + k] * wv; a2 += sc[2048 + k] * wv; a3 += sc[3072 + k] * wv; a4 += sc[4096 + k] * wv;
      }
      red[(kg * 5 + 0) * 64 + c] = a0; red[(kg * 5 + 1) * 64 + c] = a1; red[(kg * 5 + 2) * 64 + c] = a2;
      red[(kg * 5 + 3) * 64 + c] = a3; red[(kg * 5 + 4) * 64 + c] = a4;
      __syncthreads();
      if (kg == 0) {
        const float bb = p.b_ada[l * 6144 + col];
#pragma unroll
        for (int v = 0; v < 5; ++v) {
          float s = 0.f;
#pragma unroll
          for (int q = 0; q < 8; ++q) s += red[(q * 5 + v) * 64 + c];
          p.mod[(size_t)(l * 5 + v) * 6144 + col] = s + bb;
        }
      }
      __syncthreads();
    }
  }
  for (int i = bid * NTHREADS + tid; i < 2048 * 16; i += G * NTHREADS) {
    const int t = i >> 4, a = (i >> 3) & 1, f = i & 7;
    const float pos = a == 0 ? (float)(t >> 6) : (float)(t & 63);
    const float inv = powf(10000.0f, -(float)f / 8.0f);
    const float ang = pos * inv;
    p.ropec[i] = cosf(ang);
    p.ropes[i] = sinf(ang);
  }
}

DI void norm_phase(CP& p, int l, int which) {
  const int tid = opaque_tid(), lane = tid & 63, wave = tid >> 6;
  const float* gw = (which == 0 ? p.g_mix : p.g_ffn) + l * 1024;
  const int shoff = which == 0 ? 0 : 3072, scoff = shoff + 1024;
  f32x4 gg[4];
#pragma unroll
  for (int i = 0; i < 4; ++i) gg[i] = *(const f32x4*)(gw + i * 256 + lane * 4);
  const int stride = gridDim.x * 8;
  for (int tok0 = blockIdx.x * 8 + wave; tok0 < NTOK; tok0 += 2 * stride) {
    f32x4 v[2][4], sc[2][4], sh[2][4];
    bool ok[2];
#pragma unroll
    for (int a = 0; a < 2; ++a) {
      const int tok = tok0 + a * stride;
      ok[a] = tok < NTOK;
      const int tk = ok[a] ? tok : tok0;
      const float* xr = p.out + (size_t)tk * 1024;
      if (l == 0 && which == 0) xr = tk < NCTX ? p.x_prompt + (size_t)tk * 1024 : p.x_sample + (size_t)(tk - NCTX) * 1024;
      const int vs = tk < NCTX ? 0 : 1 + ((tk - NCTX) >> 11);
      const float* md = p.mod + (size_t)(l * 5 + vs) * 6144;
#pragma unroll
      for (int i = 0; i < 4; ++i) {
        const int col = i * 256 + lane * 4;
        v[a][i] = *(const f32x4*)(xr + col);
        sc[a][i] = *(const f32x4*)(md + scoff + col);
        sh[a][i] = *(const f32x4*)(md + shoff + col);
      }
    }
#pragma unroll
    for (int a = 0; a < 2; ++a) {
      const int tok = tok0 + a * stride;
      float ss = 0.f;
#pragma unroll
      for (int i = 0; i < 4; ++i) ss += v[a][i][0] * v[a][i][0] + v[a][i][1] * v[a][i][1] + v[a][i][2] * v[a][i][2] + v[a][i][3] * v[a][i][3];
      ss = wave_sum(ss);
      const float rstd = rsqrtf(ss * (1.f / 1024.f) + 1e-6f);
      if (ok[a]) {
#pragma unroll
        for (int i = 0; i < 4; ++i) {
          const int col = i * 256 + lane * 4;
          f32x4 o;
#pragma unroll
          for (int j = 0; j < 4; ++j) o[j] = v[a][i][j] * rstd * gg[i][j] * (1.f + sc[a][i][j]) + sh[a][i][j];
          u32x2 pk = {pack2(o[0], o[1]), pack2(o[2], o[3])};
          *(u32x2*)(p.hb + (size_t)tok * 1024 + col) = pk;
        }
      }
    }
  }
}

DI void final_norm(CP& p) {
  const int tid = opaque_tid(), lane = tid & 63, wave = tid >> 6;
  f32x4 gg[4];
#pragma unroll
  for (int i = 0; i < 4; ++i) gg[i] = *(const f32x4*)(p.g_final + i * 256 + lane * 4);
  const int stride = gridDim.x * 8;
  for (int tok0 = blockIdx.x * 8 + wave; tok0 < NTOK; tok0 += 2 * stride) {
    f32x4 v[2][4];
    bool ok[2];
#pragma unroll
    for (int a = 0; a < 2; ++a) {
      const int tok = tok0 + a * stride;
      ok[a] = tok < NTOK;
      const float* xr = p.out + (size_t)(ok[a] ? tok : tok0) * 1024;
#pragma unroll
      for (int i = 0; i < 4; ++i) v[a][i] = *(const f32x4*)(xr + i * 256 + lane * 4);
    }
#pragma unroll
    for (int a = 0; a < 2; ++a) {
      const int tok = tok0 + a * stride;
      float ss = 0.f;
#pragma unroll
      for (int i = 0; i < 4; ++i) ss += v[a][i][0] * v[a][i][0] + v[a][i][1] * v[a][i][1] + v[a][i][2] * v[a][i][2] + v[a][i][3] * v[a][i][3];
      ss = wave_sum(ss);
      const float rstd = rsqrtf(ss * (1.f / 1024.f) + 1e-6f);
      if (ok[a]) {
        float* xr = p.out + (size_t)tok * 1024;
#pragma unroll
        for (int i = 0; i < 4; ++i) {
          f32x4 o;
#pragma unroll
          for (int j = 0; j < 4; ++j) o[j] = v[a][i][j] * rstd * gg[i][j];
          *(f32x4*)(xr + i * 256 + lane * 4) = o;
        }
      }
    }
  }
}

DI void prep_cache_row(CP& p, int l, int row) {
  const int lane = opaque_tid() & 63;
  {
    const int r = row - NTOK, b = r >> 8, j = r & 255;
    const int kvrow = NCTX + b * 2304 + j;
    const float* ck = p.cache_ckv + ((size_t)(b * 4 + l) * 256 + j) * 128;
    const f2_t v = *(const f2_t*)(ck + lane * 2);
    *(unsigned*)(p.ckvn + (size_t)kvrow * 128 + lane * 2) = pack2(v[0], v[1]);
    if (lane < 16) {
      const float* kr = p.cache_krope + ((size_t)(b * 4 + l) * 256 + j) * 32;
      const f2_t w = *(const f2_t*)(kr + lane * 2);
      *(unsigned*)(p.krope + (size_t)kvrow * 32 + lane * 2) = pack2(w[0], w[1]);
    }
  }
}

constexpr int PSTR = 1192;
struct PrepW { f32x4 gq; f2_t gkv; float cw[8][5]; float cb[8]; float dtb; };
DI void prep_load_w(CP& p, int l, int lane, PrepW& w) {
  w.gq = *(const f32x4*)(p.g_q + l * 256 + lane * 4);
  w.gkv = *(const f2_t*)(p.g_kv + l * 128 + lane * 2);
  const float* cw = p.ssd_conv_w + (size_t)l * 5 * 512;
  const float* cb = p.ssd_conv_b + l * 512;
#pragma unroll
  for (int i = 0; i < 8; ++i) {
    w.cb[i] = cb[i * 64 + lane];
#pragma unroll
    for (int j = 0; j < 5; ++j) w.cw[i][j] = cw[j * 512 + i * 64 + lane];
  }
  w.dtb = p.ssd_dt_bias[l * 8 + (lane & 7)];
}
DI void prep_row(CP& p, int l, int tok, const LAS float* cr, const PrepW& w, int lane) {
  int b, t, T, kvrow;
  const bool lat = tok >= NCTX;
  if (!lat) { b = tok >> 8; t = tok & 255; T = 256; kvrow = tok; }
  else { const int q = tok - NCTX; b = q >> 11; t = q & 2047; T = 2048; kvrow = NCTX + b * 2304 + 256 + t; }
  {
    const f32x4 v = *(const LAS f32x4*)(cr + lane * 4);
    float ss = v[0] * v[0] + v[1] * v[1] + v[2] * v[2] + v[3] * v[3];
    ss = wave_sum(ss);
    const float rstd = rsqrtf(ss * (1.f / 256.f) + 1e-6f);
    const f32x4 gg = w.gq;
    u32x2 pk = {pack2(v[0] * rstd * gg[0], v[1] * rstd * gg[1]), pack2(v[2] * rstd * gg[2], v[3] * rstd * gg[3])};
    *(u32x2*)(p.qn + (size_t)tok * 256 + lane * 4) = pk;
  }
  {
    const f2_t v = *(const LAS f2_t*)(cr + 256 + lane * 2);
    float ss = v[0] * v[0] + v[1] * v[1];
    ss = wave_sum(ss);
    const float rstd = rsqrtf(ss * (1.f / 128.f) + 1e-6f);
    const f2_t gg = w.gkv;
    const float o0 = v[0] * rstd * gg[0], o1 = v[1] * rstd * gg[1];
    *(unsigned*)(p.ckvn + (size_t)kvrow * 128 + lane * 2) = pack2(o0, o1);
    if (!lat) {
      f2_t o = {o0, o1};
      *(f2_t*)(p.out + O_CKV + ((size_t)(b * 4 + l) * 256 + t) * 128 + lane * 2) = o;
    }
  }
  if (lane < 16) {
    const int a = lane >> 3, f = lane & 7;
    const float x1 = cr[384 + a * 16 + f], x2 = cr[384 + a * 16 + 8 + f];
    float o1 = x1, o2 = x2;
    if (!lat) {
      float* dst = p.out + O_KR + ((size_t)(b * 4 + l) * 256 + t) * 32;
      dst[a * 16 + f] = x1;
      dst[a * 16 + 8 + f] = x2;
    } else {
      const float c = p.ropec[t * 16 + a * 8 + f], s = p.ropes[t * 16 + a * 8 + f];
      o1 = x1 * c - x2 * s;
      o2 = x2 * c + x1 * s;
    }
    p.krope[(size_t)kvrow * 32 + a * 16 + f] = f2bf(o1);
    p.krope[(size_t)kvrow * 32 + a * 16 + 8 + f] = f2bf(o2);
  }
  {
#pragma unroll
    for (int i = 0; i < 8; ++i) {
      const int c = i * 64 + lane;
      float acc = w.cb[i];
#pragma unroll
      for (int j = 0; j < 5; ++j) {
        acc += w.cw[i][j] * cr[(j - 2) * PSTR + 672 + c];
      }
      p.xbc[(size_t)tok * 512 + c] = siluf(acc);
    }
  }
  if (lane < 8) {
    const float x = cr[1184 + lane] + w.dtb;
    const float sp = x > 20.f ? x : log1pf(expf(x));
    p.dtb[(size_t)tok * 8 + lane] = sp;
  }
}

DI void prep_tile(CP& p, int l, int ti, char* smem) {
  const int tid = opaque_tid(), wave = tid >> 6;
  int base, t0, T;
  if (ti < 256) { base = (ti >> 4) * 256; t0 = (ti & 15) * 16; T = 256; }
  else { const int j = ti - 256; base = NCTX + (j >> 7) * 2048; t0 = (j & 127) * 16; T = 2048; }
  LAS float* sr = (LAS float*)smem;
  const int lane = tid & 63;
  PrepW pw;
  prep_load_w(p, l, lane, pw);
  __syncthreads();
  u32x4 stg[6];
#pragma unroll
  for (int i = 0; i < 6; ++i) {
    const int idx = tid + i * 512;
    const int row = idx / 149, c8 = idx - row * 149;
    const int t = t0 - 2 + row;
    stg[i] = (u32x4){0u, 0u, 0u, 0u};
    if (idx < 2980 && t >= 0 && t < T) stg[i] = *(const u32x4*)(p.comb + (size_t)(base + t) * INW + c8 * 8);
  }
#pragma unroll
  for (int i = 0; i < 6; ++i) {
    const int idx = tid + i * 512;
    const int row = idx / 149, c8 = idx - row * 149;
    if (idx < 2980) {
      f32x4 lo, hi;
      lo[0] = __uint_as_float(stg[i][0] << 16); lo[1] = __uint_as_float(stg[i][0] & 0xffff0000u);
      lo[2] = __uint_as_float(stg[i][1] << 16); lo[3] = __uint_as_float(stg[i][1] & 0xffff0000u);
      hi[0] = __uint_as_float(stg[i][2] << 16); hi[1] = __uint_as_float(stg[i][2] & 0xffff0000u);
      hi[2] = __uint_as_float(stg[i][3] << 16); hi[3] = __uint_as_float(stg[i][3] & 0xffff0000u);
      *(LAS f32x4*)(sr + row * PSTR + c8 * 8) = lo;
      *(LAS f32x4*)(sr + row * PSTR + c8 * 8 + 4) = hi;
    }
  }
  __syncthreads();
#pragma unroll
  for (int i = 0; i < 2; ++i) {
    const int tt = wave * 2 + i;
    prep_row(p, l, base + t0 + tt, sr + (tt + 2) * PSTR, pw, lane);
  }
}

DI void cm_tile(CP& p, int l, int ti, char* smem) {
  const int tid = opaque_tid(), lane = tid & 63, wave = tid >> 6;
  int base, t0, T;
  if (ti < 128) { base = (ti >> 3) * 256; t0 = (ti & 7) * 32; T = 256; }
  else { const int j = ti - 128; base = NCTX + (j >> 6) * 2048; t0 = (j & 63) * 32; T = 2048; }
  LAS float* sg = (LAS float*)smem;
  LAS float* so = sg + 62 * 256;
  const int c = tid & 255, half = tid >> 8;
  float w[31];
#pragma unroll
  for (int j = 0; j < 31; ++j) w[j] = p.cm_conv_w[(size_t)(l * 31 + j) * 256 + c];
  const float bias = p.cm_conv_b[l * 256 + c];
  __syncthreads();
  {
    u32x4 ra[4], rb[4];
#pragma unroll
    for (int i = 0; i < 4; ++i) {
      const int idx = tid + i * 512;
      const int r = idx >> 5, c8 = idx & 31;
      const int t = t0 - 15 + r;
      ra[i] = (u32x4){0u, 0u, 0u, 0u}; rb[i] = (u32x4){0u, 0u, 0u, 0u};
      if (idx < 62 * 32 && t >= 0 && t < T) {
        const u16* cr = p.comb + (size_t)(base + t) * INW;
        ra[i] = *(const u32x4*)(cr + 1192 + c8 * 8);
        rb[i] = *(const u32x4*)(cr + 1448 + c8 * 8);
      }
    }
#pragma unroll
    for (int i = 0; i < 4; ++i) {
      const int idx = tid + i * 512;
      const int r = idx >> 5, c8 = idx & 31;
      if (idx < 62 * 32) {
        f32x4 lo, hi;
#pragma unroll
        for (int q = 0; q < 2; ++q) {
          lo[2 * q] = __uint_as_float(ra[i][q] << 16) * sigmoidf(__uint_as_float(rb[i][q] << 16));
          lo[2 * q + 1] = __uint_as_float(ra[i][q] & 0xffff0000u) * sigmoidf(__uint_as_float(rb[i][q] & 0xffff0000u));
          hi[2 * q] = __uint_as_float(ra[i][q + 2] << 16) * sigmoidf(__uint_as_float(rb[i][q + 2] << 16));
          hi[2 * q + 1] = __uint_as_float(ra[i][q + 2] & 0xffff0000u) * sigmoidf(__uint_as_float(rb[i][q + 2] & 0xffff0000u));
        }
        *(LAS f32x4*)(sg + r * 256 + c8 * 8) = lo;
        *(LAS f32x4*)(sg + r * 256 + c8 * 8 + 4) = hi;
      }
    }
  }
  __syncthreads();
#pragma unroll 1
  for (int t4 = 0; t4 < 4; ++t4) {
    const int tb = half * 16 + t4 * 4;
    float a0 = bias, a1 = bias, a2 = bias, a3 = bias;
#pragma unroll
    for (int j = 0; j < 34; ++j) {
      const float x = sg[(tb + j) * 256 + c];
      if (j < 31) a0 += w[j] * x;
      if (j >= 1 && j < 32) a1 += w[j - 1] * x;
      if (j >= 2 && j < 33) a2 += w[j - 2] * x;
      if (j >= 3) a3 += w[j - 3] * x;
    }
    so[tb * 256 + c] = a0;
    so[(tb + 1) * 256 + c] = a1;
    so[(tb + 2) * 256 + c] = a2;
    so[(tb + 3) * 256 + c] = a3;
  }
  __syncthreads();
  {
    float lg[4], lb[4];
#pragma unroll
    for (int i = 0; i < 4; ++i) { lg[i] = p.cm_ln_g[l * 256 + lane + 64 * i]; lb[i] = p.cm_ln_b[l * 256 + lane + 64 * i]; }
#pragma unroll
    for (int tt = 0; tt < 4; ++tt) {
      const int t = wave * 4 + tt;
      float v[4];
      float sm = 0.f;
#pragma unroll
      for (int i = 0; i < 4; ++i) { v[i] = so[t * 256 + lane + 64 * i]; sm += v[i]; }
      const float mean = wave_sum(sm) * (1.f / 256.f);
      float q = 0.f;
#pragma unroll
      for (int i = 0; i < 4; ++i) { const float d = v[i] - mean; q += d * d; }
      const float var = wave_sum(q) * (1.f / 256.f);
      const float rstd = rsqrtf(var + 1e-5f);
#pragma unroll
      for (int i = 0; i < 4; ++i) {
        const int cc = lane + 64 * i;
        float y = (v[i] - mean) * rstd * lg[i] + lb[i];
        y = siluf(y);
        p.hb[(size_t)(base + t0 + t) * 1024 + 768 + cc] = f2bf(y);
      }
    }
  }
}

DI void ssd_item(CP& p, int l, int seq, int h, int dir, char* smem) {
  const int tid = opaque_tid(), lane = tid & 63, wave = tid >> 6, lr = lane & 15, g = lane >> 4;
  const int rt = wave & 3, ch = wave >> 2;
  const bool lat = seq >= 16;
  const int b = lat ? seq - 16 : seq;
  const int T = lat ? 2048 : 256;
  const int qbase = lat ? NCTX + b * 2048 : b * 256;
  u16* sC = (u16*)smem;
  u16* sB = sC + 64 * 72;
  u16* sBt = sB + 64 * 72;
  u16* sXt = sBt + 64 * 72;
  u16* sXw = sXt + 64 * 72;
  u16* sM = sXw + 64 * 72;
  u16* sH = sM + 64 * 72;
  float* sdtA = (float*)(sH + 64 * 72);
  float* sacsA = sdtA + 2048;
  float* swA = sacsA + 2048;
  const float Aneg = -expf(p.ssd_a_log[(l * 2 + dir) * 4 + h]);
  const int grp = h >> 1;
  f32x4 hacc[2];
  if (lat) {
    const float* src = p.state_ssd + ((size_t)(((b * 4 + l) * 2 + dir) * 4 + h)) * 4096;
#pragma unroll
    for (int n2 = 0; n2 < 2; ++n2)
#pragma unroll
      for (int i = 0; i < 4; ++i) hacc[n2][i] = src[(rt * 16 + g * 4 + i) * 64 + (ch * 2 + n2) * 16 + lr];
  } else {
#pragma unroll
    for (int n2 = 0; n2 < 2; ++n2) hacc[n2] = (f32x4){0.f, 0.f, 0.f, 0.f};
  }
  __syncthreads();
#pragma unroll
  for (int n2 = 0; n2 < 2; ++n2)
#pragma unroll
    for (int i = 0; i < 4; ++i) sH[(rt * 16 + g * 4 + i) * 72 + (ch * 2 + n2) * 16 + lr] = f2bf(hacc[n2][i]);
  const int nch = T >> 6;
  {
    float dv[4];
#pragma unroll
    for (int i = 0; i < 4; ++i) {
      const int cq = wave + 8 * i;
      dv[i] = cq < nch ? p.dtb[(size_t)(qbase + cq * 64 + lane) * 8 + dir * 4 + h] : 0.f;
    }
#pragma unroll
    for (int i = 0; i < 4; ++i) {
      const int cq = wave + 8 * i;
      float sc = dv[i] * Aneg;
      if (!dir) {
#pragma unroll
        for (int o = 1; o < 64; o <<= 1) { const float tv = __shfl_up(sc, o); if (lane >= o) sc += tv; }
      } else {
#pragma unroll
        for (int o = 1; o < 64; o <<= 1) { const float tv = __shfl_down(sc, o); if (lane + o < 64) sc += tv; }
      }
      const float tot = __shfl(sc, dir ? 0 : 63);
      if (cq < nch) { sdtA[cq * 64 + lane] = dv[i]; sacsA[cq * 64 + lane] = sc; swA[cq * 64 + lane] = __expf(tot - sc) * dv[i]; }
    }
  }
  const int e = lane;
  float xs[8], bs[8], cs[8];
  {
    const int c0 = dir ? nch - 1 : 0;
    const float* rowp = p.xbc + (size_t)(qbase + c0 * 64 + wave * 8) * 512;
#pragma unroll
    for (int i = 0; i < 8; ++i) {
      xs[i] = rowp[i * 512 + h * 64 + e];
      bs[i] = rowp[i * 512 + 256 + grp * 64 + e];
      cs[i] = rowp[i * 512 + 384 + grp * 64 + e];
    }
  }
  __syncthreads();
#pragma unroll 1
  for (int ci = 0; ci < nch; ++ci) {
    const int c = dir ? nch - 1 - ci : ci;
    const int tok0 = qbase + c * 64;
    const float* sdt = sdtA + c * 64;
    const float* sacs = sacsA + c * 64;
    const float total = dir ? sacs[0] : sacs[63];
    {
      const f32x4 w0 = *(const f32x4*)(swA + c * 64 + wave * 8), w1 = *(const f32x4*)(swA + c * 64 + wave * 8 + 4);
#pragma unroll
      for (int i = 0; i < 8; ++i) {
        sC[(wave * 8 + i) * 72 + e] = f2bf(cs[i]);
        sB[(wave * 8 + i) * 72 + e] = f2bf(bs[i]);
      }
      u32x4 tb = {pack2(bs[0], bs[1]), pack2(bs[2], bs[3]), pack2(bs[4], bs[5]), pack2(bs[6], bs[7])};
      u32x4 tx = {pack2(xs[0], xs[1]), pack2(xs[2], xs[3]), pack2(xs[4], xs[5]), pack2(xs[6], xs[7])};
      u32x4 tw = {pack2(xs[0] * w0[0], xs[1] * w0[1]), pack2(xs[2] * w0[2], xs[3] * w0[3]),
                  pack2(xs[4] * w1[0], xs[5] * w1[1]), pack2(xs[6] * w1[2], xs[7] * w1[3])};
      *(u32x4*)(sBt + e * 72 + wave * 8) = tb;
      *(u32x4*)(sXt + e * 72 + wave * 8) = tx;
      *(u32x4*)(sXw + e * 72 + wave * 8) = tw;
    }
    if (ci + 1 < nch) {
      const int cn = dir ? nch - 2 - ci : ci + 1;
      const float* rowp = p.xbc + (size_t)(qbase + cn * 64 + wave * 8) * 512;
#pragma unroll
      for (int i = 0; i < 8; ++i) {
        xs[i] = rowp[i * 512 + h * 64 + e];
        bs[i] = rowp[i * 512 + 256 + grp * 64 + e];
        cs[i] = rowp[i * 512 + 384 + grp * 64 + e];
      }
    }
    __syncthreads();
    f32x4 gacc[2];
#pragma unroll
    for (int s2 = 0; s2 < 2; ++s2) gacc[s2] = (f32x4){0.f, 0.f, 0.f, 0.f};
#pragma unroll
    for (int ks = 0; ks < 2; ++ks) {
      const bf16x8 cf = *(const bf16x8*)(sC + (rt * 16 + lr) * 72 + ks * 32 + g * 8);
#pragma unroll
      for (int s2 = 0; s2 < 2; ++s2) {
        const bf16x8 bfr = *(const bf16x8*)(sB + ((ch * 2 + s2) * 16 + lr) * 72 + ks * 32 + g * 8);
        gacc[s2] = MFMA(cf, bfr, gacc[s2]);
      }
    }
    int opq;
    asm volatile("v_mov_b32 %0, 0" : "=v"(opq));
#pragma unroll
    for (int s2 = 0; s2 < 2; ++s2) {
      const int si = (ch * 2 + s2) * 16 + lr + opq;
      const float acs_s = sacs[si], dt_s = sdt[si];
#pragma unroll
      for (int i = 0; i < 4; ++i) {
        const int li = rt * 16 + g * 4 + i;
        const float acs_l = sacs[li];
        const bool ok = dir ? (si >= li) : (si <= li);
        const float mval = ok ? gacc[s2][i] * __expf(acs_l - acs_s) * dt_s : 0.f;
        sM[li * 72 + si] = f2bf(mval);
      }
    }
    __syncthreads();
    f32x4 yd[2], yo[2];
#pragma unroll
    for (int p2 = 0; p2 < 2; ++p2) { yd[p2] = (f32x4){0.f, 0.f, 0.f, 0.f}; yo[p2] = (f32x4){0.f, 0.f, 0.f, 0.f}; }
#pragma unroll
    for (int ks = 0; ks < 2; ++ks) {
      const bf16x8 mf = *(const bf16x8*)(sM + (rt * 16 + lr) * 72 + ks * 32 + g * 8);
      const bf16x8 cf = *(const bf16x8*)(sC + (rt * 16 + lr) * 72 + ks * 32 + g * 8);
#pragma unroll
      for (int p2 = 0; p2 < 2; ++p2) {
        const bf16x8 xf = *(const bf16x8*)(sXt + ((ch * 2 + p2) * 16 + lr) * 72 + ks * 32 + g * 8);
        const bf16x8 hf = *(const bf16x8*)(sH + ((ch * 2 + p2) * 16 + lr) * 72 + ks * 32 + g * 8);
        yd[p2] = MFMA(mf, xf, yd[p2]);
        yo[p2] = MFMA(cf, hf, yo[p2]);
      }
    }
#pragma unroll
    for (int i = 0; i < 4; ++i) {
      const int li = rt * 16 + g * 4 + i;
      const float e = __expf(sacs[li]);
      float* yrow = p.ydir + ((size_t)dir * NTOK + tok0 + li) * 256 + h * 64 + ch * 32 + lr;
#pragma unroll
      for (int p2 = 0; p2 < 2; ++p2) yrow[p2 * 16] = yd[p2][i] + e * yo[p2][i];
    }
    f32x4 hn[2];
#pragma unroll
    for (int n2 = 0; n2 < 2; ++n2) hn[n2] = (f32x4){0.f, 0.f, 0.f, 0.f};
#pragma unroll
    for (int ks = 0; ks < 2; ++ks) {
      const bf16x8 xw = *(const bf16x8*)(sXw + (rt * 16 + lr) * 72 + ks * 32 + g * 8);
#pragma unroll
      for (int n2 = 0; n2 < 2; ++n2) {
        const bf16x8 bt = *(const bf16x8*)(sBt + ((ch * 2 + n2) * 16 + lr) * 72 + ks * 32 + g * 8);
        hn[n2] = MFMA(xw, bt, hn[n2]);
      }
    }
    const float et = __expf(total);
#pragma unroll
    for (int n2 = 0; n2 < 2; ++n2) hacc[n2] = hacc[n2] * et + hn[n2];
    __syncthreads();
#pragma unroll
    for (int n2 = 0; n2 < 2; ++n2)
#pragma unroll
      for (int i = 0; i < 4; ++i) sH[(rt * 16 + g * 4 + i) * 72 + (ch * 2 + n2) * 16 + lr] = f2bf(hacc[n2][i]);
  }
  if (!lat) {
    float* dst = p.out + O_SSD + ((size_t)(((b * 4 + l) * 2 + dir) * 4 + h)) * 4096;
#pragma unroll
    for (int n2 = 0; n2 < 2; ++n2)
#pragma unroll
      for (int i = 0; i < 4; ++i) dst[(rt * 16 + g * 4 + i) * 64 + (ch * 2 + n2) * 16 + lr] = hacc[n2][i];
  }
}

DI void ssd_final_rows4(CP& p, int l, int tok0) {
  const int lane = opaque_tid() & 63;
  const int c = lane * 4, h = c >> 6;
  const float dd = p.ssd_d[(l * 2 + 0) * 4 + h] + p.ssd_d[(l * 2 + 1) * 4 + h];
  const f32x4 gg = *(const f32x4*)(p.ssd_norm_g + l * 256 + c);
  f32x4 y0[4], y1[4], xs[4];
  u32x2 zr[4];
#pragma unroll
  for (int a = 0; a < 4; ++a) {
    const int tok = tok0 + a;
    y0[a] = *(const f32x4*)(p.ydir + (size_t)tok * 256 + c);
    y1[a] = *(const f32x4*)(p.ydir + ((size_t)NTOK + tok) * 256 + c);
    xs[a] = *(const f32x4*)(p.xbc + (size_t)tok * 512 + c);
    zr[a] = *(const u32x2*)(p.comb + (size_t)tok * INW + 416 + c);
  }
#pragma unroll
  for (int a = 0; a < 4; ++a) {
    const int tok = tok0 + a;
    const f32x4 z = {__uint_as_float(zr[a][0] << 16), __uint_as_float(zr[a][0] & 0xffff0000u), __uint_as_float(zr[a][1] << 16),
                     __uint_as_float(zr[a][1] & 0xffff0000u)};
    f32x4 v;
    float ss = 0.f;
#pragma unroll
    for (int j = 0; j < 4; ++j) {
      v[j] = (y0[a][j] + y1[a][j] + dd * xs[a][j]) * siluf(z[j]);
      ss += v[j] * v[j];
    }
    ss = wave_sum(ss);
    const float rstd = rsqrtf(ss * (1.f / 256.f) + 1e-6f);
    u32x2 pk = {pack2(v[0] * rstd * gg[0], v[1] * rstd * gg[1]), pack2(v[2] * rstd * gg[2], v[3] * rstd * gg[3])};
    *(u32x2*)(p.hb + (size_t)tok * 1024 + 512 + c) = pk;
  }
}

DI void attn_item(CP& p, int seq, int h, int qb, char* smem) {
  const int tid = opaque_tid(), lane = tid & 63, wave = tid >> 6, lr = lane & 15, g = lane >> 4;
  const bool lat = seq >= 16;
  int Tk, kvbase, qtok0;
  if (!lat) { Tk = 256; kvbase = seq * 256; qtok0 = seq * 256; }
  else { const int b = seq - 16; Tk = 2304; kvbase = NCTX + b * 2304; qtok0 = NCTX + b * 2048 + qb * 256; }
  LAS u16* sKb = (LAS u16*)smem;
  LAS u16* sVb = sKb + 256 * 104;
  bf16x8 qf[2][3];
#pragma unroll
  for (int qt = 0; qt < 2; ++qt) {
    const int tok = qtok0 + wave * 32 + qt * 16 + lr;
#pragma unroll
    for (int ks = 0; ks < 3; ++ks) qf[qt][ks] = *(const bf16x8*)(p.qbuf + (size_t)tok * 768 + h * 96 + ks * 32 + g * 8);
    if (lat) {
      const int t = (tok - NCTX) & 2047;
      const int axis = g >> 1, half = g & 1;
      const float* cs = p.ropec + t * 16 + axis * 8;
      const float* sn = p.ropes + t * 16 + axis * 8;
      bf16x8 r;
#pragma unroll
      for (int j = 0; j < 8; ++j) {
        const float x = bf2f((u16)qf[qt][2][j]);
        const float pr = __shfl_xor(x, 16);
        const float c = cs[j], s = sn[j];
        const float o = half ? x * c + pr * s : x * c - pr * s;
        r[j] = (short)f2bf(o);
      }
      qf[qt][2] = r;
    }
  }
  f32x4 o[2][4];
#pragma unroll
  for (int qt = 0; qt < 2; ++qt)
#pragma unroll
    for (int dt = 0; dt < 4; ++dt) o[qt][dt] = (f32x4){0.f, 0.f, 0.f, 0.f};
  float mrow[2] = {-1e30f, -1e30f}, lrow[2] = {0.f, 0.f};
  const float cs2 = 0.10206207261596574f * 1.4426950408889634f;
  const int nst = Tk >> 8;
  const u16* gk = p.knope + (size_t)(kvbase + (tid >> 3)) * 512 + h * 64 + (tid & 7) * 8;
  const u16* gr = p.krope + (size_t)(kvbase + (tid >> 2)) * 32 + (tid & 3) * 8;
  const u16* gv = p.vt + (size_t)512 * kvbase + (size_t)(h * 64 + (tid >> 5)) * Tk + (tid & 31) * 8;
  u32x4 rk[4], rr[2], rv[4];
#pragma unroll
  for (int i = 0; i < 4; ++i) { rk[i] = *(const u32x4*)(gk + (size_t)i * 64 * 512); rv[i] = *(const u32x4*)(gv + (size_t)i * 16 * Tk); }
#pragma unroll
  for (int i = 0; i < 2; ++i) rr[i] = *(const u32x4*)(gr + (size_t)i * 128 * 32);
#pragma unroll 1
  for (int st = 0; st < nst; ++st) {
    __syncthreads();
#pragma unroll
    for (int i = 0; i < 4; ++i) {
      *(LAS u32x4*)(sKb + ((tid >> 3) + i * 64) * 104 + (tid & 7) * 8) = rk[i];
      *(LAS u32x4*)(sVb + ((tid >> 5) + i * 16) * 264 + (tid & 31) * 8) = rv[i];
    }
#pragma unroll
    for (int i = 0; i < 2; ++i) *(LAS u32x4*)(sKb + ((tid >> 2) + i * 128) * 104 + 64 + (tid & 3) * 8) = rr[i];
    __syncthreads();
    if (st + 1 < nst) {
      const size_t ko = (size_t)(st + 1) * 256;
#pragma unroll
      for (int i = 0; i < 4; ++i) { rk[i] = *(const u32x4*)(gk + (ko + i * 64) * 512); rv[i] = *(const u32x4*)(gv + (size_t)i * 16 * Tk + ko); }
#pragma unroll
      for (int i = 0; i < 2; ++i) rr[i] = *(const u32x4*)(gr + (ko + i * 128) * 32);
    }
#pragma unroll 1
    for (int kt = 0; kt < 4; ++kt) {
      const LAS u16* sK = sKb + kt * 64 * 104;
      const LAS u16* sV = sVb + kt * 64;
      f32x4 s[4][2];
#pragma unroll
      for (int k4 = 0; k4 < 4; ++k4) {
        s[k4][0] = (f32x4){0.f, 0.f, 0.f, 0.f};
        s[k4][1] = (f32x4){0.f, 0.f, 0.f, 0.f};
#pragma unroll
        for (int ks = 0; ks < 3; ++ks) {
          const bf16x8 kf = *(const LAS bf16x8*)(sK + (k4 * 16 + lr) * 104 + ks * 32 + g * 8);
          s[k4][0] = MFMA(kf, qf[0][ks], s[k4][0]);
          s[k4][1] = MFMA(kf, qf[1][ks], s[k4][1]);
        }
      }
      bf16x8 pf[2][2];
#pragma unroll
      for (int qt = 0; qt < 2; ++qt) {
        float mx = -1e30f;
#pragma unroll
        for (int k4 = 0; k4 < 4; ++k4)
#pragma unroll
          for (int i = 0; i < 4; ++i) mx = fmaxf(mx, s[k4][qt][i]);
        mx = xrow16_max(mx);
        const float mnew = fmaxf(mrow[qt], mx * cs2);
        const float alpha = __builtin_amdgcn_exp2f(mrow[qt] - mnew);
        mrow[qt] = mnew;
        float psum = 0.f;
        float pv[4][4];
#pragma unroll
        for (int k4 = 0; k4 < 4; ++k4)
#pragma unroll
          for (int i = 0; i < 4; ++i) {
            pv[k4][i] = __builtin_amdgcn_exp2f(s[k4][qt][i] * cs2 - mnew);
            psum += pv[k4][i];
          }
        lrow[qt] = lrow[qt] * alpha + psum;
        if (__builtin_amdgcn_ballot_w64(alpha != 1.f) != 0ull) {
#pragma unroll
          for (int dt = 0; dt < 4; ++dt) o[qt][dt] *= alpha;
        }
#pragma unroll
        for (int s2 = 0; s2 < 2; ++s2) {
          u32x4 pk = {pack2(pv[2 * s2][0], pv[2 * s2][1]), pack2(pv[2 * s2][2], pv[2 * s2][3]),
                      pack2(pv[2 * s2 + 1][0], pv[2 * s2 + 1][1]), pack2(pv[2 * s2 + 1][2], pv[2 * s2 + 1][3])};
          pf[qt][s2] = __builtin_bit_cast(bf16x8, pk);
        }
      }
#pragma unroll
      for (int s2 = 0; s2 < 2; ++s2)
#pragma unroll
        for (int dt = 0; dt < 4; ++dt) {
          const s16x4 lo = *(const LAS s16x4*)(sV + (dt * 16 + lr) * 264 + s2 * 32 + g * 4);
          const s16x4 hi = *(const LAS s16x4*)(sV + (dt * 16 + lr) * 264 + s2 * 32 + 16 + g * 4);
          const bf16x8 vf = __builtin_shufflevector(lo, hi, 0, 1, 2, 3, 4, 5, 6, 7);
          o[0][dt] = MFMA(vf, pf[0][s2], o[0][dt]);
          o[1][dt] = MFMA(vf, pf[1][s2], o[1][dt]);
        }
    }
  }
#pragma unroll
  for (int qt = 0; qt < 2; ++qt) {
    float lsum = lrow[qt];
    lsum = xrow16_sum(lsum);
    const float inv = frcp(lsum);
    const int tok = qtok0 + wave * 32 + qt * 16 + lr;
#pragma unroll
    for (int dt = 0; dt < 4; ++dt) {
      u32x2 pk = {pack2(o[qt][dt][0] * inv, o[qt][dt][1] * inv), pack2(o[qt][dt][2] * inv, o[qt][dt][3] * inv)};
      *(u32x2*)(p.hb + (size_t)tok * 1024 + h * 64 + dt * 16 + g * 4) = pk;
    }
  }
}

DI int next_item(unsigned* ctr, int* slot) {
  __syncthreads();
  if (threadIdx.x == 0) *slot = (int)atomicAdd(ctr, 1u);
  __syncthreads();
  return *slot;
}

DI void forward(char* smem) {
  const int G = gridDim.x, bid = blockIdx.x;
  const int wave = threadIdx.x >> 6;
  int* slot = (int*)(smem + LDS_MAIN + 32);
  int ph = 0;
  XcdBarrier xb;
  {
    unsigned* stw = (unsigned*)(smem + LDS_MAIN);
    if (threadIdx.x == 0) { stw[0] = 0u; stw[1] = 0u; }
    __syncthreads();
    CP& p0 = get_params();
    xb = xcd_barrier_post(p0.bar, (volatile LAS unsigned*)stw);
    (void)xb;
  }
#define PH_BEGIN { CP& p = get_params();
#if USE_CG_SYNC
#define PH_END } { if (ph == 0) cg::this_grid().sync(); else { XcdBarrier xq; xq.bar = nullptr; xq.x = 0u; xq.st = (volatile LAS unsigned*)(smem + LDS_MAIN); xcd_barrier(xq); } } ++ph;
#else
#define PH_END } { XcdBarrier xq; xq.bar = nullptr; xq.x = 0u; xq.st = (volatile LAS unsigned*)(smem + LDS_MAIN); xcd_barrier(xq); } ++ph;
#endif

  PH_BEGIN
    phase0(p, smem);
  PH_END

#pragma unroll 1
  for (int l = 0; l < 4; ++l) {
    PH_BEGIN
      norm_phase(p, l, 0);
    PH_END
    PH_BEGIN
      gemm_phase<E_COMB, 192>(p, l, p.hb, p.wt_in + (size_t)l * INWP * 1024, 1024, 64, 7, 0, bid, G, 64 * 7, true, smem);
    PH_END
    PH_BEGIN
      for (int t = bid; t < 768 + 128; t += G) {
        if (t < 768) prep_tile(p, l, t, smem);
        else prep_cache_row(p, l, NTOK + (t - 768) * 8 + wave);
      }
    PH_END
    PH_BEGIN
      for (;;) {
        const int it = next_item(p.ctr + ph, slot);
        if (it >= 160 + 384 + 208 + 144) break;
        if (it < 32 || (it >= 416 && it < 544)) {
          const int j = it < 32 ? it : it - 416;
          ssd_item(p, l, (it < 32 ? 16 : 0) + (j >> 3), (j >> 1) & 3, j & 1, smem);
        } else if (it < 416) {
          cm_tile(p, l, it - 32, smem);
        } else if (it < 752) {
          const int t = it - 544;
          gemm_phase<E_KV, 256>(p, l, p.ckvn, p.wt_ukv + (size_t)l * 1024 * 128, 128, 52, 4, 0, t, 1 << 20, 208, false, smem);
        } else {
          const int t = it - 752;
          gemm_phase<E_Q, 256>(p, l, p.qn, p.wt_uq + (size_t)l * 768 * 256, 256, 48, 3, 0, t, 1 << 20, 144, false, smem);
        }
      }
      if (l < 3) conv_fill(p, l + 1, 0, 5792, p.ctr + 128 + ph, slot, smem);
    PH_END
    PH_BEGIN
      for (;;) {
        const int it = next_item(p.ctr + ph, slot);
        if (it >= 384 + 384) break;
        if (it < 384) {
          int sq, hh, qb;
          if (it < 256) { sq = 16 + (it >> 6); hh = (it >> 3) & 7; qb = it & 7; }
          else { const int j = it - 256; sq = j >> 3; hh = j & 7; qb = 0; }
          attn_item(p, sq, hh, qb, smem);
        } else {
          const int t0 = (it - 384) * 32 + wave * 4;
          ssd_final_rows4(p, l, t0);
        }
      }
    PH_END
    PH_BEGIN
      gemm_phase<E_RES, 192>(p, l, p.hb, p.wt_out + (size_t)l * 1024 * 1024, 1024, 64, 4, 2048, bid, G, 64 * 4, true, smem);
    PH_END
    PH_BEGIN
      norm_phase(p, l, 1);
    PH_END
    PH_BEGIN
      gemm_phase<E_SWIGLU, 192>(p, l, p.hb, p.wt_gu + (size_t)l * 2 * DFF * 1024, 1024, 64, 22, 0, bid, G, 64 * 22, true, smem);
    PH_END
    PH_BEGIN
      gemm_phase<E_RES, 192>(p, l, p.act, p.wt_down + (size_t)l * 1024 * DFF, DFF, 64, 4, 5120, bid, G, 64 * 4, true, smem);
    PH_END
  }
  { CP& p = get_params(); final_norm(p); }
}

extern __shared__ __attribute__((aligned(1024))) char dyn_smem[];

__global__ void __launch_bounds__(NTHREADS, 2) k_mega(P p) { forward(dyn_smem); }

extern "C" void kernel_launch(void* const* d_in, const int* in_sizes, int n_in, void* d_out, int out_size, void* d_ws,
                              size_t ws_size, hipStream_t stream) {
  P p{};
  const float** fp = (const float**)&p;
  for (int i = 0; i < 31; ++i) fp[i] = (const float*)d_in[i];
  p.out = (float*)d_out;
  char* ws = (char*)d_ws;
  size_t off = 0;
  auto take = [&](size_t bytes) { char* r = ws + off; off += (bytes + 255) & ~(size_t)255; return r; };
  p.bar = (unsigned*)take(16384);
  p.ctr = (unsigned*)take(16384);
  p.wt_in = (u16*)take((size_t)4 * INWP * 1024 * 2);
  p.wt_uq = (u16*)take((size_t)4 * 768 * 256 * 2);
  p.wt_ukv = (u16*)take((size_t)4 * 1024 * 128 * 2);
  p.wt_out = (u16*)take((size_t)4 * 1024 * 1024 * 2);
  p.wt_gu = (u16*)take((size_t)4 * 2 * DFF * 1024 * 2);
  p.wt_down = (u16*)take((size_t)4 * 1024 * DFF * 2);
  p.mod = (float*)take((size_t)4 * 5 * 6144 * 4);
  p.ropec = (float*)take(2048 * 16 * 4);
  p.ropes = (float*)take(2048 * 16 * 4);
  p.hb = (u16*)take((size_t)NTOK * 1024 * 2);
  p.comb = (u16*)take((size_t)NTOK * DFF * 2);
  p.act = p.comb;
  p.qn = (u16*)take((size_t)NTOK * 256 * 2);
  p.ckvn = (u16*)take((size_t)KVROWS * 128 * 2);
  p.qbuf = (u16*)take((size_t)NTOK * 768 * 2);
  p.knope = (u16*)take((size_t)KVROWS * 512 * 2);
  p.vt = (u16*)take((size_t)KVROWS * 512 * 2);
  p.krope = (u16*)take((size_t)KVROWS * 32 * 2);
  p.xbc = (float*)take((size_t)NTOK * 512 * 4);
  p.dtb = (float*)take((size_t)NTOK * 8 * 4);
  p.ydir = (float*)take((size_t)2 * NTOK * 256 * 4);
  if (off > ws_size) { fprintf(stderr, "workspace too small: need %zu have %zu\n", off, ws_size); return; }

  static int grid_blocks = 0;
  if (!grid_blocks) {
    int dev = 0, cus = 0, per_cu = 0;
    (void)hipGetDevice(&dev);
    (void)hipDeviceGetAttribute(&cus, hipDeviceAttributeMultiprocessorCount, dev);
    (void)hipFuncSetAttribute((const void*)k_mega, hipFuncAttributeMaxDynamicSharedMemorySize, LDS_BYTES);
    (void)hipOccupancyMaxActiveBlocksPerMultiprocessor(&per_cu, (const void*)k_mega, NTHREADS, LDS_BYTES);
    if (per_cu > 1) per_cu = 1;
    if (per_cu < 1) per_cu = 1;
    grid_blocks = cus * per_cu;
  }
  (void)hipMemsetAsync(d_ws, 0, 32768, stream);
  void* args[] = {&p};
  hipError_t e = hipLaunchCooperativeKernel((const void*)k_mega, dim3(grid_blocks), dim3(NTHREADS), args, LDS_BYTES, stream);
  if (e != hipSuccess) fprintf(stderr, "cooperative launch failed: %s (grid %d)\n", hipGetErrorString(e), grid_blocks);
}
```

```cpp
#include <hip/hip_runtime.h>
#include <hip/hip_cooperative_groups.h>
#include <stdint.h>
#include <stdio.h>
namespace cg = cooperative_groups;

#ifndef USE_CG_SYNC
#define USE_CG_SYNC 0
#endif

#define DI __device__ __forceinline__
#define LAS __attribute__((address_space(3)))
typedef unsigned short u16;
typedef __bf16 bf2_t __attribute__((ext_vector_type(2)));
typedef float f2_t __attribute__((ext_vector_type(2)));
using bf16x8 = __attribute__((ext_vector_type(8))) short;
using s16x4 = __attribute__((ext_vector_type(4))) short;
using f32x4 = __attribute__((ext_vector_type(4))) float;
using u32x4 = __attribute__((ext_vector_type(4))) unsigned;
using u32x2 = __attribute__((ext_vector_type(2))) unsigned;

#define MFMA(a, b, c) __builtin_amdgcn_mfma_f32_16x16x32_bf16((a), (b), (c), 0, 0, 0)

constexpr int NTOK = 12288, NCTX = 4096, KVROWS = 13312;
constexpr int INW = 1704, INWP = 1792, DFF = 2816;
constexpr size_t O_CKV = 12582912, O_KR = 14680064, O_SSD = 15204352;
constexpr int LDS_MAIN = 131072;
constexpr int LDS_BYTES = LDS_MAIN + 64;
constexpr int NTHREADS = 512;

struct P {
  const float *x_prompt, *x_sample, *c, *cache_ckv, *cache_krope, *state_ssd, *c_ctx, *w_ada, *b_ada, *g_mix, *w_in,
      *g_q, *w_uq, *g_kv, *w_ukv, *ssd_conv_w, *ssd_conv_b, *ssd_dt_bias, *ssd_a_log, *ssd_d, *ssd_norm_g, *cm_conv_w,
      *cm_conv_b, *cm_ln_g, *cm_ln_b, *w_out, *g_ffn, *w_gate, *w_up, *w_down, *g_final;
  float* out;
  unsigned* bar;
  unsigned* ctr;
  u16 *wt_in, *wt_uq, *wt_ukv, *wt_out, *wt_gu, *wt_down;
  float *mod, *ropec, *ropes;
  u16* hb;
  u16* comb;
  u16* act;
  u16 *qn, *ckvn, *qbuf, *knope, *vt, *krope;
  float *xbc, *dtb, *ydir;
};

typedef const __attribute__((address_space(4))) P CP;
DI CP& get_params() {
  unsigned long long kp = (unsigned long long)__builtin_amdgcn_kernarg_segment_ptr();
  asm volatile("" : "+s"(kp));
  return *(CP*)kp;
}
DI int opaque_tid() { int t = threadIdx.x; asm volatile("" : "+v"(t)); return t; }

DI unsigned pack2(float a, float b) {
  f2_t v = {a, b};
  bf2_t r = __builtin_convertvector(v, bf2_t);
  return __builtin_bit_cast(unsigned, r);
}
DI u16 f2bf(float a) { return (u16)(pack2(a, 0.f) & 0xffffu); }
DI float bf2f(u16 v) { return __uint_as_float(((unsigned)v) << 16); }
DI float frcp(float x) { return __builtin_amdgcn_rcpf(x); }
DI float xrow16_max(float x) {
  auto s = __builtin_amdgcn_permlane16_swap(__float_as_uint(x), __float_as_uint(x), false, false);
  x = fmaxf(__uint_as_float(s[0]), __uint_as_float(s[1]));
  auto t = __builtin_amdgcn_permlane32_swap(__float_as_uint(x), __float_as_uint(x), false, false);
  return fmaxf(__uint_as_float(t[0]), __uint_as_float(t[1]));
}
DI float xrow16_sum(float x) {
  auto s = __builtin_amdgcn_permlane16_swap(__float_as_uint(x), __float_as_uint(x), false, false);
  x = __uint_as_float(s[0]) + __uint_as_float(s[1]);
  auto t = __builtin_amdgcn_permlane32_swap(__float_as_uint(x), __float_as_uint(x), false, false);
  return __uint_as_float(t[0]) + __uint_as_float(t[1]);
}
template <int CTRL> DI float dppf(float x) {
  return __builtin_bit_cast(float, __builtin_amdgcn_mov_dpp(__builtin_bit_cast(int, x), CTRL, 0xf, 0xf, true));
}
DI float wave_sum(float x) {
  x += dppf<0xB1>(x);
  x += dppf<0x4E>(x);
  x += dppf<0x141>(x);
  x += dppf<0x128>(x);
  return xrow16_sum(x);
}
DI float sigmoidf(float x) { return frcp(1.f + __expf(-x)); }
DI float siluf(float x) { return x * frcp(1.f + __expf(-x)); }

#define XB_TMO      128
#define XB_XCNT(j)  (256  + 64 * (j))
#define XB_XSUB(j)  (1280 + 64 * (j))
#define XB_XGEN(j)  (2304 + 64 * (j))
#define XB_TOP      3328
#define XB_TOPGEN   3392
#define XB_SPIN_CAP (1u << 20)
DI unsigned xb_ld(unsigned* p) { return __hip_atomic_load(p, __ATOMIC_RELAXED, __HIP_MEMORY_SCOPE_AGENT); }
DI unsigned xb_add(unsigned* p, unsigned v) { return __hip_atomic_fetch_add(p, v, __ATOMIC_RELAXED, __HIP_MEMORY_SCOPE_AGENT); }
DI unsigned xb_xcc_id() { return (unsigned)__builtin_amdgcn_s_getreg((3 << 11) | 20) & 0xFu; }
#define XB_SPIN(cond, bar) do { unsigned _sp = 0; while (cond) { __builtin_amdgcn_s_sleep(1); \
    if ((++_sp & 255u) == 0u) { if (xb_ld(&(bar)[XB_TMO])) break; if (_sp > XB_SPIN_CAP) { atomicAdd(&(bar)[XB_TMO], 1u); break; } } } } while (0)
struct XcdBarrier { unsigned* bar; unsigned x; volatile LAS unsigned* st; };
DI XcdBarrier xcd_barrier_post(unsigned* bar, volatile LAS unsigned* st) {
  XcdBarrier b; b.bar = bar; b.x = xb_xcc_id(); b.st = st;
  if (threadIdx.x == 0) (void)xb_add(&bar[XB_XCNT(b.x)], 1u);
  return b;
}
DI void xcd_barrier_complete(unsigned* bar, unsigned x, unsigned& nloc, unsigned& nx) {
  const unsigned G = gridDim.x * gridDim.y * gridDim.z;
  unsigned sum, cnt, mine, sp = 0u;
  for (;;) {
    sum = 0u; cnt = 0u; mine = 0u;
#pragma unroll
    for (unsigned j = 0; j < 16; ++j) { const unsigned c = xb_ld(&bar[XB_XCNT(j)]); sum += c; cnt += (c > 0u) ? 1u : 0u; mine = (j == x) ? c : mine; }
    if (sum == G) break;
    __builtin_amdgcn_s_sleep(1);
    if ((++sp & 255u) == 0u) { if (xb_ld(&bar[XB_TMO])) break; if (sp > XB_SPIN_CAP) { atomicAdd(&bar[XB_TMO], 1u); break; } }
  }
  nloc = mine > 0u ? mine : 1u; nx = cnt > 0u ? cnt : 1u;
}
DI void xcd_barrier(const XcdBarrier& b0) {
  asm volatile("s_waitcnt vmcnt(0)" ::: "memory");
  __syncthreads();
  if (threadIdx.x == 0) {
    XcdBarrier b; b.bar = get_params().bar; b.x = xb_xcc_id(); b.st = b0.st;
    unsigned* bar = b.bar;
    __builtin_amdgcn_s_waitcnt(0);
    unsigned nloc = b.st[0], nx = b.st[1];
    if (nloc == 0u) { xcd_barrier_complete(bar, b.x, nloc, nx); b.st[0] = nloc; b.st[1] = nx; }
    const unsigned old = xb_add(&bar[XB_XSUB(b.x)], 1u);
    const unsigned gen = old / nloc;
    if (old + 1u == (gen + 1u) * nloc) {
      __builtin_amdgcn_fence(__ATOMIC_RELEASE, "agent");
      asm volatile("s_waitcnt vmcnt(0)" ::: "memory");
      const unsigned og = xb_add(&bar[XB_TOP], 1u);
      const unsigned tg = og / nx;
      if (og + 1u == (tg + 1u) * nx) xb_add(&bar[XB_TOPGEN], 1u);
      else XB_SPIN(xb_ld(&bar[XB_TOPGEN]) == tg, bar);
      __builtin_amdgcn_fence(__ATOMIC_ACQUIRE, "agent");
      xb_add(&bar[XB_XGEN(b.x)], 1u);
      asm volatile("s_waitcnt vmcnt(0)" ::: "memory");
    } else {
      XB_SPIN(xb_ld(&bar[XB_XGEN(b.x)]) == gen, bar);
      __builtin_amdgcn_fence(__ATOMIC_ACQUIRE, "agent");
      asm volatile("s_waitcnt vmcnt(0)" ::: "memory");
    }
  }
  __syncthreads();
}

enum { E_COMB = 0, E_Q = 1, E_KV = 2, E_RES = 3, E_SWIGLU = 4 };

DI int lds_byte(int r, int c) {
  const int st = (r >> 4) * 2 + (c >> 5), ob = (r & 15) * 64 + (c & 31) * 2;
  return st * 1024 + (ob ^ (((ob >> 9) & 1) << 5));
}
DI void stage_rc(int b, int& R, int& C) {
  const int st = b >> 10, sb = b & 1023, swz = sb ^ (((sb >> 9) & 1) << 5);
  R = (st >> 1) * 16 + swz / 64;
  C = (st & 1) * 32 + (swz % 64) / 2;
}
DI void tile_rc(int t, int nM, int nN, int& pm, int& pn) {
  const int nwg = nM * nN;
  const int q = nwg / 8, r = nwg % 8, xcd = t % 8, off = t / 8;
  const int w = (xcd < r ? xcd * (q + 1) : r * (q + 1) + (xcd - r) * q) + off;
  const int nig = 8 * nN, gid = w / nig, fm = gid * 8;
  const int gsz = (nM - fm) < 8 ? (nM - fm) : 8;
  pm = fm + ((w % nig) % gsz);
  pn = (w % nig) / gsz;
}

DI u32x4 widen16(u32x2 a, u32x2 b) {
  auto s0 = __builtin_amdgcn_permlane16_swap(a[0], b[0], false, false);
  auto s1 = __builtin_amdgcn_permlane16_swap(a[1], b[1], false, false);
  u32x4 r = {s0[0], s1[0], s0[1], s1[1]};
  return r;
}

template <int EPI, int MT>
DI void gemm_epilogue(CP& p, int l, const f32x4 (&acc)[MT][4], int mb, int nb, int goff, int fr, int fq) {
  if (EPI == E_COMB || EPI == E_Q || EPI == E_SWIGLU) {
    const int tsel = fq & 1, csel = (fq >> 1) * 8;
#pragma unroll
    for (int mi = 0; mi < MT; ++mi) {
      const int m = mb + mi * 16 + fr;
      if (EPI == E_SWIGLU) {
        u32x2 r[2];
#pragma unroll
        for (int q = 0; q < 2; ++q) {
          const f32x4 gv = acc[mi][2 * q], uv = acc[mi][2 * q + 1];
          r[q] = (u32x2){pack2(siluf(gv[0]) * uv[0], siluf(gv[1]) * uv[1]), pack2(siluf(gv[2]) * uv[2], siluf(gv[3]) * uv[3])};
        }
        const u32x4 w = widen16(r[0], r[1]);
        *(u32x4*)(p.act + (size_t)m * DFF + (nb >> 1) + tsel * 16 + csel) = w;
      } else {
#pragma unroll
        for (int q = 0; q < 2; ++q) {
          const f32x4 va = acc[mi][2 * q], vb = acc[mi][2 * q + 1];
          const u32x2 a = {pack2(va[0], va[1]), pack2(va[2], va[3])};
          const u32x2 b = {pack2(vb[0], vb[1]), pack2(vb[2], vb[3])};
          const u32x4 w = widen16(a, b);
          const int n = nb + (2 * q + tsel) * 16 + csel;
          if (EPI == E_COMB) { if (n < INW) *(u32x4*)(p.comb + (size_t)m * INW + n) = w; }
          else *(u32x4*)(p.qbuf + (size_t)m * 768 + n) = w;
        }
      }
    }
    return;
  }
#pragma unroll
  for (int mi = 0; mi < MT; ++mi) {
    const int m = mb + mi * 16 + fr;
#pragma unroll
    for (int ni = 0; ni < 4; ++ni) {
      const int n = nb + ni * 16 + fq * 4;
      const f32x4 v = acc[mi][ni];
      if (EPI == E_COMB) {
        if (n < INW) { u32x2 o = {pack2(v[0], v[1]), pack2(v[2], v[3])}; *(u32x2*)(p.comb + (size_t)m * INW + n) = o; }
      } else if (EPI == E_Q) {
        u32x2 o = {pack2(v[0], v[1]), pack2(v[2], v[3])};
        *(u32x2*)(p.qbuf + (size_t)m * 768 + n) = o;
      } else if (EPI == E_KV) {
        const int hh = n >> 7, c = n & 127;
        if (c < 64) {
          u32x2 o = {pack2(v[0], v[1]), pack2(v[2], v[3])};
          *(u32x2*)(p.knope + (size_t)m * 512 + hh * 64 + c) = o;
        } else {
          int kvbase, Tk;
          if (m < NCTX) { kvbase = m & ~255; Tk = 256; }
          else { const int b = (m - NCTX) / 2304; kvbase = NCTX + b * 2304; Tk = 2304; }
          u16* dst = p.vt + (size_t)512 * kvbase + (size_t)(hh * 64 + (c - 64)) * Tk + (m - kvbase);
#pragma unroll
          for (int i = 0; i < 4; ++i) dst[(size_t)i * Tk] = f2bf(v[i]);
        }
      } else if (EPI == E_RES) {
        const int vs = m < NCTX ? 0 : 1 + ((m - NCTX) >> 11);
        const f32x4 gt = *(const f32x4*)(p.mod + (size_t)(l * 5 + vs) * 6144 + goff + n);
        float* xp = p.out + (size_t)m * 1024 + n;
        const float* xs = xp;
        if (l == 0 && goff == 2048) xs = (m < NCTX ? p.x_prompt + (size_t)m * 1024 : p.x_sample + (size_t)(m - NCTX) * 1024) + n;
        f32x4 xv = *(const f32x4*)xs;
        xv += gt * v;
        *(f32x4*)xp = xv;
      } else if (EPI == E_SWIGLU) {
        if ((ni & 1) == 0) {
          const f32x4 u = acc[mi][ni + 1];
          u32x2 o = {pack2(siluf(v[0]) * u[0], siluf(v[1]) * u[1]), pack2(siluf(v[2]) * u[2], siluf(v[3]) * u[3])};
          *(u32x2*)(p.act + (size_t)m * DFF + ((nb + ni * 16) >> 1) + fq * 4) = o;
        }
      }
    }
  }
}

#define GEMM_STAGE(buf, Ap, Wp, kt) do {                                                                                  \
    _Pragma("unroll") for (int i = 0; i < GLA; ++i)                                                                       \
      __builtin_amdgcn_global_load_lds((const unsigned*)((Ap) + (size_t)sR[i] * K + (kt) * 64 + sC[i]),                    \
                                       (LAS unsigned*)(ls + (buf) * STAGE_B + wid * 1024 + i * 8192), 16, 0, 0);         \
    _Pragma("unroll") for (int i = 0; i < 4; ++i)                                                                         \
      __builtin_amdgcn_global_load_lds((const unsigned*)((Wp) + (size_t)sR[i] * K + (kt) * 64 + sC[i]),                    \
                                       (LAS unsigned*)(ls + (buf) * STAGE_B + TILE_A + wid * 1024 + i * 8192), 16, 0, 0); \
  } while (0)

template <int EPI, int BM>
DI void gemm_phase(CP& p, int l, const u16* __restrict__ A, const u16* __restrict__ W, int K, int nM, int nN, int goff,
                   int t0, int tstride, int ntiles, bool raster, char* smem) {
  const int tid = opaque_tid(), lane = tid & 63, wid = tid >> 6;
  const int wr = wid >> 2, wc = wid & 3, fr = lane & 15, fq = lane >> 4;
  constexpr int MT = BM / 32, GLA = BM / 64;
  constexpr int TILE_A = BM * 128, TILE_B = 256 * 128, STAGE_B = TILE_A + TILE_B;
  LAS char* ls = (LAS char*)smem;
  int sR[4], sC[4];
#pragma unroll
  for (int i = 0; i < 4; ++i) stage_rc(wid * 1024 + i * 8192 + lane * 16, sR[i], sC[i]);
  int t = t0;
  if (t >= ntiles) return;
  int pm, pn;
  if (raster) tile_rc(t, nM, nN, pm, pn); else { pn = t / nM; pm = t - pn * nM; }
  const u16* Ab = A + (size_t)pm * BM * K;
  const u16* Wb = W + (size_t)pn * 256 * K;
  const int nt = K >> 6;
  const int obf = fr * 64 + fq * 16, swzf = obf ^ (((obf >> 9) & 1) << 5);
  const char* fragA = smem + wr * (BM / 32) * 2048 + swzf;
  const char* fragB = smem + TILE_A + wc * 4 * 2048 + swzf;
  __syncthreads();
  GEMM_STAGE(0, Ab, Wb, 0);
  asm volatile("s_waitcnt vmcnt(0)" ::: "memory");
  __syncthreads();
  for (;;) {
    const int tn = t + tstride;
    const bool has_next = tn < ntiles;
    int pmn = 0, pnn = 0;
    if (has_next) { if (raster) tile_rc(tn, nM, nN, pmn, pnn); else { pnn = tn / nM; pmn = tn - pnn * nM; } }
    const u16* Abn = A + (size_t)pmn * BM * K;
    const u16* Wbn = W + (size_t)pnn * 256 * K;
    f32x4 acc[MT][4];
#pragma unroll
    for (int m = 0; m < MT; ++m)
#pragma unroll
      for (int n = 0; n < 4; ++n) acc[m][n] = (f32x4){0.f, 0.f, 0.f, 0.f};
    for (int kt = 0; kt < nt; ++kt) {
      const int cur = kt & 1;
      if (kt + 1 < nt) GEMM_STAGE(cur ^ 1, Ab, Wb, kt + 1);
      else if (has_next) GEMM_STAGE(cur ^ 1, Abn, Wbn, 0);
      const char* sa = fragA + cur * STAGE_B;
      const char* sb = fragB + cur * STAGE_B;
#pragma unroll
      for (int ks = 0; ks < 2; ++ks) {
        bf16x8 At[MT], Bf[4];
#pragma unroll
        for (int m = 0; m < MT; ++m) At[m] = *(const bf16x8*)(sa + m * 2048 + ks * 1024);
#pragma unroll
        for (int n = 0; n < 4; ++n) Bf[n] = *(const bf16x8*)(sb + n * 2048 + ks * 1024);
        __builtin_amdgcn_s_setprio(1);
#pragma unroll
        for (int m = 0; m < MT; ++m)
#pragma unroll
          for (int n = 0; n < 4; ++n) acc[m][n] = MFMA(Bf[n], At[m], acc[m][n]);
        __builtin_amdgcn_s_setprio(0);
        __builtin_amdgcn_sched_barrier(0);
      }
      if (kt + 1 < nt) {
        asm volatile("s_waitcnt vmcnt(0)" ::: "memory");
        __syncthreads();
      }
    }
    gemm_epilogue<EPI, MT>(p, l, acc, pm * BM + wr * (BM / 2), pn * 256 + wc * 64, goff, fr, fq);
    asm volatile("s_waitcnt vmcnt(0)" ::: "memory");
    __syncthreads();
    if (!has_next) break;
    t = tn; pm = pmn; pn = pnn; Ab = Abn; Wb = Wbn;
  }
}
#undef GEMM_STAGE

DI void conv_wtile(const float* __restrict__ src, int K, int N, u16* __restrict__ dst, int rowmul, int rowoff, int kt,
                   int nt, LAS float* wt, int lane) {
  const int k0 = kt * 32, n0 = nt * 64;
  float v[32];
  const bool ok = n0 + lane < N;
  const float* sp = src + (size_t)k0 * N + n0 + lane;
#pragma unroll
  for (int i = 0; i < 32; ++i) v[i] = ok ? sp[(size_t)i * N] : 0.f;
#pragma unroll
  for (int i = 0; i < 32; ++i) wt[i * 65 + lane] = v[i];
#pragma unroll
  for (int i = 0; i < 16; ++i) {
    const int n = i * 4 + (lane >> 4), kp = lane & 15;
    const float lo = wt[(2 * kp) * 65 + n], hi = wt[(2 * kp + 1) * 65 + n];
    const int nn = n0 + n;
    const int drow = rowmul == 1 ? nn : ((nn >> 4) << 5) + (nn & 15) + 16 * rowoff;
    *(unsigned*)(dst + (size_t)drow * K + k0 + 2 * kp) = pack2(lo, hi);
  }
}

DI void conv_dispatch(CP& p, int l, int r, LAS float* wt, int lane) {
  if (r < 896) {
    conv_wtile(p.w_in + (size_t)l * 1024 * INW, 1024, INW, p.wt_in + (size_t)l * INWP * 1024, 1, 0, r & 31, r >> 5, wt, lane);
  } else if ((r -= 896) < 96) {
    conv_wtile(p.w_uq + (size_t)l * 256 * 768, 256, 768, p.wt_uq + (size_t)l * 768 * 256, 1, 0, r & 7, r >> 3, wt, lane);
  } else if ((r -= 96) < 64) {
    conv_wtile(p.w_ukv + (size_t)l * 128 * 1024, 128, 1024, p.wt_ukv + (size_t)l * 1024 * 128, 1, 0, r & 3, r >> 2, wt, lane);
  } else if ((r -= 64) < 512) {
    conv_wtile(p.w_out + (size_t)l * 1024 * 1024, 1024, 1024, p.wt_out + (size_t)l * 1024 * 1024, 1, 0, r & 31, r >> 5, wt, lane);
  } else if ((r -= 512) < 1408) {
    conv_wtile(p.w_gate + (size_t)l * 1024 * DFF, 1024, DFF, p.wt_gu + (size_t)l * 2 * DFF * 1024, 2, 0, r & 31, r >> 5, wt, lane);
  } else if ((r -= 1408) < 1408) {
    conv_wtile(p.w_up + (size_t)l * 1024 * DFF, 1024, DFF, p.wt_gu + (size_t)l * 2 * DFF * 1024, 2, 1, r & 31, r >> 5, wt, lane);
  } else {
    r -= 1408;
    conv_wtile(p.w_down + (size_t)l * DFF * 1024, DFF, 1024, p.wt_down + (size_t)l * 1024 * DFF, 1, 0, r % 88, r / 88, wt, lane);
  }
}

DI void conv_fill(CP& p, int l, int r_lo, int r_hi, unsigned* ctr, int* slot, char* smem) {
  const int tid = opaque_tid(), lane = tid & 63, wave = tid >> 6;
  LAS float* wt = (LAS float*)smem + wave * (32 * 65);
  const int nitems = (r_hi - r_lo + 7) >> 3;
  for (;;) {
    __syncthreads();
    if (tid == 0) *slot = (int)atomicAdd(ctr, 1u);
    __syncthreads();
    const int it = *slot;
    if (it >= nitems) break;
    const int r = r_lo + it * 8 + wave;
    if (r < r_hi) conv_dispatch(p, l, r, wt, lane);
  }
}

DI void phase0(CP& p, char* smem) {
  const int tid = opaque_tid();
  const int G = gridDim.x, bid = blockIdx.x;
  {
    const int lane = tid & 63, wave = tid >> 6;
    LAS float* wt = (LAS float*)smem + wave * (32 * 65);
    __syncthreads();
    for (int idx = bid * 8 + wave; idx < 5792; idx += G * 8) conv_dispatch(p, 0, idx, wt, lane);
  }
  {
    float* scond = (float*)(smem + 32768);
    float* red = scond + 5120;
    __syncthreads();
    for (int i = tid; i < 5120; i += NTHREADS) {
      const int v = i >> 10, k = i & 1023;
      const float x = v == 0 ? p.c_ctx[k] : p.c[(v - 1) * 1024 + k];
      scond[i] = siluf(x);
    }
    __syncthreads();
    for (int job = bid; job < 384; job += G) {
      const int l = job / 96, chunk = job - l * 96;
      const int c = tid & 63, kg = tid >> 6, col = chunk * 64 + c;
      float a0 = 0.f, a1 = 0.f, a2 = 0.f, a3 = 0.f, a4 = 0.f;
      const float* w = p.w_ada + ((size_t)l * 1024 + kg * 128) * 6144 + col;
      const float* sc = scond + kg * 128;
#pragma unroll 32
      for (int k = 0; k < 128; ++k) {
        const float wv = w[(size_t)k * 6144];
        a0 += sc[k] * wv; a1 += sc[1024 + k] * wv; a2 += sc[2048 + k] * wv; a3 += sc[3072 + k] * wv; a4 += sc[4096 + k] * wv;
      }
      red[(kg * 5 + 0) * 64 + c] = a0; red[(kg * 5 + 1) * 64 + c] = a1; red[(kg * 5 + 2) * 64 + c] = a2;
      red[(kg * 5 + 3) * 64 + c] = a3; red[(kg * 5 + 4) * 64 + c] = a4;
      __syncthreads();
      if (kg == 0) {
        const float bb = p.b_ada[l * 6144 + col];
#pragma unroll
        for (int v = 0; v < 5; ++v) {
          float s = 0.f;
#pragma unroll
          for (int q = 0; q < 8; ++q) s += red[(q * 5 + v) * 64 + c];
          p.mod[(size_t)(l * 5 + v) * 6144 + col] = s + bb;
        }
      }
      __syncthreads();
    }
  }
  for (int i = bid * NTHREADS + tid; i < 2048 * 16; i += G * NTHREADS) {
    const int t = i >> 4, a = (i >> 3) & 1, f = i & 7;
    const float pos = a == 0 ? (float)(t >> 6) : (float)(t & 63);
    const float inv = powf(10000.0f, -(float)f / 8.0f);
    const float ang = pos * inv;
    p.ropec[i] = cosf(ang);
    p.ropes[i] = sinf(ang);
  }
}

DI void norm_phase(CP& p, int l, int which) {
  const int tid = opaque_tid(), lane = tid & 63, wave = tid >> 6;
  const float* gw = (which == 0 ? p.g_mix : p.g_ffn) + l * 1024;
  const int shoff = which == 0 ? 0 : 3072, scoff = shoff + 1024;
  f32x4 gg[4];
#pragma unroll
  for (int i = 0; i < 4; ++i) gg[i] = *(const f32x4*)(gw + i * 256 + lane * 4);
  const int stride = gridDim.x * 8;
  for (int tok0 = blockIdx.x * 8 + wave; tok0 < NTOK; tok0 += 2 * stride) {
    f32x4 v[2][4], sc[2][4], sh[2][4];
    bool ok[2];
#pragma unroll
    for (int a = 0; a < 2; ++a) {
      const int tok = tok0 + a * stride;
      ok[a] = tok < NTOK;
      const int tk = ok[a] ? tok : tok0;
      const float* xr = p.out + (size_t)tk * 1024;
      if (l == 0 && which == 0) xr = tk < NCTX ? p.x_prompt + (size_t)tk * 1024 : p.x_sample + (size_t)(tk - NCTX) * 1024;
      const int vs = tk < NCTX ? 0 : 1 + ((tk - NCTX) >> 11);
      const float* md = p.mod + (size_t)(l * 5 + vs) * 6144;
#pragma unroll
      for (int i = 0; i < 4; ++i) {
        const int col = i * 256 + lane * 4;
        v[a][i] = *(const f32x4*)(xr + col);
        sc[a][i] = *(const f32x4*)(md + scoff + col);
        sh[a][i] = *(const f32x4*)(md + shoff + col);
      }
    }
#pragma unroll
    for (int a = 0; a < 2; ++a) {
      const int tok = tok0 + a * stride;
      float ss = 0.f;
#pragma unroll
      for (int i = 0; i < 4; ++i) ss += v[a][i][0] * v[a][i][0] + v[a][i][1] * v[a][i][1] + v[a][i][2] * v[a][i][2] + v[a][i][3] * v[a][i][3];
      ss = wave_sum(ss);
      const float rstd = rsqrtf(ss * (1.f / 1024.f) + 1e-6f);
      if (ok[a]) {
#pragma unroll
        for (int i = 0; i < 4; ++i) {
          const int col = i * 256 + lane * 4;
          f32x4 o;
#pragma unroll
          for (int j = 0; j < 4; ++j) o[j] = v[a][i][j] * rstd * gg[i][j] * (1.f + sc[a][i][j]) + sh[a][i][j];
          u32x2 pk = {pack2(o[0], o[1]), pack2(o[2], o[3])};
          *(u32x2*)(p.hb + (size_t)tok * 1024 + col) = pk;
        }
      }
    }
  }
}

DI void final_norm(CP& p) {
  const int tid = opaque_tid(), lane = tid & 63, wave = tid >> 6;
  f32x4 gg[4];
#pragma unroll
  for (int i = 0; i < 4; ++i) gg[i] = *(const f32x4*)(p.g_final + i * 256 + lane * 4);
  const int stride = gridDim.x * 8;
  for (int tok0 = blockIdx.x * 8 + wave; tok0 < NTOK; tok0 += 2 * stride) {
    f32x4 v[2][4];
    bool ok[2];
#pragma unroll
    for (int a = 0; a < 2; ++a) {
      const int tok = tok0 + a * stride;
      ok[a] = tok < NTOK;
      const float* xr = p.out + (size_t)(ok[a] ? tok : tok0) * 1024;
#pragma unroll
      for (int i = 0; i < 4; ++i) v[a][i] = *(const f32x4*)(xr + i * 256 + lane * 4);
    }
#pragma unroll
    for (int a = 0; a < 2; ++a) {
      const int tok = tok0 + a * stride;
      float ss = 0.f;
#pragma unroll
      for (int i = 0; i < 4; ++i) ss += v[a][i][0] * v[a][i][0] + v[a][i][1] * v[a][i][1] + v[a][i][2] * v[a][i][2] + v[a][i][3] * v[a][i][3];
      ss = wave_sum(ss);
      const float rstd = rsqrtf(ss * (1.f / 1024.f) + 1e-6f);
      if (ok[a]) {
        float* xr = p.out + (size_t)tok * 1024;
#pragma unroll
        for (int i = 0; i < 4; ++i) {
          f32x4 o;
#pragma unroll
          for (int j = 0; j < 4; ++j) o[j] = v[a][i][j] * rstd * gg[i][j];
          *(f32x4*)(xr + i * 256 + lane * 4) = o;
        }
      }
    }
  }
}

DI void prep_cache_row(CP& p, int l, int row) {
  const int lane = opaque_tid() & 63;
  {
    const int r = row - NTOK, b = r >> 8, j = r & 255;
    const int kvrow = NCTX + b * 2304 + j;
    const float* ck = p.cache_ckv + ((size_t)(b * 4 + l) * 256 + j) * 128;
    const f2_t v = *(const f2_t*)(ck + lane * 2);
    *(unsigned*)(p.ckvn + (size_t)kvrow * 128 + lane * 2) = pack2(v[0], v[1]);
    if (lane < 16) {
      const float* kr = p.cache_krope + ((size_t)(b * 4 + l) * 256 + j) * 32;
      const f2_t w = *(const f2_t*)(kr + lane * 2);
      *(unsigned*)(p.krope + (size_t)kvrow * 32 + lane * 2) = pack2(w[0], w[1]);
    }
  }
}

constexpr int PSTR = 1192;
struct PrepW { f32x4 gq; f2_t gkv; float cw[8][5]; float cb[8]; float dtb; };
DI void prep_load_w(CP& p, int l, int lane, PrepW& w) {
  w.gq = *(const f32x4*)(p.g_q + l * 256 + lane * 4);
  w.gkv = *(const f2_t*)(p.g_kv + l * 128 + lane * 2);
  const float* cw = p.ssd_conv_w + (size_t)l * 5 * 512;
  const float* cb = p.ssd_conv_b + l * 512;
#pragma unroll
  for (int i = 0; i < 8; ++i) {
    w.cb[i] = cb[i * 64 + lane];
#pragma unroll
    for (int j = 0; j < 5; ++j) w.cw[i][j] = cw[j * 512 + i * 64 + lane];
  }
  w.dtb = p.ssd_dt_bias[l * 8 + (lane & 7)];
}
DI void prep_row(CP& p, int l, int tok, const LAS float* cr, const PrepW& w, int lane) {
  int b, t, T, kvrow;
  const bool lat = tok >= NCTX;
  if (!lat) { b = tok >> 8; t = tok & 255; T = 256; kvrow = tok; }
  else { const int q = tok - NCTX; b = q >> 11; t = q & 2047; T = 2048; kvrow = NCTX + b * 2304 + 256 + t; }
  {
    const f32x4 v = *(const LAS f32x4*)(cr + lane * 4);
    float ss = v[0] * v[0] + v[1] * v[1] + v[2] * v[2] + v[3] * v[3];
    ss = wave_sum(ss);
    const float rstd = rsqrtf(ss * (1.f / 256.f) + 1e-6f);
    const f32x4 gg = w.gq;
    u32x2 pk = {pack2(v[0] * rstd * gg[0], v[1] * rstd * gg[1]), pack2(v[2] * rstd * gg[2], v[3] * rstd * gg[3])};
    *(u32x2*)(p.qn + (size_t)tok * 256 + lane * 4) = pk;
  }
  {
    const f2_t v = *(const LAS f2_t*)(cr + 256 + lane * 2);
    float ss = v[0] * v[0] + v[1] * v[1];
    ss = wave_sum(ss);
    const float rstd = rsqrtf(ss * (1.f / 128.f) + 1e-6f);
    const f2_t gg = w.gkv;
    const float o0 = v[0] * rstd * gg[0], o1 = v[1] * rstd * gg[1];
    *(unsigned*)(p.ckvn + (size_t)kvrow * 128 + lane * 2) = pack2(o0, o1);
    if (!lat) {
      f2_t o = {o0, o1};
      *(f2_t*)(p.out + O_CKV + ((size_t)(b * 4 + l) * 256 + t) * 128 + lane * 2) = o;
    }
  }
  if (lane < 16) {
    const int a = lane >> 3, f = lane & 7;
    const float x1 = cr[384 + a * 16 + f], x2 = cr[384 + a * 16 + 8 + f];
    float o1 = x1, o2 = x2;
    if (!lat) {
      float* dst = p.out + O_KR + ((size_t)(b * 4 + l) * 256 + t) * 32;
      dst[a * 16 + f] = x1;
      dst[a * 16 + 8 + f] = x2;
    } else {
      const float c = p.ropec[t * 16 + a * 8 + f], s = p.ropes[t * 16 + a * 8 + f];
      o1 = x1 * c - x2 * s;
      o2 = x2 * c + x1 * s;
    }
    p.krope[(size_t)kvrow * 32 + a * 16 + f] = f2bf(o1);
    p.krope[(size_t)kvrow * 32 + a * 16 + 8 + f] = f2bf(o2);
  }
  {
#pragma unroll
    for (int i = 0; i < 8; ++i) {
      const int c = i * 64 + lane;
      float acc = w.cb[i];
#pragma unroll
      for (int j = 0; j < 5; ++j) {
        acc += w.cw[i][j] * cr[(j - 2) * PSTR + 672 + c];
      }
      p.xbc[(size_t)tok * 512 + c] = siluf(acc);
    }
  }
  if (lane < 8) {
    const float x = cr[1184 + lane] + w.dtb;
    const float sp = x > 20.f ? x : log1pf(expf(x));
    p.dtb[(size_t)tok * 8 + lane] = sp;
  }
}

DI void prep_tile(CP& p, int l, int ti, char* smem) {
  const int tid = opaque_tid(), wave = tid >> 6;
  int base, t0, T;
  if (ti < 256) { base = (ti >> 4) * 256; t0 = (ti & 15) * 16; T = 256; }
  else { const int j = ti - 256; base = NCTX + (j >> 7) * 2048; t0 = (j & 127) * 16; T = 2048; }
  LAS float* sr = (LAS float*)smem;
  const int lane = tid & 63;
  PrepW pw;
  prep_load_w(p, l, lane, pw);
  __syncthreads();
  u32x4 stg[6];
#pragma unroll
  for (int i = 0; i < 6; ++i) {
    const int idx = tid + i * 512;
    const int row = idx / 149, c8 = idx - row * 149;
    const int t = t0 - 2 + row;
    stg[i] = (u32x4){0u, 0u, 0u, 0u};
    if (idx < 2980 && t >= 0 && t < T) stg[i] = *(const u32x4*)(p.comb + (size_t)(base + t) * INW + c8 * 8);
  }
#pragma unroll
  for (int i = 0; i < 6; ++i) {
    const int idx = tid + i * 512;
    const int row = idx / 149, c8 = idx - row * 149;
    if (idx < 2980) {
      f32x4 lo, hi;
      lo[0] = __uint_as_float(stg[i][0] << 16); lo[1] = __uint_as_float(stg[i][0] & 0xffff0000u);
      lo[2] = __uint_as_float(stg[i][1] << 16); lo[3] = __uint_as_float(stg[i][1] & 0xffff0000u);
      hi[0] = __uint_as_float(stg[i][2] << 16); hi[1] = __uint_as_float(stg[i][2] & 0xffff0000u);
      hi[2] = __uint_as_float(stg[i][3] << 16); hi[3] = __uint_as_float(stg[i][3] & 0xffff0000u);
      *(LAS f32x4*)(sr + row * PSTR + c8 * 8) = lo;
      *(LAS f32x4*)(sr + row * PSTR + c8 * 8 + 4) = hi;
    }
  }
  __syncthreads();
#pragma unroll
  for (int i = 0; i < 2; ++i) {
    const int tt = wave * 2 + i;
    prep_row(p, l, base + t0 + tt, sr + (tt + 2) * PSTR, pw, lane);
  }
}

DI void cm_tile(CP& p, int l, int ti, char* smem) {
  const int tid = opaque_tid(), lane = tid & 63, wave = tid >> 6;
  int base, t0, T;
  if (ti < 128) { base = (ti >> 3) * 256; t0 = (ti & 7) * 32; T = 256; }
  else { const int j = ti - 128; base = NCTX + (j >> 6) * 2048; t0 = (j & 63) * 32; T = 2048; }
  LAS float* sg = (LAS float*)smem;
  LAS float* so = sg + 62 * 256;
  const int c = tid & 255, half = tid >> 8;
  float w[31];
#pragma unroll
  for (int j = 0; j < 31; ++j) w[j] = p.cm_conv_w[(size_t)(l * 31 + j) * 256 + c];
  const float bias = p.cm_conv_b[l * 256 + c];
  __syncthreads();
  {
    u32x4 ra[4], rb[4];
#pragma unroll
    for (int i = 0; i < 4; ++i) {
      const int idx = tid + i * 512;
      const int r = idx >> 5, c8 = idx & 31;
      const int t = t0 - 15 + r;
      ra[i] = (u32x4){0u, 0u, 0u, 0u}; rb[i] = (u32x4){0u, 0u, 0u, 0u};
      if (idx < 62 * 32 && t >= 0 && t < T) {
        const u16* cr = p.comb + (size_t)(base + t) * INW;
        ra[i] = *(const u32x4*)(cr + 1192 + c8 * 8);
        rb[i] = *(const u32x4*)(cr + 1448 + c8 * 8);
      }
    }
#pragma unroll
    for (int i = 0; i < 4; ++i) {
      const int idx = tid + i * 512;
      const int r = idx >> 5, c8 = idx & 31;
      if (idx < 62 * 32) {
        f32x4 lo, hi;
#pragma unroll
        for (int q = 0; q < 2; ++q) {
          lo[2 * q] = __uint_as_float(ra[i][q] << 16) * sigmoidf(__uint_as_float(rb[i][q] << 16));
          lo[2 * q + 1] = __uint_as_float(ra[i][q] & 0xffff0000u) * sigmoidf(__uint_as_float(rb[i][q] & 0xffff0000u));
          hi[2 * q] = __uint_as_float(ra[i][q + 2] << 16) * sigmoidf(__uint_as_float(rb[i][q + 2] << 16));
          hi[2 * q + 1] = __uint_as_float(ra[i][q + 2] & 0xffff0000u) * sigmoidf(__uint_as_float(rb[i][q + 2] & 0xffff0000u));
        }
        *(LAS f32x4*)(sg + r * 256 + c8 * 8) = lo;
        *(LAS f32x4*)(sg + r * 256 + c8 * 8 + 4) = hi;
      }
    }
  }
  __syncthreads();
#pragma unroll 1
  for (int t4 = 0; t4 < 4; ++t4) {
    const int tb = half * 16 + t4 * 4;
    float a0 = bias, a1 = bias, a2 = bias, a3 = bias;
#pragma unroll
    for (int j = 0; j < 34; ++j) {
      const float x = sg[(tb + j) * 256 + c];
      if (j < 31) a0 += w[j] * x;
      if (j >= 1 && j < 32) a1 += w[j - 1] * x;
      if (j >= 2 && j < 33) a2 += w[j - 2] * x;
      if (j >= 3) a3 += w[j - 3] * x;
    }
    so[tb * 256 + c] = a0;
    so[(tb + 1) * 256 + c] = a1;
    so[(tb + 2) * 256 + c] = a2;
    so[(tb + 3) * 256 + c] = a3;
  }
  __syncthreads();
  {
    float lg[4], lb[4];
#pragma unroll
    for (int i = 0; i < 4; ++i) { lg[i] = p.cm_ln_g[l * 256 + lane + 64 * i]; lb[i] = p.cm_ln_b[l * 256 + lane + 64 * i]; }
#pragma unroll
    for (int tt = 0; tt < 4; ++tt) {
      const int t = wave * 4 + tt;
      float v[4];
      float sm = 0.f;
#pragma unroll
      for (int i = 0; i < 4; ++i) { v[i] = so[t * 256 + lane + 64 * i]; sm += v[i]; }
      const float mean = wave_sum(sm) * (1.f / 256.f);
      float q = 0.f;
#pragma unroll
      for (int i = 0; i < 4; ++i) { const float d = v[i] - mean; q += d * d; }
      const float var = wave_sum(q) * (1.f / 256.f);
      const float rstd = rsqrtf(var + 1e-5f);
#pragma unroll
      for (int i = 0; i < 4; ++i) {
        const int cc = lane + 64 * i;
        float y = (v[i] - mean) * rstd * lg[i] + lb[i];
        y = siluf(y);
        p.hb[(size_t)(base + t0 + t) * 1024 + 768 + cc] = f2bf(y);
      }
    }
  }
}

DI void ssd_item(CP& p, int l, int seq, int h, int dir, char* smem) {
  const int tid = opaque_tid(), lane = tid & 63, wave = tid >> 6, lr = lane & 15, g = lane >> 4;
  const int rt = wave & 3, ch = wave >> 2;
  const bool lat = seq >= 16;
  const int b = lat ? seq - 16 : seq;
  const int T = lat ? 2048 : 256;
  const int qbase = lat ? NCTX + b * 2048 : b * 256;
  u16* sC = (u16*)smem;
  u16* sB = sC + 64 * 72;
  u16* sBt = sB + 64 * 72;
  u16* sXt = sBt + 64 * 72;
  u16* sXw = sXt + 64 * 72;
  u16* sM = sXw + 64 * 72;
  u16* sH = sM + 64 * 72;
  float* sdtA = (float*)(sH + 64 * 72);
  float* sacsA = sdtA + 2048;
  float* swA = sacsA + 2048;
  const float Aneg = -expf(p.ssd_a_log[(l * 2 + dir) * 4 + h]);
  const int grp = h >> 1;
  f32x4 hacc[2];
  if (lat) {
    const float* src = p.state_ssd + ((size_t)(((b * 4 + l) * 2 + dir) * 4 + h)) * 4096;
#pragma unroll
    for (int n2 = 0; n2 < 2; ++n2) hacc[n2] = *(const f32x4*)(src + (rt * 16 + lr) * 64 + (ch * 2 + n2) * 16 + g * 4);
  } else {
#pragma unroll
    for (int n2 = 0; n2 < 2; ++n2) hacc[n2] = (f32x4){0.f, 0.f, 0.f, 0.f};
  }
  __syncthreads();
#pragma unroll
  for (int n2 = 0; n2 < 2; ++n2) {
    u32x2 pk = {pack2(hacc[n2][0], hacc[n2][1]), pack2(hacc[n2][2], hacc[n2][3])};
    *(u32x2*)(sH + (rt * 16 + lr) * 72 + (ch * 2 + n2) * 16 + g * 4) = pk;
  }
  const int nch = T >> 6;
  {
    float dv[4];
#pragma unroll
    for (int i = 0; i < 4; ++i) {
      const int cq = wave + 8 * i;
      dv[i] = cq < nch ? p.dtb[(size_t)(qbase + cq * 64 + lane) * 8 + dir * 4 + h] : 0.f;
    }
#pragma unroll
    for (int i = 0; i < 4; ++i) {
      const int cq = wave + 8 * i;
      float sc = dv[i] * Aneg;
      if (!dir) {
#pragma unroll
        for (int o = 1; o < 64; o <<= 1) { const float tv = __shfl_up(sc, o); if (lane >= o) sc += tv; }
      } else {
#pragma unroll
        for (int o = 1; o < 64; o <<= 1) { const float tv = __shfl_down(sc, o); if (lane + o < 64) sc += tv; }
      }
      const float tot = __shfl(sc, dir ? 0 : 63);
      if (cq < nch) { sdtA[cq * 64 + lane] = dv[i]; sacsA[cq * 64 + lane] = sc; swA[cq * 64 + lane] = __expf(tot - sc) * dv[i]; }
    }
  }
  const int e = lane;
  const int r = tid >> 3, cc = (tid & 7) * 8;
  float xs[8], bs[8];
  f32x4 cv[2], bv[2];
  {
    const int c0 = dir ? nch - 1 : 0;
    const float* rowp = p.xbc + (size_t)(qbase + c0 * 64 + wave * 8) * 512;
#pragma unroll
    for (int i = 0; i < 8; ++i) {
      xs[i] = rowp[i * 512 + h * 64 + e];
      bs[i] = rowp[i * 512 + 256 + grp * 64 + e];
    }
    const float* rowq = p.xbc + (size_t)(qbase + c0 * 64 + r) * 512;
#pragma unroll
    for (int i = 0; i < 2; ++i) {
      bv[i] = *(const f32x4*)(rowq + 256 + grp * 64 + cc + i * 4);
      cv[i] = *(const f32x4*)(rowq + 384 + grp * 64 + cc + i * 4);
    }
  }
  __syncthreads();
#pragma unroll 1
  for (int ci = 0; ci < nch; ++ci) {
    const int c = dir ? nch - 1 - ci : ci;
    const int tok0 = qbase + c * 64;
    const float* sdt = sdtA + c * 64;
    const float* sacs = sacsA + c * 64;
    const float total = dir ? sacs[0] : sacs[63];
    {
      const f32x4 w0 = *(const f32x4*)(swA + c * 64 + wave * 8), w1 = *(const f32x4*)(swA + c * 64 + wave * 8 + 4);
      u32x4 c0 = {pack2(cv[0][0], cv[0][1]), pack2(cv[0][2], cv[0][3]), pack2(cv[1][0], cv[1][1]), pack2(cv[1][2], cv[1][3])};
      *(u32x4*)(sC + r * 72 + cc) = c0;
      u32x4 b0 = {pack2(bv[0][0], bv[0][1]), pack2(bv[0][2], bv[0][3]), pack2(bv[1][0], bv[1][1]), pack2(bv[1][2], bv[1][3])};
      *(u32x4*)(sB + r * 72 + cc) = b0;
      u32x4 tb = {pack2(bs[0], bs[1]), pack2(bs[2], bs[3]), pack2(bs[4], bs[5]), pack2(bs[6], bs[7])};
      u32x4 tx = {pack2(xs[0], xs[1]), pack2(xs[2], xs[3]), pack2(xs[4], xs[5]), pack2(xs[6], xs[7])};
      u32x4 tw = {pack2(xs[0] * w0[0], xs[1] * w0[1]), pack2(xs[2] * w0[2], xs[3] * w0[3]),
                  pack2(xs[4] * w1[0], xs[5] * w1[1]), pack2(xs[6] * w1[2], xs[7] * w1[3])};
      *(u32x4*)(sBt + e * 72 + wave * 8) = tb;
      *(u32x4*)(sXt + e * 72 + wave * 8) = tx;
      *(u32x4*)(sXw + e * 72 + wave * 8) = tw;
    }
    if (ci + 1 < nch) {
      const int cn = dir ? nch - 2 - ci : ci + 1;
      const float* rowp = p.xbc + (size_t)(qbase + cn * 64 + wave * 8) * 512;
#pragma unroll
      for (int i = 0; i < 8; ++i) {
        xs[i] = rowp[i * 512 + h * 64 + e];
        bs[i] = rowp[i * 512 + 256 + grp * 64 + e];
      }
      const float* rowq = p.xbc + (size_t)(qbase + cn * 64 + r) * 512;
#pragma unroll
      for (int i = 0; i < 2; ++i) {
        bv[i] = *(const f32x4*)(rowq + 256 + grp * 64 + cc + i * 4);
        cv[i] = *(const f32x4*)(rowq + 384 + grp * 64 + cc + i * 4);
      }
    }
    __syncthreads();
    f32x4 gacc[2];
#pragma unroll
    for (int s2 = 0; s2 < 2; ++s2) gacc[s2] = (f32x4){0.f, 0.f, 0.f, 0.f};
#pragma unroll
    for (int ks = 0; ks < 2; ++ks) {
      const bf16x8 cf = *(const bf16x8*)(sC + (rt * 16 + lr) * 72 + ks * 32 + g * 8);
#pragma unroll
      for (int s2 = 0; s2 < 2; ++s2) {
        const bf16x8 bfr = *(const bf16x8*)(sB + ((ch * 2 + s2) * 16 + lr) * 72 + ks * 32 + g * 8);
        gacc[s2] = MFMA(bfr, cf, gacc[s2]);
      }
    }
    int opq;
    asm volatile("v_mov_b32 %0, 0" : "=v"(opq));
    const int li = rt * 16 + lr + opq;
    const float acs_l = sacs[li];
#pragma unroll
    for (int s2 = 0; s2 < 2; ++s2) {
      const int sb0 = (ch * 2 + s2) * 16 + g * 4;
      const f32x4 acs_s = *(const f32x4*)(sacs + sb0);
      const f32x4 dt_s = *(const f32x4*)(sdt + sb0);
      float mv[4];
#pragma unroll
      for (int i = 0; i < 4; ++i) {
        const int si = sb0 + i;
        const bool ok = dir ? (si >= li) : (si <= li);
        mv[i] = ok ? gacc[s2][i] * __expf(acs_l - acs_s[i]) * dt_s[i] : 0.f;
      }
      u32x2 pk = {pack2(mv[0], mv[1]), pack2(mv[2], mv[3])};
      *(u32x2*)(sM + li * 72 + sb0) = pk;
    }
    __syncthreads();
    f32x4 yd[2], yo[2];
#pragma unroll
    for (int p2 = 0; p2 < 2; ++p2) { yd[p2] = (f32x4){0.f, 0.f, 0.f, 0.f}; yo[p2] = (f32x4){0.f, 0.f, 0.f, 0.f}; }
#pragma unroll
    for (int ks = 0; ks < 2; ++ks) {
      const bf16x8 mf = *(const bf16x8*)(sM + (rt * 16 + lr) * 72 + ks * 32 + g * 8);
      const bf16x8 cf = *(const bf16x8*)(sC + (rt * 16 + lr) * 72 + ks * 32 + g * 8);
#pragma unroll
      for (int p2 = 0; p2 < 2; ++p2) {
        const bf16x8 xf = *(const bf16x8*)(sXt + ((ch * 2 + p2) * 16 + lr) * 72 + ks * 32 + g * 8);
        const bf16x8 hf = *(const bf16x8*)(sH + ((ch * 2 + p2) * 16 + lr) * 72 + ks * 32 + g * 8);
        yd[p2] = MFMA(xf, mf, yd[p2]);
        yo[p2] = MFMA(hf, cf, yo[p2]);
      }
    }
    {
      const float e = __expf(acs_l);
      float* yrow = p.ydir + ((size_t)dir * NTOK + tok0 + rt * 16 + lr) * 256 + h * 64 + ch * 32 + g * 4;
#pragma unroll
      for (int p2 = 0; p2 < 2; ++p2) {
        f32x4 yv;
#pragma unroll
        for (int i = 0; i < 4; ++i) yv[i] = yd[p2][i] + e * yo[p2][i];
        *(f32x4*)(yrow + p2 * 16) = yv;
      }
    }
    f32x4 hn[2];
#pragma unroll
    for (int n2 = 0; n2 < 2; ++n2) hn[n2] = (f32x4){0.f, 0.f, 0.f, 0.f};
#pragma unroll
    for (int ks = 0; ks < 2; ++ks) {
      const bf16x8 xw = *(const bf16x8*)(sXw + (rt * 16 + lr) * 72 + ks * 32 + g * 8);
#pragma unroll
      for (int n2 = 0; n2 < 2; ++n2) {
        const bf16x8 bt = *(const bf16x8*)(sBt + ((ch * 2 + n2) * 16 + lr) * 72 + ks * 32 + g * 8);
        hn[n2] = MFMA(bt, xw, hn[n2]);
      }
    }
    const float et = __expf(total);
#pragma unroll
    for (int n2 = 0; n2 < 2; ++n2) hacc[n2] = hacc[n2] * et + hn[n2];
    __syncthreads();
#pragma unroll
    for (int n2 = 0; n2 < 2; ++n2) {
      u32x2 pk = {pack2(hacc[n2][0], hacc[n2][1]), pack2(hacc[n2][2], hacc[n2][3])};
      *(u32x2*)(sH + (rt * 16 + lr) * 72 + (ch * 2 + n2) * 16 + g * 4) = pk;
    }
  }
  if (!lat) {
    float* dst = p.out + O_SSD + ((size_t)(((b * 4 + l) * 2 + dir) * 4 + h)) * 4096;
#pragma unroll
    for (int n2 = 0; n2 < 2; ++n2) *(f32x4*)(dst + (rt * 16 + lr) * 64 + (ch * 2 + n2) * 16 + g * 4) = hacc[n2];
  }
}

DI void ssd_final_rows4(CP& p, int l, int tok0) {
  const int lane = opaque_tid() & 63;
  const int c = lane * 4, h = c >> 6;
  const float dd = p.ssd_d[(l * 2 + 0) * 4 + h] + p.ssd_d[(l * 2 + 1) * 4 + h];
  const f32x4 gg = *(const f32x4*)(p.ssd_norm_g + l * 256 + c);
  f32x4 y0[4], y1[4], xs[4];
  u32x2 zr[4];
#pragma unroll
  for (int a = 0; a < 4; ++a) {
    const int tok = tok0 + a;
    y0[a] = *(const f32x4*)(p.ydir + (size_t)tok * 256 + c);
    y1[a] = *(const f32x4*)(p.ydir + ((size_t)NTOK + tok) * 256 + c);
    xs[a] = *(const f32x4*)(p.xbc + (size_t)tok * 512 + c);
    zr[a] = *(const u32x2*)(p.comb + (size_t)tok * INW + 416 + c);
  }
#pragma unroll
  for (int a = 0; a < 4; ++a) {
    const int tok = tok0 + a;
    const f32x4 z = {__uint_as_float(zr[a][0] << 16), __uint_as_float(zr[a][0] & 0xffff0000u), __uint_as_float(zr[a][1] << 16),
                     __uint_as_float(zr[a][1] & 0xffff0000u)};
    f32x4 v;
    float ss = 0.f;
#pragma unroll
    for (int j = 0; j < 4; ++j) {
      v[j] = (y0[a][j] + y1[a][j] + dd * xs[a][j]) * siluf(z[j]);
      ss += v[j] * v[j];
    }
    ss = wave_sum(ss);
    const float rstd = rsqrtf(ss * (1.f / 256.f) + 1e-6f);
    u32x2 pk = {pack2(v[0] * rstd * gg[0], v[1] * rstd * gg[1]), pack2(v[2] * rstd * gg[2], v[3] * rstd * gg[3])};
    *(u32x2*)(p.hb + (size_t)tok * 1024 + 512 + c) = pk;
  }
}

DI void attn_item(CP& p, int seq, int h, int qb, char* smem) {
  const int tid = opaque_tid(), lane = tid & 63, wave = tid >> 6, lr = lane & 15, g = lane >> 4;
  const bool lat = seq >= 16;
  int Tk, kvbase, qtok0;
  if (!lat) { Tk = 256; kvbase = seq * 256; qtok0 = seq * 256; }
  else { const int b = seq - 16; Tk = 2304; kvbase = NCTX + b * 2304; qtok0 = NCTX + b * 2048 + qb * 256; }
  LAS u16* sKb = (LAS u16*)smem;
  LAS u16* sVb = sKb + 256 * 104;
  bf16x8 qf[2][3];
#pragma unroll
  for (int qt = 0; qt < 2; ++qt) {
    const int tok = qtok0 + wave * 32 + qt * 16 + lr;
#pragma unroll
    for (int ks = 0; ks < 3; ++ks) qf[qt][ks] = *(const bf16x8*)(p.qbuf + (size_t)tok * 768 + h * 96 + ks * 32 + g * 8);
    if (lat) {
      const int t = (tok - NCTX) & 2047;
      const int axis = g >> 1, half = g & 1;
      const float* cs = p.ropec + t * 16 + axis * 8;
      const float* sn = p.ropes + t * 16 + axis * 8;
      bf16x8 r;
#pragma unroll
      for (int j = 0; j < 8; ++j) {
        const float x = bf2f((u16)qf[qt][2][j]);
        const float pr = __shfl_xor(x, 16);
        const float c = cs[j], s = sn[j];
        const float o = half ? x * c + pr * s : x * c - pr * s;
        r[j] = (short)f2bf(o);
      }
      qf[qt][2] = r;
    }
  }
  f32x4 o[2][4];
#pragma unroll
  for (int qt = 0; qt < 2; ++qt)
#pragma unroll
    for (int dt = 0; dt < 4; ++dt) o[qt][dt] = (f32x4){0.f, 0.f, 0.f, 0.f};
  float mrow[2] = {-1e30f, -1e30f}, lrow[2] = {0.f, 0.f};
  const float cs2 = 0.10206207261596574f * 1.4426950408889634f;
  const int nst = Tk >> 8;
  const u16* gk = p.knope + (size_t)(kvbase + (tid >> 3)) * 512 + h * 64 + (tid & 7) * 8;
  const u16* gr = p.krope + (size_t)(kvbase + (tid >> 2)) * 32 + (tid & 3) * 8;
  const u16* gv = p.vt + (size_t)512 * kvbase + (size_t)(h * 64 + (tid >> 5)) * Tk + (tid & 31) * 8;
  u32x4 rk[4], rr[2], rv[4];
#pragma unroll
  for (int i = 0; i < 4; ++i) { rk[i] = *(const u32x4*)(gk + (size_t)i * 64 * 512); rv[i] = *(const u32x4*)(gv + (size_t)i * 16 * Tk); }
#pragma unroll
  for (int i = 0; i < 2; ++i) rr[i] = *(const u32x4*)(gr + (size_t)i * 128 * 32);
#pragma unroll 1
  for (int st = 0; st < nst; ++st) {
    __syncthreads();
#pragma unroll
    for (int i = 0; i < 4; ++i) {
      *(LAS u32x4*)(sKb + ((tid >> 3) + i * 64) * 104 + (tid & 7) * 8) = rk[i];
      *(LAS u32x4*)(sVb + ((tid >> 5) + i * 16) * 264 + (tid & 31) * 8) = rv[i];
    }
#pragma unroll
    for (int i = 0; i < 2; ++i) *(LAS u32x4*)(sKb + ((tid >> 2) + i * 128) * 104 + 64 + (tid & 3) * 8) = rr[i];
    __syncthreads();
    if (st + 1 < nst) {
      const size_t ko = (size_t)(st + 1) * 256;
#pragma unroll
      for (int i = 0; i < 4; ++i) { rk[i] = *(const u32x4*)(gk + (ko + i * 64) * 512); rv[i] = *(const u32x4*)(gv + (size_t)i * 16 * Tk + ko); }
#pragma unroll
      for (int i = 0; i < 2; ++i) rr[i] = *(const u32x4*)(gr + (ko + i * 128) * 32);
    }
#pragma unroll 1
    for (int kt = 0; kt < 4; ++kt) {
      const LAS u16* sK = sKb + kt * 64 * 104;
      const LAS u16* sV = sVb + kt * 64;
      f32x4 s[4][2];
#pragma unroll
      for (int k4 = 0; k4 < 4; ++k4) {
        s[k4][0] = (f32x4){0.f, 0.f, 0.f, 0.f};
        s[k4][1] = (f32x4){0.f, 0.f, 0.f, 0.f};
#pragma unroll
        for (int ks = 0; ks < 3; ++ks) {
          const bf16x8 kf = *(const LAS bf16x8*)(sK + (k4 * 16 + lr) * 104 + ks * 32 + g * 8);
          s[k4][0] = MFMA(kf, qf[0][ks], s[k4][0]);
          s[k4][1] = MFMA(kf, qf[1][ks], s[k4][1]);
        }
      }
      bf16x8 pf[2][2];
#pragma unroll
      for (int qt = 0; qt < 2; ++qt) {
        float mx = -1e30f;
#pragma unroll
        for (int k4 = 0; k4 < 4; ++k4)
#pragma unroll
          for (int i = 0; i < 4; ++i) mx = fmaxf(mx, s[k4][qt][i]);
        mx = xrow16_max(mx);
        const float mnew = fmaxf(mrow[qt], mx * cs2);
        const float alpha = __builtin_amdgcn_exp2f(mrow[qt] - mnew);
        mrow[qt] = mnew;
        float psum = 0.f;
        float pv[4][4];
#pragma unroll
        for (int k4 = 0; k4 < 4; ++k4)
#pragma unroll
          for (int i = 0; i < 4; ++i) {
            pv[k4][i] = __builtin_amdgcn_exp2f(s[k4][qt][i] * cs2 - mnew);
            psum += pv[k4][i];
          }
        lrow[qt] = lrow[qt] * alpha + psum;
        if (__builtin_amdgcn_ballot_w64(alpha != 1.f) != 0ull) {
#pragma unroll
          for (int dt = 0; dt < 4; ++dt) o[qt][dt] *= alpha;
        }
#pragma unroll
        for (int s2 = 0; s2 < 2; ++s2) {
          u32x4 pk = {pack2(pv[2 * s2][0], pv[2 * s2][1]), pack2(pv[2 * s2][2], pv[2 * s2][3]),
                      pack2(pv[2 * s2 + 1][0], pv[2 * s2 + 1][1]), pack2(pv[2 * s2 + 1][2], pv[2 * s2 + 1][3])};
          pf[qt][s2] = __builtin_bit_cast(bf16x8, pk);
        }
      }
#pragma unroll
      for (int s2 = 0; s2 < 2; ++s2)
#pragma unroll
        for (int dt = 0; dt < 4; ++dt) {
          const s16x4 lo = *(const LAS s16x4*)(sV + (dt * 16 + lr) * 264 + s2 * 32 + g * 4);
          const s16x4 hi = *(const LAS s16x4*)(sV + (dt * 16 + lr) * 264 + s2 * 32 + 16 + g * 4);
          const bf16x8 vf = __builtin_shufflevector(lo, hi, 0, 1, 2, 3, 4, 5, 6, 7);
          o[0][dt] = MFMA(vf, pf[0][s2], o[0][dt]);
          o[1][dt] = MFMA(vf, pf[1][s2], o[1][dt]);
        }
    }
  }
#pragma unroll
  for (int qt = 0; qt < 2; ++qt) {
    float lsum = lrow[qt];
    lsum = xrow16_sum(lsum);
    const float inv = frcp(lsum);
    const int tok = qtok0 + wave * 32 + qt * 16 + lr;
#pragma unroll
    for (int dt = 0; dt < 4; ++dt) {
      u32x2 pk = {pack2(o[qt][dt][0] * inv, o[qt][dt][1] * inv), pack2(o[qt][dt][2] * inv, o[qt][dt][3] * inv)};
      *(u32x2*)(p.hb + (size_t)tok * 1024 + h * 64 + dt * 16 + g * 4) = pk;
    }
  }
}

DI int next_item(unsigned* ctr, int* slot) {
  __syncthreads();
  if (threadIdx.x == 0) *slot = (int)atomicAdd(ctr, 1u);
  __syncthreads();
  return *slot;
}

DI void forward(char* smem) {
  const int G = gridDim.x, bid = blockIdx.x;
  const int wave = threadIdx.x >> 6;
  int* slot = (int*)(smem + LDS_MAIN + 32);
  int ph = 0;
  XcdBarrier xb;
  {
    unsigned* stw = (unsigned*)(smem + LDS_MAIN);
    if (threadIdx.x == 0) { stw[0] = 0u; stw[1] = 0u; }
    __syncthreads();
    CP& p0 = get_params();
    xb = xcd_barrier_post(p0.bar, (volatile LAS unsigned*)stw);
    (void)xb;
  }
#define PH_BEGIN { CP& p = get_params();
#if USE_CG_SYNC
#define PH_END } { if (ph == 0) cg::this_grid().sync(); else { XcdBarrier xq; xq.bar = nullptr; xq.x = 0u; xq.st = (volatile LAS unsigned*)(smem + LDS_MAIN); xcd_barrier(xq); } } ++ph;
#else
#define PH_END } { XcdBarrier xq; xq.bar = nullptr; xq.x = 0u; xq.st = (volatile LAS unsigned*)(smem + LDS_MAIN); xcd_barrier(xq); } ++ph;
#endif

  PH_BEGIN
    phase0(p, smem);
  PH_END

#pragma unroll 1
  for (int l = 0; l < 4; ++l) {
    PH_BEGIN
      norm_phase(p, l, 0);
    PH_END
    PH_BEGIN
      gemm_phase<E_COMB, 192>(p, l, p.hb, p.wt_in + (size_t)l * INWP * 1024, 1024, 64, 7, 0, bid, G, 64 * 7, true, smem);
    PH_END
    PH_BEGIN
      for (int t = bid; t < 768 + 128; t += G) {
        if (t < 768) prep_tile(p, l, t, smem);
        else prep_cache_row(p, l, NTOK + (t - 768) * 8 + wave);
      }
    PH_END
    PH_BEGIN
      for (;;) {
        const int it = next_item(p.ctr + ph, slot);
        if (it >= 160 + 384 + 208 + 144) break;
        if (it < 32 || (it >= 416 && it < 544)) {
          const int j = it < 32 ? it : it - 416;
          ssd_item(p, l, (it < 32 ? 16 : 0) + (j >> 3), (j >> 1) & 3, j & 1, smem);
        } else if (it < 416) {
          cm_tile(p, l, it - 32, smem);
        } else if (it < 752) {
          const int t = it - 544;
          gemm_phase<E_KV, 256>(p, l, p.ckvn, p.wt_ukv + (size_t)l * 1024 * 128, 128, 52, 4, 0, t, 1 << 20, 208, false, smem);
        } else {
          const int t = it - 752;
          gemm_phase<E_Q, 256>(p, l, p.qn, p.wt_uq + (size_t)l * 768 * 256, 256, 48, 3, 0, t, 1 << 20, 144, false, smem);
        }
      }
      if (l < 3) conv_fill(p, l + 1, 0, 5792, p.ctr + 128 + ph, slot, smem);
    PH_END
    PH_BEGIN
      for (;;) {
        const int it = next_item(p.ctr + ph, slot);
        if (it >= 384 + 384) break;
        if (it < 384) {
          int sq, hh, qb;
          if (it < 256) { sq = 16 + (it >> 6); hh = (it >> 3) & 7; qb = it & 7; }
          else { const int j = it - 256; sq = j >> 3; hh = j & 7; qb = 0; }
          attn_item(p, sq, hh, qb, smem);
        } else {
          const int t0 = (it - 384) * 32 + wave * 4;
          ssd_final_rows4(p, l, t0);
        }
      }
    PH_END
    PH_BEGIN
      gemm_phase<E_RES, 192>(p, l, p.hb, p.wt_out + (size_t)l * 1024 * 1024, 1024, 64, 4, 2048, bid, G, 64 * 4, true, smem);
    PH_END
    PH_BEGIN
      norm_phase(p, l, 1);
    PH_END
    PH_BEGIN
      gemm_phase<E_SWIGLU, 192>(p, l, p.hb, p.wt_gu + (size_t)l * 2 * DFF * 1024, 1024, 64, 22, 0, bid, G, 64 * 22, true, smem);
    PH_END
    PH_BEGIN
      gemm_phase<E_RES, 192>(p, l, p.act, p.wt_down + (size_t)l * 1024 * DFF, DFF, 64, 4, 5120, bid, G, 64 * 4, true, smem);
    PH_END
  }
  { CP& p = get_params(); final_norm(p); }
}

extern __shared__ __attribute__((aligned(1024))) char dyn_smem[];

__global__ void __launch_bounds__(NTHREADS, 2) k_mega(P p) { forward(dyn_smem); }

extern "C" void kernel_launch(void* const* d_in, const int* in_sizes, int n_in, void* d_out, int out_size, void* d_ws,
                              size_t ws_size, hipStream_t stream) {
  P p{};
  const float** fp = (const float**)&p;
  for (int i = 0; i < 31; ++i) fp[i] = (const float*)d_in[i];
  p.out = (float*)d_out;
  char* ws = (char*)d_ws;
  size_t off = 0;
  auto take = [&](size_t bytes) { char* r = ws + off; off += (bytes + 255) & ~(size_t)255; return r; };
  p.bar = (unsigned*)take(16384);
  p.ctr = (unsigned*)take(16384);
  p.wt_in = (u16*)take((size_t)4 * INWP * 1024 * 2);
  p.wt_uq = (u16*)take((size_t)4 * 768 * 256 * 2);
  p.wt_ukv = (u16*)take((size_t)4 * 1024 * 128 * 2);
  p.wt_out = (u16*)take((size_t)4 * 1024 * 1024 * 2);
  p.wt_gu = (u16*)take((size_t)4 * 2 * DFF * 1024 * 2);
  p.wt_down = (u16*)take((size_t)4 * 1024 * DFF * 2);
  p.mod = (float*)take((size_t)4 * 5 * 6144 * 4);
  p.ropec = (float*)take(2048 * 16 * 4);
  p.ropes = (float*)take(2048 * 16 * 4);
  p.hb = (u16*)take((size_t)NTOK * 1024 * 2);
  p.comb = (u16*)take((size_t)NTOK * DFF * 2);
  p.act = p.comb;
  p.qn = (u16*)take((size_t)NTOK * 256 * 2);
  p.ckvn = (u16*)take((size_t)KVROWS * 128 * 2);
  p.qbuf = (u16*)take((size_t)NTOK * 768 * 2);
  p.knope = (u16*)take((size_t)KVROWS * 512 * 2);
  p.vt = (u16*)take((size_t)KVROWS * 512 * 2);
  p.krope = (u16*)take((size_t)KVROWS * 32 * 2);
  p.xbc = (float*)take((size_t)NTOK * 512 * 4);
  p.dtb = (float*)take((size_t)NTOK * 8 * 4);
  p.ydir = (float*)take((size_t)2 * NTOK * 256 * 4);
  if (off > ws_size) { fprintf(stderr, "workspace too small: need %zu have %zu\n", off, ws_size); return; }

  static int grid_blocks = 0;
  if (!grid_blocks) {
    int dev = 0, cus = 0, per_cu = 0;
    (void)hipGetDevice(&dev);
    (void)hipDeviceGetAttribute(&cus, hipDeviceAttributeMultiprocessorCount, dev);
    (void)hipFuncSetAttribute((const void*)k_mega, hipFuncAttributeMaxDynamicSharedMemorySize, LDS_BYTES);
    (void)hipOccupancyMaxActiveBlocksPerMultiprocessor(&per_cu, (const void*)k_mega, NTHREADS, LDS_BYTES);
    if (per_cu > 1) per_cu = 1;
    if (per_cu < 1) per_cu = 1;
    grid_blocks = cus * per_cu;
  }
  (void)hipMemsetAsync(d_ws, 0, 32768, stream);
  void* args[] = {&p};
  hipError_t e = hipLaunchCooperativeKernel((const void*)k_mega, dim3(grid_blocks), dim3(NTHREADS), args, LDS_BYTES, stream);
  if (e != hipSuccess) fprintf(stderr, "cooperative launch failed: %s (grid %d)\n", hipGetErrorString(e), grid_blocks);
}
```

```cpp
#include <hip/hip_runtime.h>
#include <hip/hip_cooperative_groups.h>
#include <stdint.h>
#include <stdio.h>
namespace cg = cooperative_groups;

#ifndef USE_CG_SYNC
#define USE_CG_SYNC 0
#endif

#define DI __device__ __forceinline__
#define LAS __attribute__((address_space(3)))
typedef unsigned short u16;
typedef __bf16 bf2_t __attribute__((ext_vector_type(2)));
typedef float f2_t __attribute__((ext_vector_type(2)));
using bf16x8 = __attribute__((ext_vector_type(8))) short;
using s16x4 = __attribute__((ext_vector_type(4))) short;
using f32x4 = __attribute__((ext_vector_type(4))) float;
using u32x4 = __attribute__((ext_vector_type(4))) unsigned;
using u32x2 = __attribute__((ext_vector_type(2))) unsigned;

#define MFMA(a, b, c) __builtin_amdgcn_mfma_f32_16x16x32_bf16((a), (b), (c), 0, 0, 0)

constexpr int NTOK = 12288, NCTX = 4096, KVROWS = 13312;
constexpr int INW = 1704, INWP = 1792, DFF = 2816;
constexpr size_t O_CKV = 12582912, O_KR = 14680064, O_SSD = 15204352;
constexpr int LDS_MAIN = 139264;
constexpr int LDS_BYTES = LDS_MAIN + 64;
constexpr int NTHREADS = 512;

struct P {
  const float *x_prompt, *x_sample, *c, *cache_ckv, *cache_krope, *state_ssd, *c_ctx, *w_ada, *b_ada, *g_mix, *w_in,
      *g_q, *w_uq, *g_kv, *w_ukv, *ssd_conv_w, *ssd_conv_b, *ssd_dt_bias, *ssd_a_log, *ssd_d, *ssd_norm_g, *cm_conv_w,
      *cm_conv_b, *cm_ln_g, *cm_ln_b, *w_out, *g_ffn, *w_gate, *w_up, *w_down, *g_final;
  float* out;
  unsigned* bar;
  unsigned* ctr;
  u16 *wt_in, *wt_uq, *wt_ukv, *wt_out, *wt_gu, *wt_down;
  float *mod, *ropec, *ropes;
  u16* hb;
  u16* comb;
  u16* act;
  u16 *qn, *ckvn, *qbuf, *knope, *vt, *krope;
  float *xbc, *dtb, *ydir;
};

typedef const __attribute__((address_space(4))) P CP;
DI CP& get_params() {
  unsigned long long kp = (unsigned long long)__builtin_amdgcn_kernarg_segment_ptr();
  asm volatile("" : "+s"(kp));
  return *(CP*)kp;
}
DI int opaque_tid() { int t = threadIdx.x; asm volatile("" : "+v"(t)); return t; }

DI unsigned pack2(float a, float b) {
  f2_t v = {a, b};
  bf2_t r = __builtin_convertvector(v, bf2_t);
  return __builtin_bit_cast(unsigned, r);
}
DI u16 f2bf(float a) { return (u16)(pack2(a, 0.f) & 0xffffu); }
DI float bf2f(u16 v) { return __uint_as_float(((unsigned)v) << 16); }
DI float frcp(float x) { return __builtin_amdgcn_rcpf(x); }
DI float xrow16_max(float x) {
  auto s = __builtin_amdgcn_permlane16_swap(__float_as_uint(x), __float_as_uint(x), false, false);
  x = fmaxf(__uint_as_float(s[0]), __uint_as_float(s[1]));
  auto t = __builtin_amdgcn_permlane32_swap(__float_as_uint(x), __float_as_uint(x), false, false);
  return fmaxf(__uint_as_float(t[0]), __uint_as_float(t[1]));
}
DI float xrow16_sum(float x) {
  auto s = __builtin_amdgcn_permlane16_swap(__float_as_uint(x), __float_as_uint(x), false, false);
  x = __uint_as_float(s[0]) + __uint_as_float(s[1]);
  auto t = __builtin_amdgcn_permlane32_swap(__float_as_uint(x), __float_as_uint(x), false, false);
  return __uint_as_float(t[0]) + __uint_as_float(t[1]);
}
template <int CTRL> DI float dppf(float x) {
  return __builtin_bit_cast(float, __builtin_amdgcn_mov_dpp(__builtin_bit_cast(int, x), CTRL, 0xf, 0xf, true));
}
DI float wave_sum(float x) {
  x += dppf<0xB1>(x);
  x += dppf<0x4E>(x);
  x += dppf<0x141>(x);
  x += dppf<0x128>(x);
  return xrow16_sum(x);
}
DI float sigmoidf(float x) { return frcp(1.f + __expf(-x)); }
DI float siluf(float x) { return x * frcp(1.f + __expf(-x)); }

#define XB_TMO      128
#define XB_XCNT(j)  (256  + 64 * (j))
#define XB_XSUB(j)  (1280 + 64 * (j))
#define XB_XGEN(j)  (2304 + 64 * (j))
#define XB_TOP      3328
#define XB_TOPGEN   3392
#define XB_SPIN_CAP (1u << 20)
DI unsigned xb_ld(unsigned* p) { return __hip_atomic_load(p, __ATOMIC_RELAXED, __HIP_MEMORY_SCOPE_AGENT); }
DI unsigned xb_add(unsigned* p, unsigned v) { return __hip_atomic_fetch_add(p, v, __ATOMIC_RELAXED, __HIP_MEMORY_SCOPE_AGENT); }
DI unsigned xb_xcc_id() { return (unsigned)__builtin_amdgcn_s_getreg((3 << 11) | 20) & 0xFu; }
#define XB_SPIN(cond, bar) do { unsigned _sp = 0; while (cond) { __builtin_amdgcn_s_sleep(1); \
    if ((++_sp & 255u) == 0u) { if (xb_ld(&(bar)[XB_TMO])) break; if (_sp > XB_SPIN_CAP) { atomicAdd(&(bar)[XB_TMO], 1u); break; } } } } while (0)
struct XcdBarrier { unsigned* bar; unsigned x; volatile LAS unsigned* st; };
DI XcdBarrier xcd_barrier_post(unsigned* bar, volatile LAS unsigned* st) {
  XcdBarrier b; b.bar = bar; b.x = xb_xcc_id(); b.st = st;
  if (threadIdx.x == 0) (void)xb_add(&bar[XB_XCNT(b.x)], 1u);
  return b;
}
DI void xcd_barrier_complete(unsigned* bar, unsigned x, unsigned& nloc, unsigned& nx) {
  const unsigned G = gridDim.x * gridDim.y * gridDim.z;
  unsigned sum, cnt, mine, sp = 0u;
  for (;;) {
    sum = 0u; cnt = 0u; mine = 0u;
#pragma unroll
    for (unsigned j = 0; j < 16; ++j) { const unsigned c = xb_ld(&bar[XB_XCNT(j)]); sum += c; cnt += (c > 0u) ? 1u : 0u; mine = (j == x) ? c : mine; }
    if (sum == G) break;
    __builtin_amdgcn_s_sleep(1);
    if ((++sp & 255u) == 0u) { if (xb_ld(&bar[XB_TMO])) break; if (sp > XB_SPIN_CAP) { atomicAdd(&bar[XB_TMO], 1u); break; } }
  }
  nloc = mine > 0u ? mine : 1u; nx = cnt > 0u ? cnt : 1u;
}
DI void xcd_barrier(const XcdBarrier& b0) {
  asm volatile("s_waitcnt vmcnt(0)" ::: "memory");
  __syncthreads();
  if (threadIdx.x == 0) {
    XcdBarrier b; b.bar = get_params().bar; b.x = xb_xcc_id(); b.st = b0.st;
    unsigned* bar = b.bar;
    __builtin_amdgcn_s_waitcnt(0);
    unsigned nloc = b.st[0], nx = b.st[1];
    if (nloc == 0u) { xcd_barrier_complete(bar, b.x, nloc, nx); b.st[0] = nloc; b.st[1] = nx; }
    const unsigned old = xb_add(&bar[XB_XSUB(b.x)], 1u);
    const unsigned gen = old / nloc;
    if (old + 1u == (gen + 1u) * nloc) {
      __builtin_amdgcn_fence(__ATOMIC_RELEASE, "agent");
      asm volatile("s_waitcnt vmcnt(0)" ::: "memory");
      const unsigned og = xb_add(&bar[XB_TOP], 1u);
      const unsigned tg = og / nx;
      if (og + 1u == (tg + 1u) * nx) xb_add(&bar[XB_TOPGEN], 1u);
      else XB_SPIN(xb_ld(&bar[XB_TOPGEN]) == tg, bar);
      __builtin_amdgcn_fence(__ATOMIC_ACQUIRE, "agent");
      xb_add(&bar[XB_XGEN(b.x)], 1u);
      asm volatile("s_waitcnt vmcnt(0)" ::: "memory");
    } else {
      XB_SPIN(xb_ld(&bar[XB_XGEN(b.x)]) == gen, bar);
      __builtin_amdgcn_fence(__ATOMIC_ACQUIRE, "agent");
      asm volatile("s_waitcnt vmcnt(0)" ::: "memory");
    }
  }
  __syncthreads();
}

enum { E_COMB = 0, E_Q = 1, E_KV = 2, E_RES = 3, E_SWIGLU = 4 };

DI int lds_byte(int r, int c) {
  const int st = (r >> 4) * 2 + (c >> 5), ob = (r & 15) * 64 + (c & 31) * 2;
  return st * 1024 + (ob ^ (((ob >> 9) & 1) << 5));
}
DI void stage_rc(int b, int& R, int& C) {
  const int st = b >> 10, sb = b & 1023, swz = sb ^ (((sb >> 9) & 1) << 5);
  R = (st >> 1) * 16 + swz / 64;
  C = (st & 1) * 32 + (swz % 64) / 2;
}
DI void tile_rc(int t, int nM, int nN, int& pm, int& pn) {
  const int nwg = nM * nN;
  const int q = nwg / 8, r = nwg % 8, xcd = t % 8, off = t / 8;
  const int w = (xcd < r ? xcd * (q + 1) : r * (q + 1) + (xcd - r) * q) + off;
  const int nig = 8 * nN, gid = w / nig, fm = gid * 8;
  const int gsz = (nM - fm) < 8 ? (nM - fm) : 8;
  pm = fm + ((w % nig) % gsz);
  pn = (w % nig) / gsz;
}

DI u32x4 widen16(u32x2 a, u32x2 b) {
  auto s0 = __builtin_amdgcn_permlane16_swap(a[0], b[0], false, false);
  auto s1 = __builtin_amdgcn_permlane16_swap(a[1], b[1], false, false);
  u32x4 r = {s0[0], s1[0], s0[1], s1[1]};
  return r;
}

template <int EPI, int MT>
DI void gemm_epilogue(CP& p, int l, const f32x4 (&acc)[MT][4], int mb, int nb, int goff, int fr, int fq) {
  if (EPI == E_COMB || EPI == E_Q || EPI == E_SWIGLU) {
    const int tsel = fq & 1, csel = (fq >> 1) * 8;
#pragma unroll
    for (int mi = 0; mi < MT; ++mi) {
      const int m = mb + mi * 16 + fr;
      if (EPI == E_SWIGLU) {
        u32x2 r[2];
#pragma unroll
        for (int q = 0; q < 2; ++q) {
          const f32x4 gv = acc[mi][2 * q], uv = acc[mi][2 * q + 1];
          r[q] = (u32x2){pack2(siluf(gv[0]) * uv[0], siluf(gv[1]) * uv[1]), pack2(siluf(gv[2]) * uv[2], siluf(gv[3]) * uv[3])};
        }
        const u32x4 w = widen16(r[0], r[1]);
        *(u32x4*)(p.act + (size_t)m * DFF + (nb >> 1) + tsel * 16 + csel) = w;
      } else {
#pragma unroll
        for (int q = 0; q < 2; ++q) {
          const f32x4 va = acc[mi][2 * q], vb = acc[mi][2 * q + 1];
          const u32x2 a = {pack2(va[0], va[1]), pack2(va[2], va[3])};
          const u32x2 b = {pack2(vb[0], vb[1]), pack2(vb[2], vb[3])};
          const u32x4 w = widen16(a, b);
          const int n = nb + (2 * q + tsel) * 16 + csel;
          if (EPI == E_COMB) { if (n < INW) *(u32x4*)(p.comb + (size_t)m * INW + n) = w; }
          else *(u32x4*)(p.qbuf + (size_t)m * 768 + n) = w;
        }
      }
    }
    return;
  }
#pragma unroll
  for (int mi = 0; mi < MT; ++mi) {
    const int m = mb + mi * 16 + fr;
#pragma unroll
    for (int ni = 0; ni < 4; ++ni) {
      const int n = nb + ni * 16 + fq * 4;
      const f32x4 v = acc[mi][ni];
      if (EPI == E_COMB) {
        if (n < INW) { u32x2 o = {pack2(v[0], v[1]), pack2(v[2], v[3])}; *(u32x2*)(p.comb + (size_t)m * INW + n) = o; }
      } else if (EPI == E_Q) {
        u32x2 o = {pack2(v[0], v[1]), pack2(v[2], v[3])};
        *(u32x2*)(p.qbuf + (size_t)m * 768 + n) = o;
      } else if (EPI == E_KV) {
        const int hh = n >> 7, c = n & 127;
        if (c < 64) {
          u32x2 o = {pack2(v[0], v[1]), pack2(v[2], v[3])};
          *(u32x2*)(p.knope + (size_t)m * 512 + hh * 64 + c) = o;
        } else {
          int kvbase, Tk;
          if (m < NCTX) { kvbase = m & ~255; Tk = 256; }
          else { const int b = (m - NCTX) / 2304; kvbase = NCTX + b * 2304; Tk = 2304; }
          u16* dst = p.vt + (size_t)512 * kvbase + (size_t)(hh * 64 + (c - 64)) * Tk + (m - kvbase);
#pragma unroll
          for (int i = 0; i < 4; ++i) dst[(size_t)i * Tk] = f2bf(v[i]);
        }
      } else if (EPI == E_RES) {
        const int vs = m < NCTX ? 0 : 1 + ((m - NCTX) >> 11);
        const f32x4 gt = *(const f32x4*)(p.mod + (size_t)(l * 5 + vs) * 6144 + goff + n);
        float* xp = p.out + (size_t)m * 1024 + n;
        const float* xs = xp;
        if (l == 0 && goff == 2048) xs = (m < NCTX ? p.x_prompt + (size_t)m * 1024 : p.x_sample + (size_t)(m - NCTX) * 1024) + n;
        f32x4 xv = *(const f32x4*)xs;
        xv += gt * v;
        *(f32x4*)xp = xv;
      } else if (EPI == E_SWIGLU) {
        if ((ni & 1) == 0) {
          const f32x4 u = acc[mi][ni + 1];
          u32x2 o = {pack2(siluf(v[0]) * u[0], siluf(v[1]) * u[1]), pack2(siluf(v[2]) * u[2], siluf(v[3]) * u[3])};
          *(u32x2*)(p.act + (size_t)m * DFF + ((nb + ni * 16) >> 1) + fq * 4) = o;
        }
      }
    }
  }
}

#define GEMM_STAGE(buf, Ap, Wp, kt) do {                                                                                  \
    _Pragma("unroll") for (int i = 0; i < GLA; ++i)                                                                       \
      __builtin_amdgcn_global_load_lds((const unsigned*)((Ap) + (size_t)sR[i] * K + (kt) * 64 + sC[i]),                    \
                                       (LAS unsigned*)(ls + (buf) * STAGE_B + wid * 1024 + i * 8192), 16, 0, 0);         \
    _Pragma("unroll") for (int i = 0; i < 4; ++i)                                                                         \
      __builtin_amdgcn_global_load_lds((const unsigned*)((Wp) + (size_t)sR[i] * K + (kt) * 64 + sC[i]),                    \
                                       (LAS unsigned*)(ls + (buf) * STAGE_B + TILE_A + wid * 1024 + i * 8192), 16, 0, 0); \
  } while (0)

template <int EPI, int BM>
DI void gemm_phase(CP& p, int l, const u16* __restrict__ A, const u16* __restrict__ W, int K, int nM, int nN, int goff,
                   int t0, int tstride, int ntiles, bool raster, char* smem) {
  const int tid = opaque_tid(), lane = tid & 63, wid = tid >> 6;
  const int wr = wid >> 2, wc = wid & 3, fr = lane & 15, fq = lane >> 4;
  constexpr int MT = BM / 32, GLA = BM / 64;
  constexpr int TILE_A = BM * 128, TILE_B = 256 * 128, STAGE_B = TILE_A + TILE_B;
  LAS char* ls = (LAS char*)smem;
  int sR[4], sC[4];
#pragma unroll
  for (int i = 0; i < 4; ++i) stage_rc(wid * 1024 + i * 8192 + lane * 16, sR[i], sC[i]);
  int t = t0;
  if (t >= ntiles) return;
  int pm, pn;
  if (raster) tile_rc(t, nM, nN, pm, pn); else { pn = t / nM; pm = t - pn * nM; }
  const u16* Ab = A + (size_t)pm * BM * K;
  const u16* Wb = W + (size_t)pn * 256 * K;
  const int nt = K >> 6;
  const int obf = fr * 64 + fq * 16, swzf = obf ^ (((obf >> 9) & 1) << 5);
  const char* fragA = smem + wr * (BM / 32) * 2048 + swzf;
  const char* fragB = smem + TILE_A + wc * 4 * 2048 + swzf;
  __syncthreads();
  GEMM_STAGE(0, Ab, Wb, 0);
  asm volatile("s_waitcnt vmcnt(0)" ::: "memory");
  __syncthreads();
  for (;;) {
    const int tn = t + tstride;
    const bool has_next = tn < ntiles;
    int pmn = 0, pnn = 0;
    if (has_next) { if (raster) tile_rc(tn, nM, nN, pmn, pnn); else { pnn = tn / nM; pmn = tn - pnn * nM; } }
    const u16* Abn = A + (size_t)pmn * BM * K;
    const u16* Wbn = W + (size_t)pnn * 256 * K;
    f32x4 acc[MT][4];
#pragma unroll
    for (int m = 0; m < MT; ++m)
#pragma unroll
      for (int n = 0; n < 4; ++n) acc[m][n] = (f32x4){0.f, 0.f, 0.f, 0.f};
    for (int kt = 0; kt < nt; ++kt) {
      const int cur = kt & 1;
      if (kt + 1 < nt) GEMM_STAGE(cur ^ 1, Ab, Wb, kt + 1);
      else if (has_next) GEMM_STAGE(cur ^ 1, Abn, Wbn, 0);
      const char* sa = fragA + cur * STAGE_B;
      const char* sb = fragB + cur * STAGE_B;
#pragma unroll
      for (int ks = 0; ks < 2; ++ks) {
        bf16x8 At[MT], Bf[4];
#pragma unroll
        for (int m = 0; m < MT; ++m) At[m] = *(const bf16x8*)(sa + m * 2048 + ks * 1024);
#pragma unroll
        for (int n = 0; n < 4; ++n) Bf[n] = *(const bf16x8*)(sb + n * 2048 + ks * 1024);
        __builtin_amdgcn_s_setprio(1);
#pragma unroll
        for (int m = 0; m < MT; ++m)
#pragma unroll
          for (int n = 0; n < 4; ++n) acc[m][n] = MFMA(Bf[n], At[m], acc[m][n]);
        __builtin_amdgcn_s_setprio(0);
        __builtin_amdgcn_sched_barrier(0);
      }
      if (kt + 1 < nt) {
        asm volatile("s_waitcnt vmcnt(0)" ::: "memory");
        __syncthreads();
      }
    }
    gemm_epilogue<EPI, MT>(p, l, acc, pm * BM + wr * (BM / 2), pn * 256 + wc * 64, goff, fr, fq);
    asm volatile("s_waitcnt vmcnt(0)" ::: "memory");
    __syncthreads();
    if (!has_next) break;
    t = tn; pm = pmn; pn = pnn; Ab = Abn; Wb = Wbn;
  }
}
#undef GEMM_STAGE

DI void conv_wtile(const float* __restrict__ src, int K, int N, u16* __restrict__ dst, int rowmul, int rowoff, int kt,
                   int nt, LAS float* wt, int lane) {
  const int k0 = kt * 32, n0 = nt * 64;
  float v[32];
  const bool ok = n0 + lane < N;
  const float* sp = src + (size_t)k0 * N + n0 + lane;
#pragma unroll
  for (int i = 0; i < 32; ++i) v[i] = ok ? sp[(size_t)i * N] : 0.f;
#pragma unroll
  for (int i = 0; i < 32; ++i) wt[i * 65 + lane] = v[i];
#pragma unroll
  for (int i = 0; i < 16; ++i) {
    const int n = i * 4 + (lane >> 4), kp = lane & 15;
    const float lo = wt[(2 * kp) * 65 + n], hi = wt[(2 * kp + 1) * 65 + n];
    const int nn = n0 + n;
    const int drow = rowmul == 1 ? nn : ((nn >> 4) << 5) + (nn & 15) + 16 * rowoff;
    *(unsigned*)(dst + (size_t)drow * K + k0 + 2 * kp) = pack2(lo, hi);
  }
}

DI void conv_dispatch(CP& p, int l, int r, LAS float* wt, int lane) {
  if (r < 896) {
    conv_wtile(p.w_in + (size_t)l * 1024 * INW, 1024, INW, p.wt_in + (size_t)l * INWP * 1024, 1, 0, r & 31, r >> 5, wt, lane);
  } else if ((r -= 896) < 96) {
    conv_wtile(p.w_uq + (size_t)l * 256 * 768, 256, 768, p.wt_uq + (size_t)l * 768 * 256, 1, 0, r & 7, r >> 3, wt, lane);
  } else if ((r -= 96) < 64) {
    conv_wtile(p.w_ukv + (size_t)l * 128 * 1024, 128, 1024, p.wt_ukv + (size_t)l * 1024 * 128, 1, 0, r & 3, r >> 2, wt, lane);
  } else if ((r -= 64) < 512) {
    conv_wtile(p.w_out + (size_t)l * 1024 * 1024, 1024, 1024, p.wt_out + (size_t)l * 1024 * 1024, 1, 0, r & 31, r >> 5, wt, lane);
  } else if ((r -= 512) < 1408) {
    conv_wtile(p.w_gate + (size_t)l * 1024 * DFF, 1024, DFF, p.wt_gu + (size_t)l * 2 * DFF * 1024, 2, 0, r & 31, r >> 5, wt, lane);
  } else if ((r -= 1408) < 1408) {
    conv_wtile(p.w_up + (size_t)l * 1024 * DFF, 1024, DFF, p.wt_gu + (size_t)l * 2 * DFF * 1024, 2, 1, r & 31, r >> 5, wt, lane);
  } else {
    r -= 1408;
    conv_wtile(p.w_down + (size_t)l * DFF * 1024, DFF, 1024, p.wt_down + (size_t)l * 1024 * DFF, 1, 0, r % 88, r / 88, wt, lane);
  }
}

DI void conv_fill(CP& p, int l, int r_lo, int r_hi, unsigned* ctr, int* slot, char* smem) {
  const int tid = opaque_tid(), lane = tid & 63, wave = tid >> 6;
  LAS float* wt = (LAS float*)smem + wave * (32 * 65);
  const int nitems = (r_hi - r_lo + 7) >> 3;
  for (;;) {
    __syncthreads();
    if (tid == 0) *slot = (int)atomicAdd(ctr, 1u);
    __syncthreads();
    const int it = *slot;
    if (it >= nitems) break;
    const int r = r_lo + it * 8 + wave;
    if (r < r_hi) conv_dispatch(p, l, r, wt, lane);
  }
}

DI void phase0(CP& p, char* smem) {
  const int tid = opaque_tid();
  const int G = gridDim.x, bid = blockIdx.x;
  {
    const int lane = tid & 63, wave = tid >> 6;
    LAS float* wt = (LAS float*)smem + wave * (32 * 65);
    __syncthreads();
    for (int idx = bid * 8 + wave; idx < 5792; idx += G * 8) conv_dispatch(p, 0, idx, wt, lane);
  }
  {
    float* scond = (float*)(smem + 32768);
    float* red = scond + 5120;
    __syncthreads();
    for (int i = tid; i < 5120; i += NTHREADS) {
      const int v = i >> 10, k = i & 1023;
      const float x = v == 0 ? p.c_ctx[k] : p.c[(v - 1) * 1024 + k];
      scond[i] = siluf(x);
    }
    __syncthreads();
    for (int job = bid; job < 384; job += G) {
      const int l = job / 96, chunk = job - l * 96;
      const int c = tid & 63, kg = tid >> 6, col = chunk * 64 + c;
      float a0 = 0.f, a1 = 0.f, a2 = 0.f, a3 = 0.f, a4 = 0.f;
      const float* w = p.w_ada + ((size_t)l * 1024 + kg * 128) * 6144 + col;
      const float* sc = scond + kg * 128;
#pragma unroll 32
      for (int k = 0; k < 128; ++k) {
        const float wv = w[(size_t)k * 6144];
        a0 += sc[k] * wv; a1 += sc[1024 + k] * wv; a2 += sc[2048 + k] * wv; a3 += sc[3072 + k] * wv; a4 += sc[4096 + k] * wv;
      }
      red[(kg * 5 + 0) * 64 + c] = a0; red[(kg * 5 + 1) * 64 + c] = a1; red[(kg * 5 + 2) * 64 + c] = a2;
      red[(kg * 5 + 3) * 64 + c] = a3; red[(kg * 5 + 4) * 64 + c] = a4;
      __syncthreads();
      if (kg == 0) {
        const float bb = p.b_ada[l * 6144 + col];
#pragma unroll
        for (int v = 0; v < 5; ++v) {
          float s = 0.f;
#pragma unroll
          for (int q = 0; q < 8; ++q) s += red[(q * 5 + v) * 64 + c];
          p.mod[(size_t)(l * 5 + v) * 6144 + col] = s + bb;
        }
      }
      __syncthreads();
    }
  }
  for (int i = bid * NTHREADS + tid; i < 2048 * 16; i += G * NTHREADS) {
    const int t = i >> 4, a = (i >> 3) & 1, f = i & 7;
    const float pos = a == 0 ? (float)(t >> 6) : (float)(t & 63);
    const float inv = powf(10000.0f, -(float)f / 8.0f);
    const float ang = pos * inv;
    p.ropec[i] = cosf(ang);
    p.ropes[i] = sinf(ang);
  }
}

DI void norm_phase(CP& p, int l, int which) {
  const int tid = opaque_tid(), lane = tid & 63, wave = tid >> 6;
  const float* gw = (which == 0 ? p.g_mix : p.g_ffn) + l * 1024;
  const int shoff = which == 0 ? 0 : 3072, scoff = shoff + 1024;
  f32x4 gg[4];
#pragma unroll
  for (int i = 0; i < 4; ++i) gg[i] = *(const f32x4*)(gw + i * 256 + lane * 4);
  const int stride = gridDim.x * 8;
  for (int tok0 = blockIdx.x * 8 + wave; tok0 < NTOK; tok0 += 2 * stride) {
    f32x4 v[2][4], sc[2][4], sh[2][4];
    bool ok[2];
#pragma unroll
    for (int a = 0; a < 2; ++a) {
      const int tok = tok0 + a * stride;
      ok[a] = tok < NTOK;
      const int tk = ok[a] ? tok : tok0;
      const float* xr = p.out + (size_t)tk * 1024;
      if (l == 0 && which == 0) xr = tk < NCTX ? p.x_prompt + (size_t)tk * 1024 : p.x_sample + (size_t)(tk - NCTX) * 1024;
      const int vs = tk < NCTX ? 0 : 1 + ((tk - NCTX) >> 11);
      const float* md = p.mod + (size_t)(l * 5 + vs) * 6144;
#pragma unroll
      for (int i = 0; i < 4; ++i) {
        const int col = i * 256 + lane * 4;
        v[a][i] = *(const f32x4*)(xr + col);
        sc[a][i] = *(const f32x4*)(md + scoff + col);
        sh[a][i] = *(const f32x4*)(md + shoff + col);
      }
    }
#pragma unroll
    for (int a = 0; a < 2; ++a) {
      const int tok = tok0 + a * stride;
      float ss = 0.f;
#pragma unroll
      for (int i = 0; i < 4; ++i) ss += v[a][i][0] * v[a][i][0] + v[a][i][1] * v[a][i][1] + v[a][i][2] * v[a][i][2] + v[a][i][3] * v[a][i][3];
      ss = wave_sum(ss);
      const float rstd = rsqrtf(ss * (1.f / 1024.f) + 1e-6f);
      if (ok[a]) {
#pragma unroll
        for (int i = 0; i < 4; ++i) {
          const int col = i * 256 + lane * 4;
          f32x4 o;
#pragma unroll
          for (int j = 0; j < 4; ++j) o[j] = v[a][i][j] * rstd * gg[i][j] * (1.f + sc[a][i][j]) + sh[a][i][j];
          u32x2 pk = {pack2(o[0], o[1]), pack2(o[2], o[3])};
          *(u32x2*)(p.hb + (size_t)tok * 1024 + col) = pk;
        }
      }
    }
  }
}

DI void final_norm(CP& p) {
  const int tid = opaque_tid(), lane = tid & 63, wave = tid >> 6;
  f32x4 gg[4];
#pragma unroll
  for (int i = 0; i < 4; ++i) gg[i] = *(const f32x4*)(p.g_final + i * 256 + lane * 4);
  const int stride = gridDim.x * 8;
  for (int tok0 = blockIdx.x * 8 + wave; tok0 < NTOK; tok0 += 2 * stride) {
    f32x4 v[2][4];
    bool ok[2];
#pragma unroll
    for (int a = 0; a < 2; ++a) {
      const int tok = tok0 + a * stride;
      ok[a] = tok < NTOK;
      const float* xr = p.out + (size_t)(ok[a] ? tok : tok0) * 1024;
#pragma unroll
      for (int i = 0; i < 4; ++i) v[a][i] = *(const f32x4*)(xr + i * 256 + lane * 4);
    }
#pragma unroll
    for (int a = 0; a < 2; ++a) {
      const int tok = tok0 + a * stride;
      float ss = 0.f;
#pragma unroll
      for (int i = 0; i < 4; ++i) ss += v[a][i][0] * v[a][i][0] + v[a][i][1] * v[a][i][1] + v[a][i][2] * v[a][i][2] + v[a][i][3] * v[a][i][3];
      ss = wave_sum(ss);
      const float rstd = rsqrtf(ss * (1.f / 1024.f) + 1e-6f);
      if (ok[a]) {
        float* xr = p.out + (size_t)tok * 1024;
#pragma unroll
        for (int i = 0; i < 4; ++i) {
          f32x4 o;
#pragma unroll
          for (int j = 0; j < 4; ++j) o[j] = v[a][i][j] * rstd * gg[i][j];
          *(f32x4*)(xr + i * 256 + lane * 4) = o;
        }
      }
    }
  }
}

DI void prep_cache_row(CP& p, int l, int row) {
  const int lane = opaque_tid() & 63;
  {
    const int r = row - NTOK, b = r >> 8, j = r & 255;
    const int kvrow = NCTX + b * 2304 + j;
    const float* ck = p.cache_ckv + ((size_t)(b * 4 + l) * 256 + j) * 128;
    const f2_t v = *(const f2_t*)(ck + lane * 2);
    *(unsigned*)(p.ckvn + (size_t)kvrow * 128 + lane * 2) = pack2(v[0], v[1]);
    if (lane < 16) {
      const float* kr = p.cache_krope + ((size_t)(b * 4 + l) * 256 + j) * 32;
      const f2_t w = *(const f2_t*)(kr + lane * 2);
      *(unsigned*)(p.krope + (size_t)kvrow * 32 + lane * 2) = pack2(w[0], w[1]);
    }
  }
}

constexpr int PSTR = 1192;
struct PrepW { f32x4 gq; f2_t gkv; float cw[8][5]; float cb[8]; float dtb; };
DI void prep_load_w(CP& p, int l, int lane, PrepW& w) {
  w.gq = *(const f32x4*)(p.g_q + l * 256 + lane * 4);
  w.gkv = *(const f2_t*)(p.g_kv + l * 128 + lane * 2);
  const float* cw = p.ssd_conv_w + (size_t)l * 5 * 512;
  const float* cb = p.ssd_conv_b + l * 512;
#pragma unroll
  for (int i = 0; i < 8; ++i) {
    w.cb[i] = cb[i * 64 + lane];
#pragma unroll
    for (int j = 0; j < 5; ++j) w.cw[i][j] = cw[j * 512 + i * 64 + lane];
  }
  w.dtb = p.ssd_dt_bias[l * 8 + (lane & 7)];
}
DI void prep_row(CP& p, int l, int tok, const LAS float* cr, const PrepW& w, int lane) {
  int b, t, T, kvrow;
  const bool lat = tok >= NCTX;
  if (!lat) { b = tok >> 8; t = tok & 255; T = 256; kvrow = tok; }
  else { const int q = tok - NCTX; b = q >> 11; t = q & 2047; T = 2048; kvrow = NCTX + b * 2304 + 256 + t; }
  {
    const f32x4 v = *(const LAS f32x4*)(cr + lane * 4);
    float ss = v[0] * v[0] + v[1] * v[1] + v[2] * v[2] + v[3] * v[3];
    ss = wave_sum(ss);
    const float rstd = rsqrtf(ss * (1.f / 256.f) + 1e-6f);
    const f32x4 gg = w.gq;
    u32x2 pk = {pack2(v[0] * rstd * gg[0], v[1] * rstd * gg[1]), pack2(v[2] * rstd * gg[2], v[3] * rstd * gg[3])};
    *(u32x2*)(p.qn + (size_t)tok * 256 + lane * 4) = pk;
  }
  {
    const f2_t v = *(const LAS f2_t*)(cr + 256 + lane * 2);
    float ss = v[0] * v[0] + v[1] * v[1];
    ss = wave_sum(ss);
    const float rstd = rsqrtf(ss * (1.f / 128.f) + 1e-6f);
    const f2_t gg = w.gkv;
    const float o0 = v[0] * rstd * gg[0], o1 = v[1] * rstd * gg[1];
    *(unsigned*)(p.ckvn + (size_t)kvrow * 128 + lane * 2) = pack2(o0, o1);
    if (!lat) {
      f2_t o = {o0, o1};
      *(f2_t*)(p.out + O_CKV + ((size_t)(b * 4 + l) * 256 + t) * 128 + lane * 2) = o;
    }
  }
  if (lane < 16) {
    const int a = lane >> 3, f = lane & 7;
    const float x1 = cr[384 + a * 16 + f], x2 = cr[384 + a * 16 + 8 + f];
    float o1 = x1, o2 = x2;
    if (!lat) {
      float* dst = p.out + O_KR + ((size_t)(b * 4 + l) * 256 + t) * 32;
      dst[a * 16 + f] = x1;
      dst[a * 16 + 8 + f] = x2;
    } else {
      const float c = p.ropec[t * 16 + a * 8 + f], s = p.ropes[t * 16 + a * 8 + f];
      o1 = x1 * c - x2 * s;
      o2 = x2 * c + x1 * s;
    }
    p.krope[(size_t)kvrow * 32 + a * 16 + f] = f2bf(o1);
    p.krope[(size_t)kvrow * 32 + a * 16 + 8 + f] = f2bf(o2);
  }
  {
#pragma unroll
    for (int i = 0; i < 8; ++i) {
      const int c = i * 64 + lane;
      float acc = w.cb[i];
#pragma unroll
      for (int j = 0; j < 5; ++j) {
        acc += w.cw[i][j] * cr[(j - 2) * PSTR + 672 + c];
      }
      p.xbc[(size_t)tok * 512 + c] = siluf(acc);
    }
  }
  if (lane < 8) {
    const float x = cr[1184 + lane] + w.dtb;
    const float sp = x > 20.f ? x : log1pf(expf(x));
    p.dtb[(size_t)tok * 8 + lane] = sp;
  }
}

DI void prep_tile(CP& p, int l, int ti, char* smem) {
  const int tid = opaque_tid(), wave = tid >> 6;
  int base, t0, T;
  if (ti < 256) { base = (ti >> 4) * 256; t0 = (ti & 15) * 16; T = 256; }
  else { const int j = ti - 256; base = NCTX + (j >> 7) * 2048; t0 = (j & 127) * 16; T = 2048; }
  LAS float* sr = (LAS float*)smem;
  const int lane = tid & 63;
  PrepW pw;
  prep_load_w(p, l, lane, pw);
  __syncthreads();
  u32x4 stg[6];
#pragma unroll
  for (int i = 0; i < 6; ++i) {
    const int idx = tid + i * 512;
    const int row = idx / 149, c8 = idx - row * 149;
    const int t = t0 - 2 + row;
    stg[i] = (u32x4){0u, 0u, 0u, 0u};
    if (idx < 2980 && t >= 0 && t < T) stg[i] = *(const u32x4*)(p.comb + (size_t)(base + t) * INW + c8 * 8);
  }
#pragma unroll
  for (int i = 0; i < 6; ++i) {
    const int idx = tid + i * 512;
    const int row = idx / 149, c8 = idx - row * 149;
    if (idx < 2980) {
      f32x4 lo, hi;
      lo[0] = __uint_as_float(stg[i][0] << 16); lo[1] = __uint_as_float(stg[i][0] & 0xffff0000u);
      lo[2] = __uint_as_float(stg[i][1] << 16); lo[3] = __uint_as_float(stg[i][1] & 0xffff0000u);
      hi[0] = __uint_as_float(stg[i][2] << 16); hi[1] = __uint_as_float(stg[i][2] & 0xffff0000u);
      hi[2] = __uint_as_float(stg[i][3] << 16); hi[3] = __uint_as_float(stg[i][3] & 0xffff0000u);
      *(LAS f32x4*)(sr + row * PSTR + c8 * 8) = lo;
      *(LAS f32x4*)(sr + row * PSTR + c8 * 8 + 4) = hi;
    }
  }
  __syncthreads();
#pragma unroll
  for (int i = 0; i < 2; ++i) {
    const int tt = wave * 2 + i;
    prep_row(p, l, base + t0 + tt, sr + (tt + 2) * PSTR, pw, lane);
  }
}

DI void cm_tile(CP& p, int l, int ti, char* smem) {
  const int tid = opaque_tid(), lane = tid & 63, wave = tid >> 6;
  int base, t0, T;
  if (ti < 128) { base = (ti >> 3) * 256; t0 = (ti & 7) * 32; T = 256; }
  else { const int j = ti - 128; base = NCTX + (j >> 6) * 2048; t0 = (j & 63) * 32; T = 2048; }
  LAS float* sg = (LAS float*)smem;
  LAS float* so = sg + 62 * 256;
  const int c = tid & 255, half = tid >> 8;
  float w[31];
#pragma unroll
  for (int j = 0; j < 31; ++j) w[j] = p.cm_conv_w[(size_t)(l * 31 + j) * 256 + c];
  const float bias = p.cm_conv_b[l * 256 + c];
  __syncthreads();
  {
    u32x4 ra[4], rb[4];
#pragma unroll
    for (int i = 0; i < 4; ++i) {
      const int idx = tid + i * 512;
      const int r = idx >> 5, c8 = idx & 31;
      const int t = t0 - 15 + r;
      ra[i] = (u32x4){0u, 0u, 0u, 0u}; rb[i] = (u32x4){0u, 0u, 0u, 0u};
      if (idx < 62 * 32 && t >= 0 && t < T) {
        const u16* cr = p.comb + (size_t)(base + t) * INW;
        ra[i] = *(const u32x4*)(cr + 1192 + c8 * 8);
        rb[i] = *(const u32x4*)(cr + 1448 + c8 * 8);
      }
    }
#pragma unroll
    for (int i = 0; i < 4; ++i) {
      const int idx = tid + i * 512;
      const int r = idx >> 5, c8 = idx & 31;
      if (idx < 62 * 32) {
        f32x4 lo, hi;
#pragma unroll
        for (int q = 0; q < 2; ++q) {
          lo[2 * q] = __uint_as_float(ra[i][q] << 16) * sigmoidf(__uint_as_float(rb[i][q] << 16));
          lo[2 * q + 1] = __uint_as_float(ra[i][q] & 0xffff0000u) * sigmoidf(__uint_as_float(rb[i][q] & 0xffff0000u));
          hi[2 * q] = __uint_as_float(ra[i][q + 2] << 16) * sigmoidf(__uint_as_float(rb[i][q + 2] << 16));
          hi[2 * q + 1] = __uint_as_float(ra[i][q + 2] & 0xffff0000u) * sigmoidf(__uint_as_float(rb[i][q + 2] & 0xffff0000u));
        }
        *(LAS f32x4*)(sg + r * 256 + c8 * 8) = lo;
        *(LAS f32x4*)(sg + r * 256 + c8 * 8 + 4) = hi;
      }
    }
  }
  __syncthreads();
#pragma unroll 1
  for (int t4 = 0; t4 < 4; ++t4) {
    const int tb = half * 16 + t4 * 4;
    float a0 = bias, a1 = bias, a2 = bias, a3 = bias;
#pragma unroll
    for (int j = 0; j < 34; ++j) {
      const float x = sg[(tb + j) * 256 + c];
      if (j < 31) a0 += w[j] * x;
      if (j >= 1 && j < 32) a1 += w[j - 1] * x;
      if (j >= 2 && j < 33) a2 += w[j - 2] * x;
      if (j >= 3) a3 += w[j - 3] * x;
    }
    so[tb * 256 + c] = a0;
    so[(tb + 1) * 256 + c] = a1;
    so[(tb + 2) * 256 + c] = a2;
    so[(tb + 3) * 256 + c] = a3;
  }
  __syncthreads();
  {
    float lg[4], lb[4];
#pragma unroll
    for (int i = 0; i < 4; ++i) { lg[i] = p.cm_ln_g[l * 256 + lane + 64 * i]; lb[i] = p.cm_ln_b[l * 256 + lane + 64 * i]; }
#pragma unroll
    for (int tt = 0; tt < 4; ++tt) {
      const int t = wave * 4 + tt;
      float v[4];
      float sm = 0.f;
#pragma unroll
      for (int i = 0; i < 4; ++i) { v[i] = so[t * 256 + lane + 64 * i]; sm += v[i]; }
      const float mean = wave_sum(sm) * (1.f / 256.f);
      float q = 0.f;
#pragma unroll
      for (int i = 0; i < 4; ++i) { const float d = v[i] - mean; q += d * d; }
      const float var = wave_sum(q) * (1.f / 256.f);
      const float rstd = rsqrtf(var + 1e-5f);
#pragma unroll
      for (int i = 0; i < 4; ++i) {
        const int cc = lane + 64 * i;
        float y = (v[i] - mean) * rstd * lg[i] + lb[i];
        y = siluf(y);
        p.hb[(size_t)(base + t0 + t) * 1024 + 768 + cc] = f2bf(y);
      }
    }
  }
}

DI void ssd_item(CP& p, int l, int seq, int h, int dir, char* smem) {
  const int tid = opaque_tid(), lane = tid & 63, wave = tid >> 6, lr = lane & 15, g = lane >> 4;
  const int rt = wave & 3, ch = wave >> 2;
  const bool lat = seq >= 16;
  const int b = lat ? seq - 16 : seq;
  const int T = lat ? 2048 : 256;
  const int qbase = lat ? NCTX + b * 2048 : b * 256;
  constexpr int TSZ = 64 * 72;
  u16* tset = (u16*)smem;
  u16* sM = tset + 2 * 5 * TSZ;
  u16* sH = sM + TSZ;
  float* sdtA = (float*)(sH + 64 * 72);
  float* sacsA = sdtA + 2048;
  float* swA = sacsA + 2048;
  const float Aneg = -expf(p.ssd_a_log[(l * 2 + dir) * 4 + h]);
  const int grp = h >> 1;
  f32x4 hacc[2];
  if (lat) {
    const float* src = p.state_ssd + ((size_t)(((b * 4 + l) * 2 + dir) * 4 + h)) * 4096;
#pragma unroll
    for (int n2 = 0; n2 < 2; ++n2) hacc[n2] = *(const f32x4*)(src + (rt * 16 + lr) * 64 + (ch * 2 + n2) * 16 + g * 4);
  } else {
#pragma unroll
    for (int n2 = 0; n2 < 2; ++n2) hacc[n2] = (f32x4){0.f, 0.f, 0.f, 0.f};
  }
  __syncthreads();
#pragma unroll
  for (int n2 = 0; n2 < 2; ++n2) {
    u32x2 pk = {pack2(hacc[n2][0], hacc[n2][1]), pack2(hacc[n2][2], hacc[n2][3])};
    *(u32x2*)(sH + (rt * 16 + lr) * 72 + (ch * 2 + n2) * 16 + g * 4) = pk;
  }
  const int nch = T >> 6;
  {
    float dv[4];
#pragma unroll
    for (int i = 0; i < 4; ++i) {
      const int cq = wave + 8 * i;
      dv[i] = cq < nch ? p.dtb[(size_t)(qbase + cq * 64 + lane) * 8 + dir * 4 + h] : 0.f;
    }
#pragma unroll
    for (int i = 0; i < 4; ++i) {
      const int cq = wave + 8 * i;
      float sc = dv[i] * Aneg;
      if (!dir) {
#pragma unroll
        for (int o = 1; o < 64; o <<= 1) { const float tv = __shfl_up(sc, o); if (lane >= o) sc += tv; }
      } else {
#pragma unroll
        for (int o = 1; o < 64; o <<= 1) { const float tv = __shfl_down(sc, o); if (lane + o < 64) sc += tv; }
      }
      const float tot = __shfl(sc, dir ? 0 : 63);
      if (cq < nch) { sdtA[cq * 64 + lane] = dv[i]; sacsA[cq * 64 + lane] = sc; swA[cq * 64 + lane] = __expf(tot - sc) * dv[i]; }
    }
  }
  const int e = lane;
  const int r = tid >> 3, cc = (tid & 7) * 8;
  float xs[8], bs[8];
  f32x4 cv[2], bv[2];
  {
    const int c0 = dir ? nch - 1 : 0;
    const float* rowp = p.xbc + (size_t)(qbase + c0 * 64 + wave * 8) * 512;
#pragma unroll
    for (int i = 0; i < 8; ++i) {
      xs[i] = rowp[i * 512 + h * 64 + e];
      bs[i] = rowp[i * 512 + 256 + grp * 64 + e];
    }
    const float* rowq = p.xbc + (size_t)(qbase + c0 * 64 + r) * 512;
#pragma unroll
    for (int i = 0; i < 2; ++i) {
      bv[i] = *(const f32x4*)(rowq + 256 + grp * 64 + cc + i * 4);
      cv[i] = *(const f32x4*)(rowq + 384 + grp * 64 + cc + i * 4);
    }
  }
  __syncthreads();
#define SSD_WRITE_TILES(SET, CH) do {                                                                                    \
    u16* wC_ = tset + (SET) * 5 * TSZ; u16* wB_ = wC_ + TSZ; u16* wBt_ = wB_ + TSZ; u16* wXt_ = wBt_ + TSZ; u16* wXw_ = wXt_ + TSZ; \
    const f32x4 w0 = *(const f32x4*)(swA + (CH) * 64 + wave * 8), w1 = *(const f32x4*)(swA + (CH) * 64 + wave * 8 + 4);   \
    u32x4 c0 = {pack2(cv[0][0], cv[0][1]), pack2(cv[0][2], cv[0][3]), pack2(cv[1][0], cv[1][1]), pack2(cv[1][2], cv[1][3])}; \
    *(u32x4*)(wC_ + r * 72 + cc) = c0;                                                                                    \
    u32x4 b0 = {pack2(bv[0][0], bv[0][1]), pack2(bv[0][2], bv[0][3]), pack2(bv[1][0], bv[1][1]), pack2(bv[1][2], bv[1][3])}; \
    *(u32x4*)(wB_ + r * 72 + cc) = b0;                                                                                    \
    u32x4 tb = {pack2(bs[0], bs[1]), pack2(bs[2], bs[3]), pack2(bs[4], bs[5]), pack2(bs[6], bs[7])};                       \
    u32x4 tx = {pack2(xs[0], xs[1]), pack2(xs[2], xs[3]), pack2(xs[4], xs[5]), pack2(xs[6], xs[7])};                       \
    u32x4 tw = {pack2(xs[0] * w0[0], xs[1] * w0[1]), pack2(xs[2] * w0[2], xs[3] * w0[3]),                                  \
                pack2(xs[4] * w1[0], xs[5] * w1[1]), pack2(xs[6] * w1[2], xs[7] * w1[3])};                                 \
    *(u32x4*)(wBt_ + e * 72 + wave * 8) = tb;                                                                             \
    *(u32x4*)(wXt_ + e * 72 + wave * 8) = tx;                                                                             \
    *(u32x4*)(wXw_ + e * 72 + wave * 8) = tw;                                                                             \
  } while (0)
#define SSD_PREFETCH(CH) do {                                                                                            \
    const float* rowp = p.xbc + (size_t)(qbase + (CH) * 64 + wave * 8) * 512;                                             \
    _Pragma("unroll") for (int i = 0; i < 8; ++i) {                                                                       \
      xs[i] = rowp[i * 512 + h * 64 + e];                                                                                 \
      bs[i] = rowp[i * 512 + 256 + grp * 64 + e];                                                                         \
    }                                                                                                                     \
    const float* rowq = p.xbc + (size_t)(qbase + (CH) * 64 + r) * 512;                                                    \
    _Pragma("unroll") for (int i = 0; i < 2; ++i) {                                                                       \
      bv[i] = *(const f32x4*)(rowq + 256 + grp * 64 + cc + i * 4);                                                        \
      cv[i] = *(const f32x4*)(rowq + 384 + grp * 64 + cc + i * 4);                                                        \
    }                                                                                                                     \
  } while (0)
  {
    const int c0 = dir ? nch - 1 : 0;
    SSD_WRITE_TILES(0, c0);
    if (nch > 1) { const int c1 = dir ? nch - 2 : 1; SSD_PREFETCH(c1); }
  }
  __syncthreads();
#pragma unroll 1
  for (int ci = 0; ci < nch; ++ci) {
    const int c = dir ? nch - 1 - ci : ci;
    const int tok0 = qbase + c * 64;
    const float* sdt = sdtA + c * 64;
    const float* sacs = sacsA + c * 64;
    const float total = dir ? sacs[0] : sacs[63];
    const int cur = ci & 1;
    u16* sC = tset + cur * 5 * TSZ; u16* sB = sC + TSZ; u16* sBt = sB + TSZ; u16* sXt = sBt + TSZ; u16* sXw = sXt + TSZ;
    f32x4 gacc[2];
#pragma unroll
    for (int s2 = 0; s2 < 2; ++s2) gacc[s2] = (f32x4){0.f, 0.f, 0.f, 0.f};
#pragma unroll
    for (int ks = 0; ks < 2; ++ks) {
      const bf16x8 cf = *(const bf16x8*)(sC + (rt * 16 + lr) * 72 + ks * 32 + g * 8);
#pragma unroll
      for (int s2 = 0; s2 < 2; ++s2) {
        const bf16x8 bfr = *(const bf16x8*)(sB + ((ch * 2 + s2) * 16 + lr) * 72 + ks * 32 + g * 8);
        gacc[s2] = MFMA(bfr, cf, gacc[s2]);
      }
    }
    int opq;
    asm volatile("v_mov_b32 %0, 0" : "=v"(opq));
    const int li = rt * 16 + lr + opq;
    const float acs_l = sacs[li];
#pragma unroll
    for (int s2 = 0; s2 < 2; ++s2) {
      const int sb0 = (ch * 2 + s2) * 16 + g * 4;
      const f32x4 acs_s = *(const f32x4*)(sacs + sb0);
      const f32x4 dt_s = *(const f32x4*)(sdt + sb0);
      float mv[4];
#pragma unroll
      for (int i = 0; i < 4; ++i) {
        const int si = sb0 + i;
        const bool ok = dir ? (si >= li) : (si <= li);
        mv[i] = ok ? gacc[s2][i] * __expf(acs_l - acs_s[i]) * dt_s[i] : 0.f;
      }
      u32x2 pk = {pack2(mv[0], mv[1]), pack2(mv[2], mv[3])};
      *(u32x2*)(sM + li * 72 + sb0) = pk;
    }
    if (ci + 1 < nch) {
      const int cn = dir ? nch - 2 - ci : ci + 1;
      SSD_WRITE_TILES(cur ^ 1, cn);
      if (ci + 2 < nch) { const int c2 = dir ? nch - 3 - ci : ci + 2; SSD_PREFETCH(c2); }
    }
    __syncthreads();
    f32x4 yd[2], yo[2];
#pragma unroll
    for (int p2 = 0; p2 < 2; ++p2) { yd[p2] = (f32x4){0.f, 0.f, 0.f, 0.f}; yo[p2] = (f32x4){0.f, 0.f, 0.f, 0.f}; }
#pragma unroll
    for (int ks = 0; ks < 2; ++ks) {
      const bf16x8 mf = *(const bf16x8*)(sM + (rt * 16 + lr) * 72 + ks * 32 + g * 8);
      const bf16x8 cf = *(const bf16x8*)(sC + (rt * 16 + lr) * 72 + ks * 32 + g * 8);
#pragma unroll
      for (int p2 = 0; p2 < 2; ++p2) {
        const bf16x8 xf = *(const bf16x8*)(sXt + ((ch * 2 + p2) * 16 + lr) * 72 + ks * 32 + g * 8);
        const bf16x8 hf = *(const bf16x8*)(sH + ((ch * 2 + p2) * 16 + lr) * 72 + ks * 32 + g * 8);
        yd[p2] = MFMA(xf, mf, yd[p2]);
        yo[p2] = MFMA(hf, cf, yo[p2]);
      }
    }
    {
      const float e = __expf(acs_l);
      float* yrow = p.ydir + ((size_t)dir * NTOK + tok0 + rt * 16 + lr) * 256 + h * 64 + ch * 32 + g * 4;
#pragma unroll
      for (int p2 = 0; p2 < 2; ++p2) {
        f32x4 yv;
#pragma unroll
        for (int i = 0; i < 4; ++i) yv[i] = yd[p2][i] + e * yo[p2][i];
        *(f32x4*)(yrow + p2 * 16) = yv;
      }
    }
    f32x4 hn[2];
#pragma unroll
    for (int n2 = 0; n2 < 2; ++n2) hn[n2] = (f32x4){0.f, 0.f, 0.f, 0.f};
#pragma unroll
    for (int ks = 0; ks < 2; ++ks) {
      const bf16x8 xw = *(const bf16x8*)(sXw + (rt * 16 + lr) * 72 + ks * 32 + g * 8);
#pragma unroll
      for (int n2 = 0; n2 < 2; ++n2) {
        const bf16x8 bt = *(const bf16x8*)(sBt + ((ch * 2 + n2) * 16 + lr) * 72 + ks * 32 + g * 8);
        hn[n2] = MFMA(bt, xw, hn[n2]);
      }
    }
    const float et = __expf(total);
#pragma unroll
    for (int n2 = 0; n2 < 2; ++n2) hacc[n2] = hacc[n2] * et + hn[n2];
    __syncthreads();
#pragma unroll
    for (int n2 = 0; n2 < 2; ++n2) {
      u32x2 pk = {pack2(hacc[n2][0], hacc[n2][1]), pack2(hacc[n2][2], hacc[n2][3])};
      *(u32x2*)(sH + (rt * 16 + lr) * 72 + (ch * 2 + n2) * 16 + g * 4) = pk;
    }
  }
  if (!lat) {
    float* dst = p.out + O_SSD + ((size_t)(((b * 4 + l) * 2 + dir) * 4 + h)) * 4096;
#pragma unroll
    for (int n2 = 0; n2 < 2; ++n2) *(f32x4*)(dst + (rt * 16 + lr) * 64 + (ch * 2 + n2) * 16 + g * 4) = hacc[n2];
  }
}

DI void ssd_final_rows4(CP& p, int l, int tok0) {
  const int lane = opaque_tid() & 63;
  const int c = lane * 4, h = c >> 6;
  const float dd = p.ssd_d[(l * 2 + 0) * 4 + h] + p.ssd_d[(l * 2 + 1) * 4 + h];
  const f32x4 gg = *(const f32x4*)(p.ssd_norm_g + l * 256 + c);
  f32x4 y0[4], y1[4], xs[4];
  u32x2 zr[4];
#pragma unroll
  for (int a = 0; a < 4; ++a) {
    const int tok = tok0 + a;
    y0[a] = *(const f32x4*)(p.ydir + (size_t)tok * 256 + c);
    y1[a] = *(const f32x4*)(p.ydir + ((size_t)NTOK + tok) * 256 + c);
    xs[a] = *(const f32x4*)(p.xbc + (size_t)tok * 512 + c);
    zr[a] = *(const u32x2*)(p.comb + (size_t)tok * INW + 416 + c);
  }
#pragma unroll
  for (int a = 0; a < 4; ++a) {
    const int tok = tok0 + a;
    const f32x4 z = {__uint_as_float(zr[a][0] << 16), __uint_as_float(zr[a][0] & 0xffff0000u), __uint_as_float(zr[a][1] << 16),
                     __uint_as_float(zr[a][1] & 0xffff0000u)};
    f32x4 v;
    float ss = 0.f;
#pragma unroll
    for (int j = 0; j < 4; ++j) {
      v[j] = (y0[a][j] + y1[a][j] + dd * xs[a][j]) * siluf(z[j]);
      ss += v[j] * v[j];
    }
    ss = wave_sum(ss);
    const float rstd = rsqrtf(ss * (1.f / 256.f) + 1e-6f);
    u32x2 pk = {pack2(v[0] * rstd * gg[0], v[1] * rstd * gg[1]), pack2(v[2] * rstd * gg[2], v[3] * rstd * gg[3])};
    *(u32x2*)(p.hb + (size_t)tok * 1024 + 512 + c) = pk;
  }
}

DI void attn_item(CP& p, int seq, int h, int qb, char* smem) {
  const int tid = opaque_tid(), lane = tid & 63, wave = tid >> 6, lr = lane & 15, g = lane >> 4;
  const bool lat = seq >= 16;
  int Tk, kvbase, qtok0;
  if (!lat) { Tk = 256; kvbase = seq * 256; qtok0 = seq * 256; }
  else { const int b = seq - 16; Tk = 2304; kvbase = NCTX + b * 2304; qtok0 = NCTX + b * 2048 + qb * 256; }
  LAS u16* sKb = (LAS u16*)smem;
  LAS u16* sVb = sKb + 256 * 104;
  bf16x8 qf[2][3];
#pragma unroll
  for (int qt = 0; qt < 2; ++qt) {
    const int tok = qtok0 + wave * 32 + qt * 16 + lr;
#pragma unroll
    for (int ks = 0; ks < 3; ++ks) qf[qt][ks] = *(const bf16x8*)(p.qbuf + (size_t)tok * 768 + h * 96 + ks * 32 + g * 8);
    if (lat) {
      const int t = (tok - NCTX) & 2047;
      const int axis = g >> 1, half = g & 1;
      const float* cs = p.ropec + t * 16 + axis * 8;
      const float* sn = p.ropes + t * 16 + axis * 8;
      bf16x8 r;
#pragma unroll
      for (int j = 0; j < 8; ++j) {
        const float x = bf2f((u16)qf[qt][2][j]);
        const float pr = __shfl_xor(x, 16);
        const float c = cs[j], s = sn[j];
        const float o = half ? x * c + pr * s : x * c - pr * s;
        r[j] = (short)f2bf(o);
      }
      qf[qt][2] = r;
    }
  }
  f32x4 o[2][4];
#pragma unroll
  for (int qt = 0; qt < 2; ++qt)
#pragma unroll
    for (int dt = 0; dt < 4; ++dt) o[qt][dt] = (f32x4){0.f, 0.f, 0.f, 0.f};
  float mrow[2] = {-1e30f, -1e30f}, lrow[2] = {0.f, 0.f};
  const float cs2 = 0.10206207261596574f * 1.4426950408889634f;
  const int nst = Tk >> 8;
  const u16* gk = p.knope + (size_t)(kvbase + (tid >> 3)) * 512 + h * 64 + (tid & 7) * 8;
  const u16* gr = p.krope + (size_t)(kvbase + (tid >> 2)) * 32 + (tid & 3) * 8;
  const u16* gv = p.vt + (size_t)512 * kvbase + (size_t)(h * 64 + (tid >> 5)) * Tk + (tid & 31) * 8;
  u32x4 rk[4], rr[2], rv[4];
#pragma unroll
  for (int i = 0; i < 4; ++i) { rk[i] = *(const u32x4*)(gk + (size_t)i * 64 * 512); rv[i] = *(const u32x4*)(gv + (size_t)i * 16 * Tk); }
#pragma unroll
  for (int i = 0; i < 2; ++i) rr[i] = *(const u32x4*)(gr + (size_t)i * 128 * 32);
#pragma unroll 1
  for (int st = 0; st < nst; ++st) {
    __syncthreads();
#pragma unroll
    for (int i = 0; i < 4; ++i) {
      *(LAS u32x4*)(sKb + ((tid >> 3) + i * 64) * 104 + (tid & 7) * 8) = rk[i];
      *(LAS u32x4*)(sVb + ((tid >> 5) + i * 16) * 264 + (tid & 31) * 8) = rv[i];
    }
#pragma unroll
    for (int i = 0; i < 2; ++i) *(LAS u32x4*)(sKb + ((tid >> 2) + i * 128) * 104 + 64 + (tid & 3) * 8) = rr[i];
    __syncthreads();
    if (st + 1 < nst) {
      const size_t ko = (size_t)(st + 1) * 256;
#pragma unroll
      for (int i = 0; i < 4; ++i) { rk[i] = *(const u32x4*)(gk + (ko + i * 64) * 512); rv[i] = *(const u32x4*)(gv + (size_t)i * 16 * Tk + ko); }
#pragma unroll
      for (int i = 0; i < 2; ++i) rr[i] = *(const u32x4*)(gr + (ko + i * 128) * 32);
    }
#pragma unroll 1
    for (int kt = 0; kt < 4; ++kt) {
      const LAS u16* sK = sKb + kt * 64 * 104;
      const LAS u16* sV = sVb + kt * 64;
      f32x4 s[4][2];
#pragma unroll
      for (int k4 = 0; k4 < 4; ++k4) {
        s[k4][0] = (f32x4){0.f, 0.f, 0.f, 0.f};
        s[k4][1] = (f32x4){0.f, 0.f, 0.f, 0.f};
#pragma unroll
        for (int ks = 0; ks < 3; ++ks) {
          const bf16x8 kf = *(const LAS bf16x8*)(sK + (k4 * 16 + lr) * 104 + ks * 32 + g * 8);
          s[k4][0] = MFMA(kf, qf[0][ks], s[k4][0]);
          s[k4][1] = MFMA(kf, qf[1][ks], s[k4][1]);
        }
      }
      bf16x8 pf[2][2];
#pragma unroll
      for (int qt = 0; qt < 2; ++qt) {
        float mx = -1e30f;
#pragma unroll
        for (int k4 = 0; k4 < 4; ++k4)
#pragma unroll
          for (int i = 0; i < 4; ++i) mx = fmaxf(mx, s[k4][qt][i]);
        mx = xrow16_max(mx);
        const float mnew = fmaxf(mrow[qt], mx * cs2);
        const float alpha = __builtin_amdgcn_exp2f(mrow[qt] - mnew);
        mrow[qt] = mnew;
        float psum = 0.f;
        float pv[4][4];
#pragma unroll
        for (int k4 = 0; k4 < 4; ++k4)
#pragma unroll
          for (int i = 0; i < 4; ++i) {
            pv[k4][i] = __builtin_amdgcn_exp2f(s[k4][qt][i] * cs2 - mnew);
            psum += pv[k4][i];
          }
        lrow[qt] = lrow[qt] * alpha + psum;
        if (__builtin_amdgcn_ballot_w64(alpha != 1.f) != 0ull) {
#pragma unroll
          for (int dt = 0; dt < 4; ++dt) o[qt][dt] *= alpha;
        }
#pragma unroll
        for (int s2 = 0; s2 < 2; ++s2) {
          u32x4 pk = {pack2(pv[2 * s2][0], pv[2 * s2][1]), pack2(pv[2 * s2][2], pv[2 * s2][3]),
                      pack2(pv[2 * s2 + 1][0], pv[2 * s2 + 1][1]), pack2(pv[2 * s2 + 1][2], pv[2 * s2 + 1][3])};
          pf[qt][s2] = __builtin_bit_cast(bf16x8, pk);
        }
      }
#pragma unroll
      for (int s2 = 0; s2 < 2; ++s2)
#pragma unroll
        for (int dt = 0; dt < 4; ++dt) {
          const s16x4 lo = *(const LAS s16x4*)(sV + (dt * 16 + lr) * 264 + s2 * 32 + g * 4);
          const s16x4 hi = *(const LAS s16x4*)(sV + (dt * 16 + lr) * 264 + s2 * 32 + 16 + g * 4);
          const bf16x8 vf = __builtin_shufflevector(lo, hi, 0, 1, 2, 3, 4, 5, 6, 7);
          o[0][dt] = MFMA(vf, pf[0][s2], o[0][dt]);
          o[1][dt] = MFMA(vf, pf[1][s2], o[1][dt]);
        }
    }
  }
#pragma unroll
  for (int qt = 0; qt < 2; ++qt) {
    float lsum = lrow[qt];
    lsum = xrow16_sum(lsum);
    const float inv = frcp(lsum);
    const int tok = qtok0 + wave * 32 + qt * 16 + lr;
#pragma unroll
    for (int dt = 0; dt < 4; ++dt) {
      u32x2 pk = {pack2(o[qt][dt][0] * inv, o[qt][dt][1] * inv), pack2(o[qt][dt][2] * inv, o[qt][dt][3] * inv)};
      *(u32x2*)(p.hb + (size_t)tok * 1024 + h * 64 + dt * 16 + g * 4) = pk;
    }
  }
}

DI int next_item(unsigned* ctr, int* slot) {
  __syncthreads();
  if (threadIdx.x == 0) *slot = (int)atomicAdd(ctr, 1u);
  __syncthreads();
  return *slot;
}

DI void forward(char* smem) {
  const int G = gridDim.x, bid = blockIdx.x;
  const int wave = threadIdx.x >> 6;
  int* slot = (int*)(smem + LDS_MAIN + 32);
  int ph = 0;
  XcdBarrier xb;
  {
    unsigned* stw = (unsigned*)(smem + LDS_MAIN);
    if (threadIdx.x == 0) { stw[0] = 0u; stw[1] = 0u; }
    __syncthreads();
    CP& p0 = get_params();
    xb = xcd_barrier_post(p0.bar, (volatile LAS unsigned*)stw);
    (void)xb;
  }
#define PH_BEGIN { CP& p = get_params();
#if USE_CG_SYNC
#define PH_END } { if (ph == 0) cg::this_grid().sync(); else { XcdBarrier xq; xq.bar = nullptr; xq.x = 0u; xq.st = (volatile LAS unsigned*)(smem + LDS_MAIN); xcd_barrier(xq); } } ++ph;
#else
#define PH_END } { XcdBarrier xq; xq.bar = nullptr; xq.x = 0u; xq.st = (volatile LAS unsigned*)(smem + LDS_MAIN); xcd_barrier(xq); } ++ph;
#endif

  PH_BEGIN
    phase0(p, smem);
  PH_END

#pragma unroll 1
  for (int l = 0; l < 4; ++l) {
    PH_BEGIN
      norm_phase(p, l, 0);
    PH_END
    PH_BEGIN
      gemm_phase<E_COMB, 192>(p, l, p.hb, p.wt_in + (size_t)l * INWP * 1024, 1024, 64, 7, 0, bid, G, 64 * 7, true, smem);
    PH_END
    PH_BEGIN
      for (int t = bid; t < 768 + 128; t += G) {
        if (t < 768) prep_tile(p, l, t, smem);
        else prep_cache_row(p, l, NTOK + (t - 768) * 8 + wave);
      }
    PH_END
    PH_BEGIN
      for (;;) {
        const int it = next_item(p.ctr + ph, slot);
        if (it >= 160 + 384 + 208 + 144) break;
        if (it < 32 || (it >= 416 && it < 544)) {
          const int j = it < 32 ? it : it - 416;
          ssd_item(p, l, (it < 32 ? 16 : 0) + (j >> 3), (j >> 1) & 3, j & 1, smem);
        } else if (it < 416) {
          cm_tile(p, l, it - 32, smem);
        } else if (it < 752) {
          const int t = it - 544;
          gemm_phase<E_KV, 256>(p, l, p.ckvn, p.wt_ukv + (size_t)l * 1024 * 128, 128, 52, 4, 0, t, 1 << 20, 208, false, smem);
        } else {
          const int t = it - 752;
          gemm_phase<E_Q, 256>(p, l, p.qn, p.wt_uq + (size_t)l * 768 * 256, 256, 48, 3, 0, t, 1 << 20, 144, false, smem);
        }
      }
      if (l < 3) conv_fill(p, l + 1, 0, 5792, p.ctr + 128 + ph, slot, smem);
    PH_END
    PH_BEGIN
      for (;;) {
        const int it = next_item(p.ctr + ph, slot);
        if (it >= 384 + 384) break;
        if (it < 384) {
          int sq, hh, qb;
          if (it < 256) { sq = 16 + (it >> 6); hh = (it >> 3) & 7; qb = it & 7; }
          else { const int j = it - 256; sq = j >> 3; hh = j & 7; qb = 0; }
          attn_item(p, sq, hh, qb, smem);
        } else {
          const int t0 = (it - 384) * 32 + wave * 4;
          ssd_final_rows4(p, l, t0);
        }
      }
    PH_END
    PH_BEGIN
      gemm_phase<E_RES, 192>(p, l, p.hb, p.wt_out + (size_t)l * 1024 * 1024, 1024, 64, 4, 2048, bid, G, 64 * 4, true, smem);
    PH_END
    PH_BEGIN
      norm_phase(p, l, 1);
    PH_END
    PH_BEGIN
      gemm_phase<E_SWIGLU, 192>(p, l, p.hb, p.wt_gu + (size_t)l * 2 * DFF * 1024, 1024, 64, 22, 0, bid, G, 64 * 22, true, smem);
    PH_END
    PH_BEGIN
      gemm_phase<E_RES, 192>(p, l, p.act, p.wt_down + (size_t)l * 1024 * DFF, DFF, 64, 4, 5120, bid, G, 64 * 4, true, smem);
    PH_END
  }
  { CP& p = get_params(); final_norm(p); }
}

extern __shared__ __attribute__((aligned(1024))) char dyn_smem[];

__global__ void __launch_bounds__(NTHREADS, 2) k_mega(P p) { forward(dyn_smem); }

extern "C" void kernel_launch(void* const* d_in, const int* in_sizes, int n_in, void* d_out, int out_size, void* d_ws,
                              size_t ws_size, hipStream_t stream) {
  P p{};
  const float** fp = (const float**)&p;
  for (int i = 0; i < 31; ++i) fp[i] = (const float*)d_in[i];
  p.out = (float*)d_out;
  char* ws = (char*)d_ws;
  size_t off = 0;
  auto take = [&](size_t bytes) { char* r = ws + off; off += (bytes + 255) & ~(size_t)255; return r; };
  p.bar = (unsigned*)take(16384);
  p.ctr = (unsigned*)take(16384);
  p.wt_in = (u16*)take((size_t)4 * INWP * 1024 * 2);
  p.wt_uq = (u16*)take((size_t)4 * 768 * 256 * 2);
  p.wt_ukv = (u16*)take((size_t)4 * 1024 * 128 * 2);
  p.wt_out = (u16*)take((size_t)4 * 1024 * 1024 * 2);
  p.wt_gu = (u16*)take((size_t)4 * 2 * DFF * 1024 * 2);
  p.wt_down = (u16*)take((size_t)4 * 1024 * DFF * 2);
  p.mod = (float*)take((size_t)4 * 5 * 6144 * 4);
  p.ropec = (float*)take(2048 * 16 * 4);
  p.ropes = (float*)take(2048 * 16 * 4);
  p.hb = (u16*)take((size_t)NTOK * 1024 * 2);
  p.comb = (u16*)take((size_t)NTOK * DFF * 2);
  p.act = p.comb;
  p.qn = (u16*)take((size_t)NTOK * 256 * 2);
  p.ckvn = (u16*)take((size_t)KVROWS * 128 * 2);
  p.qbuf = (u16*)take((size_t)NTOK * 768 * 2);
  p.knope = (u16*)take((size_t)KVROWS * 512 * 2);
  p.vt = (u16*)take((size_t)KVROWS * 512 * 2);
  p.krope = (u16*)take((size_t)KVROWS * 32 * 2);
  p.xbc = (float*)take((size_t)NTOK * 512 * 4);
  p.dtb = (float*)take((size_t)NTOK * 8 * 4);
  p.ydir = (float*)take((size_t)2 * NTOK * 256 * 4);
  if (off > ws_size) { fprintf(stderr, "workspace too small: need %zu have %zu\n", off, ws_size); return; }

  static int grid_blocks = 0;
  if (!grid_blocks) {
    int dev = 0, cus = 0, per_cu = 0;
    (void)hipGetDevice(&dev);
    (void)hipDeviceGetAttribute(&cus, hipDeviceAttributeMultiprocessorCount, dev);
    (void)hipFuncSetAttribute((const void*)k_mega, hipFuncAttributeMaxDynamicSharedMemorySize, LDS_BYTES);
    (void)hipOccupancyMaxActiveBlocksPerMultiprocessor(&per_cu, (const void*)k_mega, NTHREADS, LDS_BYTES);
    if (per_cu > 1) per_cu = 1;
    if (per_cu < 1) per_cu = 1;
    grid_blocks = cus * per_cu;
  }
  (void)hipMemsetAsync(d_ws, 0, 32768, stream);
  void* args[] = {&p};
  hipError_t e = hipLaunchCooperativeKernel((const void*)k_mega, dim3(grid_blocks), dim3(NTHREADS), args, LDS_BYTES, stream);
  if (e != hipSuccess) fprintf(stderr, "cooperative launch failed: %s (grid %d)\n", hipGetErrorString(e), grid_blocks);
}
```
